# Optimizing an MI355X kernel written in HIP

```python
import jax, jax.numpy as jnp
from jax import lax
import numpy as np

D_MODEL = 2048
BATCH = 4
SEQ = 2048
DEPTH = 1

CONV_CH = D_MODEL // 2
CONV_K = 3
RET_HEADS = 8
RET_DK = D_MODEL // (2 * RET_HEADS)
RET_DV = 2 * RET_DK
RET_QK = RET_HEADS * RET_DK
RET_V = RET_HEADS * RET_DV
CHUNK = 128
ROPE_BASE = 10000.0
N_GROUPS = 4
EXPERTS_PER_GROUP = 8
N_EXPERTS = N_GROUPS * EXPERTS_PER_GROUP
TOP_K = 2
D_EXPERT = D_MODEL // 2
EXPERT_BLOCK = 128
EPS = 1e-6
IN_COLS = 3 * CONV_CH + 2 * RET_QK + 2 * RET_V + 2 * D_MODEL

kernel_name = "hybrid_conv_retention_hmoe_adaln"


def rmsnorm(x, g):
    xf = x.astype(jnp.float32)
    xf = xf * lax.rsqrt(jnp.mean(xf * xf, axis=-1, keepdims=True) + EPS)
    return (xf * g.astype(jnp.float32)).astype(x.dtype)


def modulate(h, shift, scale):
    return h * (1 + scale[:, None, :]) + shift[:, None, :]


def causal_dwconv(z, w):
    S = z.shape[1]
    zp = jnp.pad(z, ((0, 0), (CONV_K - 1, 0), (0, 0)))
    out = zp[:, 0:S] * w[0]
    for tap in range(1, CONV_K):
        out = out + zp[:, tap:tap + S] * w[tap]
    return out


def rotary(t):
    S, d = t.shape[-2], t.shape[-1]
    inv = ROPE_BASE ** (-jnp.arange(0, d, 2, dtype=jnp.float32) / d)
    ang = jnp.arange(S, dtype=jnp.float32)[:, None] * inv[None, :]
    cos, sin = jnp.cos(ang).astype(t.dtype), jnp.sin(ang).astype(t.dtype)
    t1, t2 = t[..., : d // 2], t[..., d // 2:]
    return jnp.concatenate([t1 * cos - t2 * sin, t1 * sin + t2 * cos], axis=-1)


def retention_chunkwise(q, k, v):
    B, H, S, dk = q.shape
    dv = v.shape[-1]
    N = S // CHUNK
    dt = q.dtype
    log_g = jnp.log1p(-(2.0 ** (-5.0 - jnp.arange(H, dtype=jnp.float32))))
    i = jnp.arange(CHUNK, dtype=jnp.float32)
    diff = i[:, None] - i[None, :]
    inner_decay = jnp.where(diff >= 0, jnp.exp(log_g[:, None, None] * jnp.maximum(diff, 0.0)), 0.0).astype(dt)
    q_decay = jnp.exp(log_g[:, None] * (i + 1.0)).astype(dt)
    k_decay = jnp.exp(log_g[:, None] * (CHUNK - 1.0 - i)).astype(dt)
    chunk_decay = jnp.exp(log_g * CHUNK).astype(dt)[:, None, None]
    qc = q.reshape(B, H, N, CHUNK, dk)
    kc = k.reshape(B, H, N, CHUNK, dk)
    vc = v.reshape(B, H, N, CHUNK, dv)
    scores = jnp.einsum('bhnid,bhnjd->bhnij', qc, kc) * inner_decay[None, :, None]
    inner = jnp.einsum('bhnij,bhnje->bhnie', scores, vc)
    kv = jnp.einsum('bhnjd,hj,bhnje->nbhde', kc, k_decay, vc)

    def step(state, kv_n):
        return state * chunk_decay + kv_n, state

    _, s_prev = lax.scan(step, jnp.zeros((B, H, dk, dv), kv.dtype), kv)
    cross = jnp.einsum('bhnid,hi,nbhde->bhnie', qc, q_decay, s_prev)
    return (inner + cross).reshape(B, H, S, dv)


def hier_moe(h, w_router_group, b_router_group, w_router_expert, b_router_expert, w_gate, w_up, w_down):
    T, D = h.shape
    g_logits = (h @ w_router_group).astype(jnp.float32) + b_router_group.astype(jnp.float32)
    g_prob = jax.nn.softmax(g_logits, axis=-1)
    g_sel = jnp.argmax(g_logits, axis=-1)
    tok = jnp.arange(T)
    g_w = g_prob[tok, g_sel][:, None]
    e_logits = ((h @ w_router_expert).astype(jnp.float32) + b_router_expert.astype(jnp.float32)).reshape(T, N_GROUPS, EXPERTS_PER_GROUP)
    e_prob = jax.nn.softmax(e_logits[tok, g_sel], axis=-1)
    top_p, top_i = lax.top_k(e_prob, TOP_K)
    top_p = top_p / jnp.sum(top_p, axis=-1, keepdims=True)
    combine = g_w * top_p
    expert_id = g_sel[:, None] * EXPERTS_PER_GROUP + top_i

    A = T * TOP_K
    flat_e = expert_id.reshape(A)
    flat_tok = jnp.repeat(tok, TOP_K)
    flat_w = combine.reshape(A)
    order = jnp.argsort(flat_e)
    se, stok, sw = flat_e[order], flat_tok[order], flat_w[order]
    counts = jnp.bincount(flat_e, length=N_EXPERTS)
    start = jnp.cumsum(counts) - counts
    padded = (counts + EXPERT_BLOCK - 1) // EXPERT_BLOCK * EXPERT_BLOCK
    pend = jnp.cumsum(padded)
    pstart = pend - padded
    dest = pstart[se] + (jnp.arange(A) - start[se])
    R = A + N_EXPERTS * EXPERT_BLOCK
    n_blk = R // EXPERT_BLOCK
    x_buf = jnp.zeros((R, D), h.dtype).at[dest].set(h[stok])
    tok_buf = jnp.zeros((R,), jnp.int32).at[dest].set(stok.astype(jnp.int32))
    w_buf = jnp.zeros((R,), h.dtype).at[dest].set(sw.astype(h.dtype))
    blk_e = jnp.minimum(jnp.searchsorted(pend, jnp.arange(n_blk) * EXPERT_BLOCK, side='right'), N_EXPERTS - 1)

    def run_block(args):
        xb, e = args
        return (jax.nn.silu(xb @ w_gate[e]) * (xb @ w_up[e])) @ w_down[e]

    y_buf = lax.map(run_block, (x_buf.reshape(n_blk, EXPERT_BLOCK, D), blk_e)).reshape(R, D)
    return jnp.zeros((T, D), h.dtype).at[tok_buf].add(y_buf * w_buf[:, None])


def setup_inputs(seed: int = 0) -> dict:
    key = jax.random.key(seed)
    ks = jax.random.split(key, 20)
    D, L = D_MODEL, DEPTH
    nrm = lambda k, shape, fan_in, s=1.0: (jax.random.normal(k, shape, jnp.float32) * (s * fan_in ** -0.5))
    return {
        "x": jax.random.normal(ks[0], (BATCH, SEQ, D), jnp.float32),
        "c": jax.random.normal(ks[1], (BATCH, D), jnp.float32),
        "w_ada": nrm(ks[2], (L, D, 6 * D), D, 0.5),
        "b_ada": 0.01 * jax.random.normal(ks[3], (L, 6 * D), jnp.float32),
        "norm1_g": 1.0 + 0.05 * jax.random.normal(ks[4], (L, D), jnp.float32),
        "w_in": nrm(ks[5], (L, D, IN_COLS), D),
        "conv_w": nrm(ks[6], (L, CONV_K, CONV_CH), CONV_K),
        "w_conv_out": nrm(ks[7], (L, CONV_CH, D), CONV_CH),
        "w_ret_out": nrm(ks[8], (L, RET_V, D), RET_V),
        "w_o": nrm(ks[9], (L, D, D), D),
        "norm2_g": 1.0 + 0.05 * jax.random.normal(ks[10], (L, D), jnp.float32),
        "w_router_group": nrm(ks[11], (L, D, N_GROUPS), D),
        "b_router_group": 0.01 * jax.random.normal(ks[12], (L, N_GROUPS), jnp.float32),
        "w_router_expert": nrm(ks[13], (L, D, N_EXPERTS), D),
        "b_router_expert": 0.01 * jax.random.normal(ks[14], (L, N_EXPERTS), jnp.float32),
        "w_gate": nrm(ks[15], (L, N_EXPERTS, D, D_EXPERT), D),
        "w_up": nrm(ks[16], (L, N_EXPERTS, D, D_EXPERT), D),
        "w_down": nrm(ks[17], (L, N_EXPERTS, D_EXPERT, D), D_EXPERT),
        "norm_f_g": 1.0 + 0.05 * jax.random.normal(ks[18], (D,), jnp.float32),
    }


def reference(x, c, w_ada, b_ada, norm1_g, w_in, conv_w, w_conv_out, w_ret_out, w_o, norm2_g,
              w_router_group, b_router_group, w_router_expert, b_router_expert,
              w_gate, w_up, w_down, norm_f_g):
    B, S, D = x.shape
    sizes = (CONV_CH, CONV_CH, CONV_CH, RET_QK, RET_QK, RET_V, RET_V, D_MODEL, D_MODEL)
    split_at = tuple(int(s) for s in np.cumsum(sizes)[:-1])
    c_act = jax.nn.silu(c)
    for l in range(DEPTH):
        mod = c_act @ w_ada[l] + b_ada[l]
        sh1, sc1, g1, sh2, sc2, g2 = jnp.split(mod, 6, axis=-1)

        h = modulate(rmsnorm(x, norm1_g[l]), sh1, sc1)
        u = h @ w_in[l]
        cb, cc, cx, q, k, v, rg, gate_a, gate_b = jnp.split(u, split_at, axis=-1)

        y_a = (cb * causal_dwconv(cc * cx, conv_w[l])) @ w_conv_out[l]

        qh = rotary(q.reshape(B, S, RET_HEADS, RET_DK).transpose(0, 2, 1, 3))
        kh = rotary(k.reshape(B, S, RET_HEADS, RET_DK).transpose(0, 2, 1, 3)) * (RET_DK ** -0.5)
        vh = v.reshape(B, S, RET_HEADS, RET_DV).transpose(0, 2, 1, 3)
        ret = retention_chunkwise(qh, kh, vh)
        rf = ret.astype(jnp.float32)
        rf = rf * lax.rsqrt(jnp.mean(rf * rf, axis=-1, keepdims=True) + EPS)
        ret = rf.astype(x.dtype).transpose(0, 2, 1, 3).reshape(B, S, RET_V)
        y_b = (jax.nn.silu(rg) * ret) @ w_ret_out[l]

        merged = jax.nn.sigmoid(gate_a) * y_a + jax.nn.sigmoid(gate_b) * y_b
        x = x + g1[:, None, :] * (merged @ w_o[l])

        h2 = modulate(rmsnorm(x, norm2_g[l]), sh2, sc2).reshape(B * S, D)
        y = hier_moe(h2, w_router_group[l], b_router_group[l], w_router_expert[l], b_router_expert[l],
                     w_gate[l], w_up[l], w_down[l]).reshape(B, S, D)
        x = x + g2[:, None, :] * y
    return rmsnorm(x, norm_f_g)
```

```cpp
#define MK_ONE_LAUNCH 1
#include <hip/hip_runtime.h>
#include <cstdint>
#include <cstdio>

constexpr int D = 2048, NB = 4, SEQ = 2048, T = NB * SEQ;
constexpr int CONV_CH = 1024, RH = 8, DK = 128, DV = 256, RQK = 1024, RV = 2048, CHUNK = 128, NCH = SEQ / CHUNK;
constexpr int NE = 32, DE = 1024, NA = T * 2;
constexpr int INC = 13312, MODC = 6 * D;
constexpr int OFF_CB = 0, OFF_CC = 1024, OFF_CX = 2048, OFF_Q = 3072, OFF_K = 4096, OFF_V = 5120, OFF_RG = 7168, OFF_GA = 9216, OFF_GB = 11264;
constexpr float EPS = 1e-6f;
constexpr int ADA_KS = 16;
#ifndef MOE_MT
#define MOE_MT 256
#endif
constexpr int RPAD = NA + NE * MOE_MT;

constexpr size_t al256(size_t x) { return (x + 255) & ~(size_t)255; }
constexpr size_t WS_CTL = 0, CTL_ZERO_BYTES = 1u << 20;
constexpr size_t WS_ZERO = WS_CTL + (768u << 10);
constexpr size_t WS_MODP = WS_CTL + CTL_ZERO_BYTES;
constexpr size_t WS_MOD = WS_MODP + al256((size_t)ADA_KS * 4 * MODC * 4);
constexpr size_t WS_ROPE = WS_MOD + al256((size_t)4 * MODC * 4);
constexpr size_t WS_WRT = WS_ROPE + al256((size_t)2 * SEQ * 64 * 4);
constexpr size_t WS_WIN = WS_WRT + al256((size_t)2 * 48 * D * 2);
constexpr int K4 = CONV_CH + RV;
constexpr size_t WS_W4 = WS_WIN + al256((size_t)INC * D * 2);
constexpr size_t WS_WO = WS_W4 + al256((size_t)D * K4 * 2);
constexpr size_t WS_WGU = WS_WO + al256((size_t)D * D * 2);
constexpr size_t WS_WD = WS_WGU + al256((size_t)NE * 2 * DE * D * 2);
constexpr size_t WS_H = WS_WD + al256((size_t)NE * D * DE * 2);
constexpr size_t WS_U = WS_H + al256((size_t)T * D * 2);
constexpr size_t WS_KVT = WS_U + al256((size_t)T * INC * 2);
constexpr size_t WS_SPT = WS_KVT + al256((size_t)NB * RH * NCH * DV * DK * 2);
constexpr size_t WS_A4 = WS_SPT + al256((size_t)NB * RH * NCH * DV * DK * 2);
constexpr size_t WS_T1 = WS_A4 + al256((size_t)T * K4 * 2);
constexpr size_t WS_MG = WS_T1 + al256((size_t)T * D * 2);
constexpr size_t WS_X1 = WS_MG + al256((size_t)T * D * 2);
constexpr size_t WS_ROUTE = WS_X1 + al256((size_t)T * D * 4);
constexpr size_t WS_END = WS_ROUTE + al256((size_t)NA * 12) + al256((size_t)NE * T * 4);
constexpr size_t WS_HM = WS_U;
constexpr size_t WS_Y = WS_HM + al256((size_t)RPAD * DE * 2);
constexpr size_t WS_Y2 = WS_Y + al256((size_t)RPAD * D * 2);
static_assert(WS_Y2 + (size_t)128 * 65536 * 2 <= WS_KVT, "HM/Y/Y2 overlay fits inside U");
#ifndef MOE_TAILSPLIT
#define MOE_TAILSPLIT 0
#endif
#ifndef MOE_KSPLIT
#define MOE_KSPLIT 0
#endif
constexpr int CW_CNT = 64;
constexpr int CW_BAR = 4096;

constexpr int RING_OFF = 0, RING_BYTES = 131072;
constexpr int LDSCTL_OFF = RING_BYTES, MISC_OFF = LDSCTL_OFF + 320;
constexpr int LDSTAB_OFF = MISC_OFF + 128;
constexpr int LDS_BYTES = 147456;
constexpr int NWAVES = 8;

#define GAS __attribute__((address_space(1)))
#define LAS __attribute__((address_space(3)))
typedef unsigned short bf16;
typedef unsigned v4u __attribute__((ext_vector_type(4)));
typedef unsigned v2u __attribute__((ext_vector_type(2)));
typedef float f32x4 __attribute__((ext_vector_type(4)));
typedef short bf16x8 __attribute__((ext_vector_type(8)));
typedef short bf16x4 __attribute__((ext_vector_type(4)));
typedef GAS unsigned gu32;
#define RLX_AGENT __ATOMIC_RELAXED, __HIP_MEMORY_SCOPE_AGENT
#define LDS_WAIT() asm volatile("s_waitcnt lgkmcnt(0)" ::: "memory")
#define VM_WAIT() asm volatile("s_waitcnt vmcnt(0)" ::: "memory")
__device__ __forceinline__ unsigned f2bf(float f) { unsigned u = __builtin_bit_cast(unsigned, f); return (u + 0x7fffu + ((u >> 16) & 1u)) >> 16; }
__device__ __forceinline__ unsigned pk2(float lo, float hi) { return f2bf(lo) | (f2bf(hi) << 16); }
__device__ __forceinline__ float bf2f(unsigned short b) { return __builtin_bit_cast(float, (unsigned)b << 16); }
__device__ __forceinline__ float bflo(unsigned w) { return __builtin_bit_cast(float, w << 16); }
__device__ __forceinline__ float bfhi(unsigned w) { return __builtin_bit_cast(float, w & 0xffff0000u); }
__device__ __forceinline__ float silu_f(float v) { return v * __builtin_amdgcn_rcpf(1.f + __expf(-v)); }
__device__ __forceinline__ float sigm_f(float v) { return __builtin_amdgcn_rcpf(1.f + __expf(-v)); }
__device__ __forceinline__ float wave_sum(float v) {
#pragma unroll
    for (int o = 1; o < 64; o <<= 1) v += __shfl_xor(v, o);
    return v;
}

#define XB_TMO      128
#define XB_XCNT(j)  (256  + 64 * (j))
#define XB_XSUB(j)  (1280 + 64 * (j))
#define XB_XGEN(j)  (2304 + 64 * (j))
#define XB_TOP      3328
#define XB_TOPGEN   3392
#define XCD_BAR_WORDS 3456
#define XB_SPIN_CAP (1u << 18)
__device__ __forceinline__ unsigned xb_ld(unsigned* p)              { return __hip_atomic_load(p, __ATOMIC_RELAXED, __HIP_MEMORY_SCOPE_AGENT); }
__device__ __forceinline__ unsigned xb_add(unsigned* p, unsigned v) { return __hip_atomic_fetch_add(p, v, __ATOMIC_RELAXED, __HIP_MEMORY_SCOPE_AGENT); }
__device__ __forceinline__ unsigned xb_xcc_id() { return (unsigned)__builtin_amdgcn_s_getreg((3 << 11) | 20) & 0xFu; }
#define XB_SPIN(cond, bar) do { unsigned _sp = 0; while (cond) { __builtin_amdgcn_s_sleep(1); \
    if ((++_sp & 255u) == 0u) { if (xb_ld(&(bar)[XB_TMO])) break; if (_sp > XB_SPIN_CAP) { atomicAdd(&(bar)[XB_TMO], 1u); break; } } } } while (0)
struct XcdBarrier { unsigned* bar; unsigned x; volatile LAS unsigned* st; };
__device__ __forceinline__ XcdBarrier xcd_barrier_post(unsigned* bar, volatile LAS unsigned* st) {
    XcdBarrier b; b.bar = bar; b.x = xb_xcc_id(); b.st = st;
    if (threadIdx.x == 0) (void)xb_add(&bar[XB_XCNT(b.x)], 1u);
    return b;
}
__device__ __forceinline__ void xcd_barrier_complete(unsigned* bar, unsigned x, unsigned& nloc, unsigned& nx) {
    const unsigned G = gridDim.x * gridDim.y * gridDim.z;
    unsigned sum, cnt, mine, sp = 0u;
    for (;;) {
        sum = 0u; cnt = 0u; mine = 0u;
#pragma unroll
        for (unsigned j = 0; j < 16; ++j) { const unsigned c = xb_ld(&bar[XB_XCNT(j)]); sum += c; cnt += (c > 0u) ? 1u : 0u; mine = (j == x) ? c : mine; }
        if (sum == G) break;
        __builtin_amdgcn_s_sleep(1);
        if ((++sp & 255u) == 0u) { if (xb_ld(&bar[XB_TMO])) break; if (sp > XB_SPIN_CAP) { atomicAdd(&bar[XB_TMO], 1u); break; } }
    }
    nloc = mine > 0u ? mine : 1u; nx = cnt > 0u ? cnt : 1u;
}
__device__ __forceinline__ int lane_id() { return (int)__builtin_amdgcn_mbcnt_hi(~0u, __builtin_amdgcn_mbcnt_lo(~0u, 0u)); }
__device__ __forceinline__ void xcd_barrier(const XcdBarrier& b, const bool t0) {
    asm volatile("s_waitcnt vmcnt(0)" ::: "memory");
    __syncthreads();
    if (t0) {
        unsigned* bar = b.bar;
        __builtin_amdgcn_s_waitcnt(0);
        unsigned nloc = b.st[0], nx = b.st[1];
        if (nloc == 0u) { xcd_barrier_complete(bar, b.x, nloc, nx); b.st[0] = nloc; b.st[1] = nx; }
        const unsigned old = xb_add(&bar[XB_XSUB(b.x)], 1u);
        const unsigned gen = old / nloc;
        if (old + 1u == (gen + 1u) * nloc) {
            __builtin_amdgcn_fence(__ATOMIC_RELEASE, "agent");
            asm volatile("s_waitcnt vmcnt(0)" ::: "memory");
            const unsigned og = xb_add(&bar[XB_TOP], 1u);
            const unsigned tg = og / nx;
            if (og + 1u == (tg + 1u) * nx) xb_add(&bar[XB_TOPGEN], 1u);
            else XB_SPIN(xb_ld(&bar[XB_TOPGEN]) == tg, bar);
            __builtin_amdgcn_fence(__ATOMIC_ACQUIRE, "agent");
            xb_add(&bar[XB_XGEN(b.x)], 1u);
            asm volatile("s_waitcnt vmcnt(0)" ::: "memory");
        } else {
            XB_SPIN(xb_ld(&bar[XB_XGEN(b.x)]) == gen, bar);
            __builtin_amdgcn_fence(__ATOMIC_ACQUIRE, "agent");
            asm volatile("s_waitcnt vmcnt(0)" ::: "memory");
        }
    }
    __syncthreads();
}
namespace pg8 {
#define PG8_LAS __attribute__((address_space(3)))
typedef unsigned short bf16_t;
typedef short bf16x8 __attribute__((ext_vector_type(8)));
typedef float f32x4 __attribute__((ext_vector_type(4)));
typedef float f32x2 __attribute__((ext_vector_type(2)));
typedef unsigned u32x4 __attribute__((ext_vector_type(4)));
typedef unsigned u32x2 __attribute__((ext_vector_type(2)));
constexpr int BM = 256, BK = 64, HALF = 128, HTB = HALF * BK * 2  , STAGE_BYTES = 8 * HTB, NXCD = 8, WGM = 8;

__host__ __device__ __forceinline__ int lds_byte(int r, int c) { const int st = (r >> 4) * 2 + (c >> 5), rr = r & 15, cc = c & 31, ob = rr * 64 + cc * 2; return st * 1024 + (ob ^ (((ob >> 9) & 1) << 5)); }
__host__ __device__ __forceinline__ void stage_rc(int b, int& R, int& C) { const int st = b / 1024, sb = b % 1024, swz = sb ^ (((sb >> 9) & 1) << 5); R = (st >> 1) * 16 + swz / 64; C = (st & 1) * 32 + (swz % 64) / 2; }
__host__ __device__ __forceinline__ int perm32(int rho) { const int n = rho >> 4, i = rho & 15; return 8 * (i >> 2) + 4 * n + (i & 3); }

#ifndef PG8_HALF_TAIL
#define PG8_HALF_TAIL 0
#endif
struct Unit { int pm, pn, e, row0, half; };

struct StaticOrder {
    const bf16_t* A; const bf16_t* Bt; int nM, nN, nwg, G, c, tail = 0; static constexpr int ldb = 0;
    __device__ void init(const bf16_t* A_, const bf16_t* Bt_, int M, int N, int G_, int c_) { A = A_; Bt = Bt_; nM = M / BM; nN = N / BM; nwg = nM * nN; G = G_; c = c_; }
    __device__ bool next(int i, Unit& u) const {
        long L = (long)i * G + c; u.half = 0;
        { const int full = nwg / G, rem = nwg - full * G; const bool halved = PG8_HALF_TAIL && rem > 0 && 2 * rem <= G;
          if (tail) { if (!halved || i > 0 || c >= 2 * rem) return false; L = (long)full * G + (c >> 1); u.half = 1 + (c & 1); }
          else if (halved && i >= full) return false; }
        if (L >= nwg) return false;
        int wgid = (int)L; { const int q = nwg / NXCD, r = nwg % NXCD, xcd = wgid % NXCD, off = wgid / NXCD; wgid = (xcd < r ? xcd * (q + 1) : r * (q + 1) + (xcd - r) * q) + off; }
        const int nig = WGM * nN, gid = wgid / nig, fm = gid * WGM, gsz = (nM - fm) < WGM ? (nM - fm) : WGM;
        u.pm = fm + ((wgid % nig) % gsz); u.pn = (wgid % nig) / gsz; u.e = 0; u.row0 = u.pm * BM; return true;
    }
    __device__ __forceinline__ const char* a_tile(const Unit& u, size_t tstep) const { return (const char*)A + (size_t)u.pm * tstep; }
    __device__ __forceinline__ const char* b_tile(const Unit& u, size_t tstep) const { return (const char*)Bt + (size_t)u.pn * tstep + (u.half == 2 ? tstep / 2 : 0); }
    __device__ __forceinline__ void a_offsets(const Unit&, const int (&)[2], const int (&)[2], int, unsigned (&)[2][2]) const {}
};

__device__ __forceinline__ unsigned cvt_pk_bf16(float lo, float hi) { unsigned r; asm volatile("v_cvt_pk_bf16_f32 %0, %1, %2" : "=v"(r) : "v"(lo), "v"(hi)); return r; }

typedef short s16x4 __attribute__((ext_vector_type(4)));
struct NoSide { static constexpr bool ON = false; __device__ __forceinline__ void load(f32x4 (&)[2][2]) {} template <int N> __device__ __forceinline__ void store(f32x4 (&)[2][2]) {} };
template <class Epi, class Sched, bool ALIGN_EPI, bool GATHER, bool BKN = false, class Side = NoSide, bool HALFN = false, bool MIDHOOK = false>
__device__ __forceinline__ void gemm_phase(PG8_LAS unsigned char* lds, const int K, const Sched& S, const Epi& E, Side* side = nullptr) {
    const int tid = threadIdx.x, wid = __builtin_amdgcn_readfirstlane(tid >> 6), lane = tid & 63, wr = wid >> 2, wc = wid & 3, fr = lane & 15, fq = lane >> 4;
    const int nt = K / BK;
    unsigned voffA[2], voffB[2]; int stR[2], stC[2];
#pragma unroll
    for (int i = 0; i < 2; ++i) { int R, C; stage_rc(tid * 16 + i * 8192, R, C); const int Rb = Epi::PERM ? ((R & ~31) + perm32(R & 31)) : R;
        voffA[i] = (unsigned)(R * K + C) * 2u; voffB[i] = (unsigned)(Rb * K + C) * 2u; stR[i] = R; stC[i] = C;
        if constexpr (BKN) { const int b = tid * 16 + i * 8192, kk = b >> 8, chp = (b & 255) >> 4, ch = chp ^ (((kk & 3) << 2) | ((kk >> 2) & 3)); voffB[i] = (unsigned)(kk * S.ldb + 8 * ch) * 2u; } }
    const size_t kstep = (size_t)(BK * 2);
    const size_t hstep = (size_t)HALF * K * 2;
    const size_t tstep = 2 * hstep;
    const size_t kstepB = BKN ? (size_t)BK * S.ldb * 2 : kstep, hstepB = BKN ? (size_t)(HALF * 2) : hstep;
    const unsigned ldsw = (unsigned)wid * 1024u;
    const int aoff = lds_byte(wr * 64 + fr, fq * 8), boff = lds_byte(wc * 32 + fr, fq * 8);
    unsigned tb[2][2] = {{0u, 0u}, {0u, 0u}};
    if constexpr (BKN) { const int q = fr >> 2, p = lane & 3;
#pragma unroll
        for (int n = 0; n < 2; ++n)
#pragma unroll
            for (int t = 0; t < 2; ++t) { const int row = 8 * fq + 4 * t + q, ch = 2 * (2 * wc + n) + (p >> 1);
                tb[n][t] = (unsigned)(uintptr_t)lds + 4u * HTB + (unsigned)(256 * row + 16 * (ch ^ (((row & 3) << 2) | ((row >> 2) & 3))) + 8 * (p & 1)); } }
#define PG8_SA(b, h) (((b) * 2 + (h)) * HTB)
#define PG8_SB(b, h) ((4 + (b) * 2 + (h)) * HTB)
#define PG8_STAGE(bufoff, gbase, voff) do { _Pragma("unroll") for (int _i = 0; _i < 2; ++_i) \
        __builtin_amdgcn_global_load_lds((const unsigned*)((const char*)(gbase) + (voff)[_i]), (PG8_LAS unsigned*)(lds + (bufoff) + ldsw + _i * 8192), 16, 0, 0); } while (0)
#define PG8_STAGE_A(bufoff, gbase, h, VO) do { if constexpr (GATHER) { PG8_STAGE(bufoff, gbase, VO[h]); } else { PG8_STAGE(bufoff, (gbase) + (h) * hstep, voffA); } } while (0)
#define PG8_LDA(dst, b, h) do { _Pragma("unroll") for (int m = 0; m < 4; ++m) _Pragma("unroll") for (int k = 0; k < 2; ++k) dst[m][k] = *(const PG8_LAS bf16x8*)(lds + PG8_SA(b, h) + aoff + m * 2048 + k * 1024); } while (0)
#define PG8_TR(dst, vb, off) asm volatile("ds_read_b64_tr_b16 %0, %1 offset:%c2" : "=&v"(dst) : "v"(vb), "i"(off) : "memory")
#define PG8_LDB(dst, b, h) do { if constexpr (BKN) { _Pragma("unroll") for (int n = 0; n < 2; ++n) _Pragma("unroll") for (int k = 0; k < 2; ++k) { s16x4 _lo, _hi; \
            PG8_TR(_lo, tb[n][0], ((b) * 2 + (h)) * HTB + k * 8192); PG8_TR(_hi, tb[n][1], ((b) * 2 + (h)) * HTB + k * 8192); dst##L[n][k] = _lo; dst##H[n][k] = _hi; } } \
        else { _Pragma("unroll") for (int n = 0; n < 2; ++n) _Pragma("unroll") for (int k = 0; k < 2; ++k) dst[n][k] = *(const PG8_LAS bf16x8*)(lds + PG8_SB(b, h) + boff + n * 2048 + k * 1024); } } while (0)
#define PG8_BF(Bt, n, k) (BKN ? (bf16x8){Bt##L[n][k][0], Bt##L[n][k][1], Bt##L[n][k][2], Bt##L[n][k][3], Bt##H[n][k][0], Bt##H[n][k][1], Bt##H[n][k][2], Bt##H[n][k][3]} : Bt[n][k])
#define PG8_MMA(ai, bj, At, Bt) do { __builtin_amdgcn_s_setprio(1); _Pragma("unroll") for (int m = 0; m < 4; ++m) _Pragma("unroll") for (int n = 0; n < 2; ++n) _Pragma("unroll") for (int k = 0; k < 2; ++k) \
        acc[ai][bj][m][n] = __builtin_amdgcn_mfma_f32_16x16x32_bf16(PG8_BF(Bt, n, k), At[m][k], acc[ai][bj][m][n], 0, 0, 0); __builtin_amdgcn_s_setprio(0); } while (0)
#define PG8_WAIT_V(n) asm volatile("s_waitcnt vmcnt(" #n ")" ::: "memory")
#define PG8_WAIT_L(n) asm volatile("s_waitcnt lgkmcnt(" #n ")" ::: "memory")
#define PG8_BAR __builtin_amdgcn_s_barrier()
#define PG8_SCHED __builtin_amdgcn_sched_barrier(0)
#define PG8_TRIP(t) do { \
            const bool last = (t == nt - 2); \
            const char* a1 = cA + (size_t)(t + 1) * kstep; \
            const char* a2 = last ? nA : cA + (size_t)(t + 2) * kstep; const char* b2 = last ? nB : cB + (size_t)(t + 2) * kstepB; \
            const char* a3 = a2 + kstep; const char* b3 = b2 + kstepB; \
            unsigned vo2[2][2]; \
_Pragma("unroll") \
            for (int h = 0; h < 2; ++h) \
_Pragma("unroll") \
                for (int i = 0; i < 2; ++i) vo2[h][i] = last ? nxtVO[h][i] : curVO[h][i]; \
            f32x4 sv[2][2]; \
            if constexpr (Side::ON) { side->load(sv); PG8_SCHED; } \
            PG8_LDB(B0, 0, 0); PG8_LDB(B1, 0, 1); PG8_SCHED; PG8_LDA(At, 0, 0); PG8_STAGE_A(PG8_SA(1, 1), a1, 1, curVO); \
            if constexpr (Side::ON) PG8_WAIT_V(14); else PG8_WAIT_V(8); \
            PG8_WAIT_L(0); PG8_BAR; PG8_SCHED; PG8_MMA(0, 0, At, B0); if constexpr (!HALFN) PG8_MMA(0, 1, At, B1); PG8_BAR; PG8_SCHED; \
            PG8_LDA(At, 0, 1); PG8_STAGE(PG8_SB(0, 0), b2, voffB); PG8_STAGE(PG8_SB(0, 1), b2 + hstepB, voffB); PG8_STAGE_A(PG8_SA(0, 0), a2, 0, vo2); \
            if constexpr (Side::ON) PG8_WAIT_V(14); else PG8_WAIT_V(8); \
            PG8_WAIT_L(0); PG8_BAR; PG8_SCHED; PG8_MMA(1, 0, At, B0); if constexpr (!HALFN) PG8_MMA(1, 1, At, B1); PG8_BAR; PG8_SCHED; \
            PG8_LDB(B0, 1, 0); PG8_LDB(B1, 1, 1); PG8_SCHED; PG8_LDA(At, 1, 0); PG8_STAGE_A(PG8_SA(0, 1), a2, 1, vo2); \
            PG8_WAIT_V(8); PG8_WAIT_L(0); PG8_BAR; PG8_SCHED; PG8_MMA(0, 0, At, B0); if constexpr (!HALFN) PG8_MMA(0, 1, At, B1); PG8_BAR; PG8_SCHED; \
            PG8_LDA(At, 1, 1); PG8_STAGE(PG8_SB(1, 0), b3, voffB); PG8_STAGE(PG8_SB(1, 1), b3 + hstepB, voffB); PG8_STAGE_A(PG8_SA(1, 0), a3, 0, vo2); \
            PG8_WAIT_V(8); PG8_WAIT_L(0); PG8_BAR; PG8_SCHED; PG8_MMA(1, 0, At, B0); if constexpr (!HALFN) PG8_MMA(1, 1, At, B1); PG8_BAR; PG8_SCHED; \
            if constexpr (Side::ON) { side->template store<16>(sv); PG8_SCHED; } \
        } while (0)
    Unit cur, nxt; int ui = 0;
    if (!S.next(0, cur)) return;
    f32x4 acc[2][2][4][2];
#pragma unroll
    for (int a = 0; a < 2; ++a)
#pragma unroll
        for (int b = 0; b < 2; ++b)
#pragma unroll
            for (int m = 0; m < 4; ++m)
#pragma unroll
                for (int n = 0; n < 2; ++n) acc[a][b][m][n] = (f32x4){0.f, 0.f, 0.f, 0.f};
    bf16x8 At[4][2], B0[2][2], B1[2][2]; s16x4 B0L[2][2], B0H[2][2], B1L[2][2], B1H[2][2];
    unsigned curVO[2][2] = {{0u, 0u}, {0u, 0u}}, nxtVO[2][2] = {{0u, 0u}, {0u, 0u}};
    const char* cA = S.a_tile(cur, tstep); const char* cB = S.b_tile(cur, tstep);
    if constexpr (GATHER) S.a_offsets(cur, stR, stC, K, curVO);
    PG8_STAGE(PG8_SB(0, 0), cB, voffB); PG8_STAGE(PG8_SB(0, 1), cB + hstepB, voffB); PG8_STAGE_A(PG8_SA(0, 0), cA, 0, curVO); PG8_STAGE_A(PG8_SA(0, 1), cA, 1, curVO);
    if (wr == 1) PG8_BAR;
    PG8_WAIT_V(2); PG8_BAR;
    PG8_STAGE(PG8_SB(1, 0), cB + kstepB, voffB); PG8_STAGE_A(PG8_SA(1, 0), cA + kstep, 0, curVO); PG8_STAGE(PG8_SB(1, 1), cB + hstepB + kstepB, voffB);
    PG8_WAIT_V(6); PG8_BAR;
    for (;;) {
        const bool has_next = S.next(ui + 1, nxt);
        const char* nA = has_next ? S.a_tile(nxt, tstep) : cA; const char* nB = has_next ? S.b_tile(nxt, tstep) : cB;
        if constexpr (GATHER) { if (has_next) S.a_offsets(nxt, stR, stC, K, nxtVO); else {
#pragma unroll
            for (int h = 0; h < 2; ++h)
#pragma unroll
                for (int i = 0; i < 2; ++i) nxtVO[h][i] = curVO[h][i]; } }
        if constexpr (MIDHOOK) {
            for (int t = 0; t < Epi::MID_T; t += 2) PG8_TRIP(t);
            E.mid(acc, cur, wr, wc, fr, fq); PG8_SCHED;
            for (int t = Epi::MID_T; t < nt; t += 2) PG8_TRIP(t);
        } else { for (int t = 0; t < nt; t += 2) PG8_TRIP(t); }
        if constexpr (ALIGN_EPI) { if (wr == 0) PG8_BAR; }
        E(acc, cur, wr, wc, fr, fq);
        if (!has_next) break;
#pragma unroll
        for (int a = 0; a < 2; ++a)
#pragma unroll
            for (int b = 0; b < 2; ++b)
#pragma unroll
                for (int m = 0; m < 4; ++m)
#pragma unroll
                    for (int n = 0; n < 2; ++n) acc[a][b][m][n] = (f32x4){0.f, 0.f, 0.f, 0.f};
        cur = nxt; cA = nA; cB = nB; ++ui;
        if constexpr (GATHER) {
#pragma unroll
            for (int h = 0; h < 2; ++h)
#pragma unroll
                for (int i = 0; i < 2; ++i) curVO[h][i] = nxtVO[h][i]; }
        if constexpr (ALIGN_EPI) { if (wr == 1) PG8_BAR; }
    }
    PG8_WAIT_V(0);
    if constexpr (!ALIGN_EPI) { if (wr == 0) PG8_BAR; }
    PG8_BAR;
#undef PG8_TRIP
#undef PG8_SA
#undef PG8_SB
#undef PG8_STAGE
#undef PG8_STAGE_A
#undef PG8_LDA
#undef PG8_LDB
#undef PG8_TR
#undef PG8_BF
#undef PG8_MMA
#undef PG8_WAIT_V
#undef PG8_WAIT_L
#undef PG8_BAR
#undef PG8_SCHED
}
}
using pg8::Unit; using pg8::u32x4; using pg8::cvt_pk_bf16;
struct EpiBf16 {
    static constexpr bool PERM = true; bf16* O; int ldc;
    __device__ __forceinline__ void operator()(const f32x4 (&acc)[2][2][4][2], const Unit& u, int wr, int wc, int fr, int fq) const {
        const int row0 = u.row0 + wr * 64 + fr, col0 = u.pn * 256 + wc * 32 + 8 * fq;
#pragma unroll
        for (int ai = 0; ai < 2; ++ai)
#pragma unroll
            for (int m = 0; m < 4; ++m) { bf16* rowp = O + (size_t)(row0 + ai * 128 + m * 16) * ldc + col0;
#pragma unroll
                for (int bj = 0; bj < 2; ++bj) { const f32x4 v0 = acc[ai][bj][m][0], v1 = acc[ai][bj][m][1];
                    u32x4 w; w.x = cvt_pk_bf16(v0[0], v0[1]); w.y = cvt_pk_bf16(v0[2], v0[3]); w.z = cvt_pk_bf16(v1[0], v1[1]); w.w = cvt_pk_bf16(v1[2], v1[3]);
                    *(u32x4*)(rowp + bj * 128) = w; } }
    }
};

__device__ __forceinline__ void unpack8(const v4u w, float (&f)[8]) { f[0] = bflo(w.x); f[1] = bfhi(w.x); f[2] = bflo(w.y); f[3] = bfhi(w.y); f[4] = bflo(w.z); f[5] = bfhi(w.z); f[6] = bflo(w.w); f[7] = bfhi(w.w); }
struct EpiBf16H {
    static constexpr bool PERM = true; bf16* O; int ldc;
    __device__ __forceinline__ void operator()(const f32x4 (&acc)[2][2][4][2], const Unit& u, int wr, int wc, int fr, int fq) const {
        const int row0 = u.row0 + wr * 64 + fr, col0 = u.pn * 256 + (u.half == 2 ? 128 : 0) + wc * 32 + 8 * fq;
#pragma unroll
        for (int ai = 0; ai < 2; ++ai)
#pragma unroll
            for (int m = 0; m < 4; ++m) { const f32x4 v0 = acc[ai][0][m][0], v1 = acc[ai][0][m][1];
                u32x4 w; w.x = cvt_pk_bf16(v0[0], v0[1]); w.y = cvt_pk_bf16(v0[2], v0[3]); w.z = cvt_pk_bf16(v1[0], v1[1]); w.w = cvt_pk_bf16(v1[2], v1[3]);
                *(u32x4*)(O + (size_t)(row0 + ai * 128 + m * 16) * ldc + col0) = w; }
    }
};

struct EpiT1 {
    static constexpr bool PERM = true; const bf16* U; bf16* T1;
    __device__ __forceinline__ void operator()(const f32x4 (&acc)[2][2][4][2], const Unit& u, int wr, int wc, int fr, int fq) const {
        const int row0 = u.row0 + wr * 64 + fr, col0 = u.pn * 256 + wc * 32 + 8 * fq;
#pragma unroll
        for (int ai = 0; ai < 2; ++ai)
#pragma unroll
            for (int m = 0; m < 4; ++m) { const size_t r = (size_t)(row0 + ai * 128 + m * 16);
#pragma unroll
                for (int bj = 0; bj < 2; ++bj) { const int c = col0 + bj * 128; float ga[8]; unpack8(*(const v4u*)(U + r * INC + OFF_GA + c), ga);
                    const f32x4 v0 = acc[ai][bj][m][0], v1 = acc[ai][bj][m][1];
                    u32x4 w; w.x = cvt_pk_bf16(sigm_f(ga[0]) * v0[0], sigm_f(ga[1]) * v0[1]); w.y = cvt_pk_bf16(sigm_f(ga[2]) * v0[2], sigm_f(ga[3]) * v0[3]);
                    w.z = cvt_pk_bf16(sigm_f(ga[4]) * v1[0], sigm_f(ga[5]) * v1[1]); w.w = cvt_pk_bf16(sigm_f(ga[6]) * v1[2], sigm_f(ga[7]) * v1[3]);
                    *(u32x4*)(T1 + r * D + c) = w; } }
    }
};
struct EpiMG {
    static constexpr bool PERM = true; const bf16* U; const bf16* T1; bf16* MG;
    __device__ __forceinline__ void operator()(const f32x4 (&acc)[2][2][4][2], const Unit& u, int wr, int wc, int fr, int fq) const {
        const int row0 = u.row0 + wr * 64 + fr, col0 = u.pn * 256 + wc * 32 + 8 * fq;
#pragma unroll
        for (int ai = 0; ai < 2; ++ai)
#pragma unroll
            for (int m = 0; m < 4; ++m) { const size_t r = (size_t)(row0 + ai * 128 + m * 16);
#pragma unroll
                for (int bj = 0; bj < 2; ++bj) { const int c = col0 + bj * 128; float gb[8], t1[8]; unpack8(*(const v4u*)(U + r * INC + OFF_GB + c), gb); unpack8(*(const v4u*)(T1 + r * D + c), t1);
                    const f32x4 v0 = acc[ai][bj][m][0], v1 = acc[ai][bj][m][1];
                    u32x4 w; w.x = cvt_pk_bf16(t1[0] + sigm_f(gb[0]) * v0[0], t1[1] + sigm_f(gb[1]) * v0[1]); w.y = cvt_pk_bf16(t1[2] + sigm_f(gb[2]) * v0[2], t1[3] + sigm_f(gb[3]) * v0[3]);
                    w.z = cvt_pk_bf16(t1[4] + sigm_f(gb[4]) * v1[0], t1[5] + sigm_f(gb[5]) * v1[1]); w.w = cvt_pk_bf16(t1[6] + sigm_f(gb[6]) * v1[2], t1[7] + sigm_f(gb[7]) * v1[3]);
                    *(u32x4*)(MG + r * D + c) = w; } }
    }
};
struct EpiMG2 {
    static constexpr bool PERM = true; static constexpr int MID_T = CONV_CH / 64; const bf16* U; bf16* MG;
    __device__ __forceinline__ void mid(f32x4 (&acc)[2][2][4][2], const Unit& u, int wr, int wc, int fr, int fq) const {
        const unsigned vb0 = (unsigned)(((size_t)(u.row0 + wr * 64 + fr) * INC + (size_t)(u.pn * 256 + wc * 32 + 8 * fq)) * 2);
#pragma unroll
        for (int ai = 0; ai < 2; ++ai)
#pragma unroll
            for (int mp = 0; mp < 2; ++mp) {
                v4u va[2][2], vb[2][2];
#pragma unroll
                for (int mm = 0; mm < 2; ++mm)
#pragma unroll
                    for (int bj = 0; bj < 2; ++bj) { const unsigned off = vb0 + (unsigned)((((ai * 128 + (mp * 2 + mm) * 16) * INC) + bj * 128) * 2);
                        asm volatile("global_load_dwordx4 %0, %1, %2" : "=&v"(va[mm][bj]) : "v"(off + (unsigned)(OFF_GA * 2)), "s"(U) : "memory");
                        asm volatile("global_load_dwordx4 %0, %1, %2" : "=&v"(vb[mm][bj]) : "v"(off + (unsigned)(OFF_GB * 2)), "s"(U) : "memory"); }
                asm volatile("s_waitcnt vmcnt(0)" : "+v"(va[0][0]), "+v"(va[0][1]), "+v"(va[1][0]), "+v"(va[1][1]), "+v"(vb[0][0]), "+v"(vb[0][1]), "+v"(vb[1][0]), "+v"(vb[1][1]) :: "memory");
#pragma unroll
                for (int mm = 0; mm < 2; ++mm)
#pragma unroll
                    for (int bj = 0; bj < 2; ++bj) { const int m = mp * 2 + mm;
                        const unsigned wa[4] = {va[mm][bj].x, va[mm][bj].y, va[mm][bj].z, va[mm][bj].w}, wb[4] = {vb[mm][bj].x, vb[mm][bj].y, vb[mm][bj].z, vb[mm][bj].w};
#pragma unroll
                        for (int i = 0; i < 2; ++i) {
                            acc[ai][bj][m][0][2 * i] *= (1.f + __expf(-bflo(wb[i]))) * __builtin_amdgcn_rcpf(1.f + __expf(-bflo(wa[i])));
                            acc[ai][bj][m][0][2 * i + 1] *= (1.f + __expf(-bfhi(wb[i]))) * __builtin_amdgcn_rcpf(1.f + __expf(-bfhi(wa[i])));
                            acc[ai][bj][m][1][2 * i] *= (1.f + __expf(-bflo(wb[2 + i]))) * __builtin_amdgcn_rcpf(1.f + __expf(-bflo(wa[2 + i])));
                            acc[ai][bj][m][1][2 * i + 1] *= (1.f + __expf(-bfhi(wb[2 + i]))) * __builtin_amdgcn_rcpf(1.f + __expf(-bfhi(wa[2 + i]))); }
                        asm volatile("" : "+v"(acc[ai][bj][m][0]), "+v"(acc[ai][bj][m][1]) :: "memory"); }
                __builtin_amdgcn_sched_barrier(0); }
    }
    __device__ __forceinline__ void operator()(const f32x4 (&acc)[2][2][4][2], const Unit& u, int wr, int wc, int fr, int fq) const {
        const int row0 = u.row0 + wr * 64 + fr, col0 = u.pn * 256 + wc * 32 + 8 * fq;
        v4u gt[2][4][2];
#pragma unroll
        for (int ai = 0; ai < 2; ++ai)
#pragma unroll
            for (int m = 0; m < 4; ++m)
#pragma unroll
                for (int bj = 0; bj < 2; ++bj) gt[ai][m][bj] = *(const v4u*)(U + (size_t)(row0 + ai * 128 + m * 16) * INC + OFF_GB + col0 + bj * 128);
#pragma unroll
        for (int ai = 0; ai < 2; ++ai)
#pragma unroll
            for (int m = 0; m < 4; ++m) { const size_t r = (size_t)(row0 + ai * 128 + m * 16);
#pragma unroll
                for (int bj = 0; bj < 2; ++bj) { const int c = col0 + bj * 128; float gb[8]; unpack8(gt[ai][m][bj], gb);
                    const f32x4 v0 = acc[ai][bj][m][0], v1 = acc[ai][bj][m][1];
                    u32x4 w; w.x = cvt_pk_bf16(sigm_f(gb[0]) * v0[0], sigm_f(gb[1]) * v0[1]); w.y = cvt_pk_bf16(sigm_f(gb[2]) * v0[2], sigm_f(gb[3]) * v0[3]);
                    w.z = cvt_pk_bf16(sigm_f(gb[4]) * v1[0], sigm_f(gb[5]) * v1[1]); w.w = cvt_pk_bf16(sigm_f(gb[6]) * v1[2], sigm_f(gb[7]) * v1[3]);
                    *(u32x4*)(MG + r * D + c) = w; } }
    }
};

struct EpiX1 {
    static constexpr bool PERM = true; const float* X; const float* MOD; float* X1;
    __device__ __forceinline__ void operator()(const f32x4 (&acc)[2][2][4][2], const Unit& u, int wr, int wc, int fr, int fq) const {
        const int row0 = u.row0 + wr * 64 + fr, col0 = u.pn * 256 + wc * 32 + 8 * fq; const int b = u.row0 / SEQ;
        f32x4 gv[2][2];
#pragma unroll
        for (int bj = 0; bj < 2; ++bj)
#pragma unroll
            for (int n = 0; n < 2; ++n) gv[bj][n] = *(const f32x4*)(MOD + (size_t)b * MODC + 2 * D + col0 + bj * 128 + 4 * n);
#pragma unroll
        for (int ai = 0; ai < 2; ++ai) {
            f32x4 xv[4][2][2];
#pragma unroll
            for (int m = 0; m < 4; ++m)
#pragma unroll
                for (int bj = 0; bj < 2; ++bj)
#pragma unroll
                    for (int n = 0; n < 2; ++n) xv[m][bj][n] = *(const f32x4*)(X + (size_t)(row0 + ai * 128 + m * 16) * D + col0 + bj * 128 + 4 * n);
#pragma unroll
            for (int m = 0; m < 4; ++m)
#pragma unroll
                for (int bj = 0; bj < 2; ++bj)
#pragma unroll
                    for (int n = 0; n < 2; ++n) *(f32x4*)(X1 + (size_t)(row0 + ai * 128 + m * 16) * D + col0 + bj * 128 + 4 * n) = xv[m][bj][n] + gv[bj][n] * acc[ai][bj][m][n]; }
    }
};

struct Args { const float* in[19]; float* out; unsigned char* ws; int ph_lo, ph_hi; };
enum { I_X = 0, I_C, I_WADA, I_BADA, I_N1G, I_WIN, I_CONVW, I_WCO, I_WRO, I_WO, I_N2G, I_WRG, I_BRG, I_WRE, I_BRE, I_WG, I_WU, I_WD, I_NFG };

__device__ __forceinline__ void transpose_item(const float* W, int ldw, int k0, int n0, bf16* dst, int ldk, LAS float* scr, int lane) {
#pragma unroll 8
    for (int i = 0; i < 32; ++i) { const int kk = 2 * i + (lane >> 5); scr[kk * 33 + (lane & 31)] = W[(size_t)(k0 + kk) * ldw + n0 + (lane & 31)]; }
    LDS_WAIT(); asm volatile("" ::: "memory");
    const int c = lane & 7;
#pragma unroll
    for (int j = 0; j < 4; ++j) { const int n = (lane >> 3) + 8 * j; const LAS float* s = scr + (8 * c) * 33 + n;
        v4u o; o.x = pk2(s[0 * 33], s[1 * 33]); o.y = pk2(s[2 * 33], s[3 * 33]); o.z = pk2(s[4 * 33], s[5 * 33]); o.w = pk2(s[6 * 33], s[7 * 33]);
        *(GAS v4u*)(dst + (size_t)n * ldk + 8 * c) = o; }
    LDS_WAIT(); asm volatile("" ::: "memory");
}
constexpr int I_ADA = (MODC / 256) * ADA_KS;
constexpr int I_WIN_N = (D / 64) * (INC / 32), I_WCO_N = (CONV_CH / 64) * (D / 32), I_WRO_N = (RV / 64) * (D / 32), I_WO_N = (D / 64) * (D / 32);
constexpr int I_GU1 = (D / 64) * (DE / 32), I_DN1 = (DE / 64) * (D / 32), I_EXP1 = 2 * I_GU1 + I_DN1;
#ifndef MOE_E
#define MOE_E 0
#endif
#ifndef SIDE_CVT
#define SIDE_CVT 0
#endif
#ifndef LATE_W4
#define LATE_W4 0
#endif
constexpr int P0_ITEMS = I_ADA + I_WIN_N + (LATE_W4 ? 0 : I_WCO_N + I_WRO_N + I_WO_N);

__device__ __forceinline__ void p0_prologue(const Args& a, LAS unsigned char* lds, int tid, int lane, int wave, int vcu, int G, bool cvt_experts) {
    unsigned char* ws = a.ws;
    LAS float* sc = (LAS float*)(lds + 98304);
    for (int i = tid; i < 4 * D; i += 512) sc[i] = silu_f(a.in[I_C][i]);
    __syncthreads();
    LAS float* scr = (LAS float*)(lds + wave * 12288);
    const int gw = vcu * NWAVES + wave, NGW = G * NWAVES;
    for (int it = gw; it < P0_ITEMS; it += NGW) {
        int r = it;
        if (r < I_ADA) {
            const int cc = r % (MODC / 256), ks = r / (MODC / 256);
            const float* wp = a.in[I_WADA] + (size_t)(ks * 128) * MODC + cc * 256 + lane * 4;
            f32x4 a0 = {0.f, 0.f, 0.f, 0.f}, a1 = a0, a2 = a0, a3 = a0;
#pragma unroll 8
            for (int k = 0; k < 128; ++k) { const f32x4 w = *(const f32x4*)(wp + (size_t)k * MODC); const int kk = ks * 128 + k;
                a0 += sc[kk] * w; a1 += sc[D + kk] * w; a2 += sc[2 * D + kk] * w; a3 += sc[3 * D + kk] * w; }
            float* pp = (float*)(ws + WS_MODP) + (size_t)(ks * 4) * MODC + cc * 256 + lane * 4;
            *(f32x4*)(pp) = a0; *(f32x4*)(pp + MODC) = a1; *(f32x4*)(pp + 2 * MODC) = a2; *(f32x4*)(pp + 3 * MODC) = a3;
            continue;
        }
        r -= I_ADA;
        if (r < I_WIN_N) { const int nblk = INC / 32, kb = r / nblk, nb = r % nblk; transpose_item(a.in[I_WIN], INC, 64 * kb, 32 * nb, (bf16*)(ws + WS_WIN) + (size_t)(32 * nb) * D + 64 * kb, D, scr, lane); continue; } r -= I_WIN_N;
#if !LATE_W4
        if (r < I_WCO_N) { const int nblk = D / 32, kb = r / nblk, nb = r % nblk; transpose_item(a.in[I_WCO], D, 64 * kb, 32 * nb, (bf16*)(ws + WS_W4) + (size_t)(32 * nb) * K4 + 64 * kb, K4, scr, lane); continue; } r -= I_WCO_N;
        if (r < I_WRO_N) { const int nblk = D / 32, kb = r / nblk, nb = r % nblk; transpose_item(a.in[I_WRO], D, 64 * kb, 32 * nb, (bf16*)(ws + WS_W4) + (size_t)(32 * nb) * K4 + CONV_CH + 64 * kb, K4, scr, lane); continue; } r -= I_WRO_N;
        { const int nblk = D / 32, kb = r / nblk, nb = r % nblk; transpose_item(a.in[I_WO], D, 64 * kb, 32 * nb, (bf16*)(ws + WS_WO) + (size_t)(32 * nb) * D + 64 * kb, D, scr, lane); }
#endif
    }
    if (cvt_experts) {
        const size_t NG8 = (size_t)NE * D * DE / 8;
        const size_t gt = (size_t)vcu * 512 + tid, GT = (size_t)G * 512;
        for (size_t it0 = gt; it0 < 3 * NG8; it0 += 4 * GT) {
            f32x4 v0[4], v1[4];
#pragma unroll
            for (int j = 0; j < 4; ++j) { const size_t it = it0 + (size_t)j * GT; if (it < 3 * NG8) { const int which = (int)(it / NG8); const size_t i = (it % NG8) * 8;
                const float* src = a.in[which == 0 ? I_WG : which == 1 ? I_WU : I_WD] + i; v0[j] = __builtin_nontemporal_load((const f32x4*)src); v1[j] = __builtin_nontemporal_load((const f32x4*)(src + 4)); } }
#pragma unroll
            for (int j = 0; j < 4; ++j) { const size_t it = it0 + (size_t)j * GT; if (it < 3 * NG8) { const int which = (int)(it / NG8); const size_t i = (it % NG8) * 8;
                v4u o; o.x = pk2(v0[j].x, v0[j].y); o.y = pk2(v0[j].z, v0[j].w); o.z = pk2(v1[j].x, v1[j].y); o.w = pk2(v1[j].z, v1[j].w);
                if (which == 2) *(v4u*)((bf16*)(ws + WS_WD) + i) = o;
                else { const size_t ek = i / DE; const int n = (int)(i % DE); *(v4u*)((bf16*)(ws + WS_WGU) + ek * (2 * DE) + (n / 128) * 256 + (n % 128) + (which ? 128 : 0)) = o; } } }
        }
    }
    { bf16* wrt = (bf16*)(ws + WS_WRT);
      for (int idx = vcu * 512 + tid; idx < 48 * D; idx += G * 512) { const int o = idx / D, d = idx % D;
          const float w = o < 4 ? a.in[I_WRG][d * 4 + o] : (o < 36 ? a.in[I_WRE][d * 32 + (o - 4)] : 0.f);
          const unsigned hi = f2bf(w); const float r = w - __builtin_bit_cast(float, hi << 16); wrt[idx] = (bf16)hi; wrt[48 * D + idx] = (bf16)f2bf(r); } }
    float* rc = (float*)(ws + WS_ROPE);
    for (int idx = vcu * 512 + tid; idx < SEQ * 64; idx += G * 512) { const int pos = idx >> 6, j = idx & 63;
        const float inv = powf(10000.f, -(float)(2 * j) / 128.f); const float ang = (float)pos * inv; rc[idx] = cosf(ang); rc[SEQ * 64 + idx] = sinf(ang); }
}

__device__ __forceinline__ void late_w4_convert(const Args& a, LAS unsigned char* lds, int lane, int wave, int vcu, int G) {
    unsigned char* ws = a.ws; LAS float* scr = (LAS float*)(lds + wave * 12288);
    const int gw = vcu * NWAVES + wave, NGW = G * NWAVES;
    for (int it = gw; it < I_WCO_N + I_WRO_N + I_WO_N; it += NGW) { int r = it;
        if (r < I_WCO_N) { const int nblk = D / 32, kb = r / nblk, nb = r % nblk; transpose_item(a.in[I_WCO], D, 64 * kb, 32 * nb, (bf16*)(ws + WS_W4) + (size_t)(32 * nb) * K4 + 64 * kb, K4, scr, lane); continue; } r -= I_WCO_N;
        if (r < I_WRO_N) { const int nblk = D / 32, kb = r / nblk, nb = r % nblk; transpose_item(a.in[I_WRO], D, 64 * kb, 32 * nb, (bf16*)(ws + WS_W4) + (size_t)(32 * nb) * K4 + CONV_CH + 64 * kb, K4, scr, lane); continue; } r -= I_WRO_N;
        { const int nblk = D / 32, kb = r / nblk, nb = r % nblk; transpose_item(a.in[I_WO], D, 64 * kb, 32 * nb, (bf16*)(ws + WS_WO) + (size_t)(32 * nb) * D + 64 * kb, D, scr, lane); }
    }
}

__device__ __forceinline__ float mod_value(const Args& a, int b, int j) {
    const float* pp = (const float*)(a.ws + WS_MODP) + (size_t)b * MODC + j; float s = a.in[I_BADA][j];
#pragma unroll
    for (int ks = 0; ks < ADA_KS; ++ks) s += pp[(size_t)ks * 4 * MODC];
    return s;
}
__device__ __forceinline__ void p1_norm(const Args& a, LAS unsigned char* lds, int tid, int lane, int wave, int G) {
    float* MOD = (float*)(a.ws + WS_MOD);
    for (int idx = blockIdx.x * 512 + tid; idx < 4 * MODC; idx += G * 512) MOD[idx] = mod_value(a, idx / MODC, idx % MODC);
    LAS float* tsc = (LAS float*)lds; LAS float* tsh = tsc + D;
    bf16* H = (bf16*)(a.ws + WS_H); const float* g = a.in[I_N1G];
    for (int rb = blockIdx.x; rb < T / 32; rb += G) {
        const int b = (rb * 32) / SEQ;
        __syncthreads();
        for (int d = tid; d < D; d += 512) { tsh[d] = mod_value(a, b, d); tsc[d] = 1.f + mod_value(a, b, D + d); }
        __syncthreads();
        f32x4 gg[8], v[8];
#pragma unroll
        for (int j = 0; j < 8; ++j) { gg[j] = *(const f32x4*)(g + 4 * lane + 256 * j); v[j] = ((const GAS f32x4*)(a.in[I_X] + (size_t)(rb * 32 + wave * 4) * D) + lane)[64 * j]; }
#pragma unroll
        for (int rr = 0; rr < 4; ++rr) {
            const int row = rb * 32 + wave * 4 + rr;
            f32x4 vn[8];
            if (rr < 3) {
#pragma unroll
                for (int j = 0; j < 8; ++j) vn[j] = ((const GAS f32x4*)(a.in[I_X] + (size_t)(row + 1) * D) + lane)[64 * j]; }
            float s = 0.f;
#pragma unroll
            for (int j = 0; j < 8; ++j) s += (v[j].x * v[j].x + v[j].y * v[j].y) + (v[j].z * v[j].z + v[j].w * v[j].w);
            const float rstd = rsqrtf(wave_sum(s) * (1.f / D) + EPS);
            GAS v2u* o8 = (GAS v2u*)(H + (size_t)row * D) + lane;
#pragma unroll
            for (int j = 0; j < 8; ++j) { const int d = 4 * lane + 256 * j; const f32x4 cs = *(const LAS f32x4*)(tsc + d), sh = *(const LAS f32x4*)(tsh + d);
                const f32x4 o = v[j] * rstd * gg[j] * cs + sh; v2u w; w.x = pk2(o.x, o.y); w.y = pk2(o.z, o.w); o8[64 * j] = w; }
            if (rr < 3) {
#pragma unroll
                for (int j = 0; j < 8; ++j) v[j] = vn[j]; }
        }
    }
}

typedef short s16x4 __attribute__((ext_vector_type(4)));
constexpr int RS_K = 288, RS_V = 544;
constexpr int KS_OFF = 0, VS_OFF = 128 * RS_K;
#define TR_READ(dst, vb, off) asm volatile("ds_read_b64_tr_b16 %0, %1 offset:%c2" : "=&v"(dst) : "v"(vb), "i"(off) : "memory")
#define SBAR() __builtin_amdgcn_sched_barrier(0)
#define PK8(L, H) (bf16x8){L[0], L[1], L[2], L[3], H[0], H[1], H[2], H[3]}

__device__ __forceinline__ void p3a_unit(const Args& a, LAS unsigned char* lds, int unit, int tid, int lane, int wave) {
    const int n = unit % NCH, bh = unit / NCH, h = bh % RH, b = bh / RH;
    bf16* U = (bf16*)(a.ws + WS_U); const float* rc = (const float*)(a.ws + WS_ROPE);
    const size_t t0 = (size_t)b * SEQ + (size_t)n * CHUNK;
    const float log_g = log1pf(-exp2f(-5.f - (float)h));
    __syncthreads();
    {
        v4u x1[4], x2[4]; f32x4 c0[4], c1[4], s0[4], s1[4]; v4u vv[8];
#pragma unroll
        for (int it = 0; it < 4; ++it) { const int task = tid + 512 * it; const int isk = task >> 10, r_ = (task >> 3) & 127, c8 = task & 7;
            const bf16* p = U + (t0 + r_) * INC + (isk ? OFF_K : OFF_Q) + h * DK + c8 * 8; x1[it] = *(const v4u*)p; x2[it] = *(const v4u*)(p + 64);
            const float* cp = rc + (size_t)(n * CHUNK + r_) * 64 + c8 * 8; const float* sp = cp + SEQ * 64;
            c0[it] = *(const f32x4*)cp; c1[it] = *(const f32x4*)(cp + 4); s0[it] = *(const f32x4*)sp; s1[it] = *(const f32x4*)(sp + 4); }
#pragma unroll
        for (int it = 0; it < 8; ++it) { const int task = tid + 512 * it; const int r_ = task >> 5, c = task & 31; vv[it] = *(const v4u*)(U + (t0 + r_) * INC + OFF_V + h * DV + c * 8); }
#pragma unroll
        for (int it = 0; it < 4; ++it) { const int task = tid + 512 * it; const int isk = task >> 10, r_ = (task >> 3) & 127, c8 = task & 7;
            bf16* p = U + (t0 + r_) * INC + (isk ? OFF_K : OFF_Q) + h * DK + c8 * 8;
            const float cs[8] = {c0[it].x, c0[it].y, c0[it].z, c0[it].w, c1[it].x, c1[it].y, c1[it].z, c1[it].w}, sn[8] = {s0[it].x, s0[it].y, s0[it].z, s0[it].w, s1[it].x, s1[it].y, s1[it].z, s1[it].w};
            const unsigned w1[4] = {x1[it].x, x1[it].y, x1[it].z, x1[it].w}, w2[4] = {x2[it].x, x2[it].y, x2[it].z, x2[it].w};
            const float sc = isk ? 0.08838834764831845f : 1.f;
            const float kd = isk ? __expf(log_g * (float)(127 - r_)) : 0.f;
            float o1[8], o2[8];
#pragma unroll
            for (int i = 0; i < 4; ++i) {
                const float a0 = bflo(w1[i]), a1 = bfhi(w1[i]), b0 = bflo(w2[i]), b1 = bfhi(w2[i]);
                o1[2 * i] = (a0 * cs[2 * i] - b0 * sn[2 * i]) * sc; o1[2 * i + 1] = (a1 * cs[2 * i + 1] - b1 * sn[2 * i + 1]) * sc;
                o2[2 * i] = (a0 * sn[2 * i] + b0 * cs[2 * i]) * sc; o2[2 * i + 1] = (a1 * sn[2 * i + 1] + b1 * cs[2 * i + 1]) * sc;
            }
            v4u y1, y2; y1.x = pk2(o1[0], o1[1]); y1.y = pk2(o1[2], o1[3]); y1.z = pk2(o1[4], o1[5]); y1.w = pk2(o1[6], o1[7]);
            y2.x = pk2(o2[0], o2[1]); y2.y = pk2(o2[2], o2[3]); y2.z = pk2(o2[4], o2[5]); y2.w = pk2(o2[6], o2[7]);
            *(v4u*)p = y1; *(v4u*)(p + 64) = y2;
            if (isk) {
                v4u z1, z2; z1.x = pk2(o1[0] * kd, o1[1] * kd); z1.y = pk2(o1[2] * kd, o1[3] * kd); z1.z = pk2(o1[4] * kd, o1[5] * kd); z1.w = pk2(o1[6] * kd, o1[7] * kd);
                z2.x = pk2(o2[0] * kd, o2[1] * kd); z2.y = pk2(o2[2] * kd, o2[3] * kd); z2.z = pk2(o2[4] * kd, o2[5] * kd); z2.w = pk2(o2[6] * kd, o2[7] * kd);
                *(LAS v4u*)(lds + KS_OFF + r_ * RS_K + c8 * 16) = z1; *(LAS v4u*)(lds + KS_OFF + r_ * RS_K + 128 + c8 * 16) = z2;
            }
        }
#pragma unroll
        for (int it = 0; it < 8; ++it) { const int task = tid + 512 * it; const int r_ = task >> 5, c = task & 31; *(LAS v4u*)(lds + VS_OFF + r_ * RS_V + c * 16) = vv[it]; }
    }
    __syncthreads();
    const int g = lane >> 4, q = (lane & 15) >> 2, p = lane & 3;
    const unsigned aK = (unsigned)(uintptr_t)(lds + KS_OFF) + (unsigned)((8 * g + q) * RS_K + 8 * p);
    const unsigned aV = (unsigned)(uintptr_t)(lds + VS_OFF) + (unsigned)((8 * g + q) * RS_V + 64 * wave + 8 * p);
    f32x4 acc[8][2];
#pragma unroll
    for (int mt = 0; mt < 8; ++mt) { acc[mt][0] = (f32x4){0.f, 0.f, 0.f, 0.f}; acc[mt][1] = (f32x4){0.f, 0.f, 0.f, 0.f}; }
#pragma unroll
    for (int ks = 0; ks < 4; ++ks) {
        s16x4 al[8], ah[8], bl[2], bhh[2];
#pragma unroll
        for (int mt = 0; mt < 8; ++mt) { TR_READ(al[mt], aK, ks * 32 * RS_K + mt * 32); TR_READ(ah[mt], aK, ks * 32 * RS_K + 4 * RS_K + mt * 32); }
#pragma unroll
        for (int nt = 0; nt < 2; ++nt) { TR_READ(bl[nt], aV, ks * 32 * RS_V + nt * 32); TR_READ(bhh[nt], aV, ks * 32 * RS_V + 4 * RS_V + nt * 32); }
        asm volatile("s_waitcnt lgkmcnt(0)" ::: "memory"); SBAR();
#pragma unroll
        for (int mt = 0; mt < 8; ++mt)
#pragma unroll
            for (int nt = 0; nt < 2; ++nt) acc[mt][nt] = __builtin_amdgcn_mfma_f32_16x16x32_bf16(PK8(al[mt], ah[mt]), PK8(bl[nt], bhh[nt]), acc[mt][nt], 0, 0, 0);
    }
    bf16* KVT = (bf16*)(a.ws + WS_KVT) + (size_t)unit * DV * DK;
#pragma unroll
    for (int mt = 0; mt < 8; ++mt)
#pragma unroll
        for (int nt = 0; nt < 2; ++nt) { const int e = 32 * wave + 16 * nt + (lane & 15), d = 16 * mt + 4 * g;
            v2u w; w.x = pk2(acc[mt][nt][0], acc[mt][nt][1]); w.y = pk2(acc[mt][nt][2], acc[mt][nt][3]); *(v2u*)(KVT + (size_t)e * DK + d) = w; }
}

__device__ __forceinline__ void p3b_scan_conv(const Args& a, int tid, int lane, int wave, int vcu, int G) {
    const bf16* KVT = (const bf16*)(a.ws + WS_KVT); bf16* SPT = (bf16*)(a.ws + WS_SPT);
    for (int idx = blockIdx.x * 512 + tid; idx < NB * RH * DV * DK / 8; idx += G * 512) {
        const int bh = idx / (DV * DK / 8), o8 = (idx % (DV * DK / 8)) * 8, h = bh % RH;
        const float cd = __expf(log1pf(-exp2f(-5.f - (float)h)) * 128.f);
        float s[8];
#pragma unroll
        for (int i = 0; i < 8; ++i) s[i] = 0.f;
        v4u kvv[NCH - 1];
#pragma unroll
        for (int n = 1; n < NCH; ++n) kvv[n - 1] = *(const v4u*)(KVT + ((size_t)(bh * NCH + n - 1)) * DV * DK + o8);
#pragma unroll
        for (int n = 1; n < NCH; ++n) {
            const v4u kv = kvv[n - 1];
            const unsigned w[4] = {kv.x, kv.y, kv.z, kv.w};
#pragma unroll
            for (int i = 0; i < 4; ++i) { s[2 * i] = cd * s[2 * i] + bflo(w[i]); s[2 * i + 1] = cd * s[2 * i + 1] + bfhi(w[i]); }
            v4u o; o.x = pk2(s[0], s[1]); o.y = pk2(s[2], s[3]); o.z = pk2(s[4], s[5]); o.w = pk2(s[6], s[7]);
            *(v4u*)(SPT + ((size_t)(bh * NCH + n)) * DV * DK + o8) = o;
        }
    }
    const bf16* U = (const bf16*)(a.ws + WS_U); bf16* AIN = (bf16*)(a.ws + WS_A4); const float* cw = a.in[I_CONVW];
    const int gw = vcu * NWAVES + wave, NGW = G * NWAVES;
    for (int task = gw; task < (T / 16) * 2; task += NGW) {
        const int tb = task >> 1, ch = (task & 1) * 512 + lane * 8, tr0 = tb * 16;
        float w0[8], w1[8], w2[8];
#pragma unroll
        for (int i = 0; i < 8; ++i) { w0[i] = cw[ch + i]; w1[i] = cw[CONV_CH + ch + i]; w2[i] = cw[2 * CONV_CH + ch + i]; }
        float zm2[8], zm1[8];
        const bool first = (tr0 % SEQ) == 0;
#pragma unroll
        for (int i = 0; i < 8; ++i) { zm2[i] = 0.f; zm1[i] = 0.f; }
        if (!first) {
            const v4u c2 = *(const v4u*)(U + (size_t)(tr0 - 2) * INC + OFF_CC + ch), x2 = *(const v4u*)(U + (size_t)(tr0 - 2) * INC + OFF_CX + ch);
            const v4u c1 = *(const v4u*)(U + (size_t)(tr0 - 1) * INC + OFF_CC + ch), x1 = *(const v4u*)(U + (size_t)(tr0 - 1) * INC + OFF_CX + ch);
            const unsigned a2[4] = {c2.x, c2.y, c2.z, c2.w}, b2[4] = {x2.x, x2.y, x2.z, x2.w}, a1[4] = {c1.x, c1.y, c1.z, c1.w}, b1[4] = {x1.x, x1.y, x1.z, x1.w};
#pragma unroll
            for (int i = 0; i < 4; ++i) { zm2[2 * i] = bflo(a2[i]) * bflo(b2[i]); zm2[2 * i + 1] = bfhi(a2[i]) * bfhi(b2[i]); zm1[2 * i] = bflo(a1[i]) * bflo(b1[i]); zm1[2 * i + 1] = bfhi(a1[i]) * bfhi(b1[i]); }
        }
#pragma unroll 1
        for (int r0 = 0; r0 < 16; r0 += 4) {
            v4u ccv[4], cxv[4], cbv[4];
#pragma unroll
            for (int rr = 0; rr < 4; ++rr) { const size_t row = (size_t)(tr0 + r0 + rr) * INC; ccv[rr] = *(const v4u*)(U + row + OFF_CC + ch); cxv[rr] = *(const v4u*)(U + row + OFF_CX + ch); cbv[rr] = *(const v4u*)(U + row + OFF_CB + ch); }
#pragma unroll
            for (int rr = 0; rr < 4; ++rr) {
                const unsigned ac[4] = {ccv[rr].x, ccv[rr].y, ccv[rr].z, ccv[rr].w}, ax[4] = {cxv[rr].x, cxv[rr].y, cxv[rr].z, cxv[rr].w}, ab[4] = {cbv[rr].x, cbv[rr].y, cbv[rr].z, cbv[rr].w};
                float z[8], o[8];
#pragma unroll
                for (int i = 0; i < 4; ++i) { z[2 * i] = bflo(ac[i]) * bflo(ax[i]); z[2 * i + 1] = bfhi(ac[i]) * bfhi(ax[i]); }
#pragma unroll
                for (int i = 0; i < 8; ++i) o[i] = w0[i] * zm2[i] + w1[i] * zm1[i] + w2[i] * z[i];
#pragma unroll
                for (int i = 0; i < 4; ++i) { o[2 * i] *= bflo(ab[i]); o[2 * i + 1] *= bfhi(ab[i]); }
                v4u ov; ov.x = pk2(o[0], o[1]); ov.y = pk2(o[2], o[3]); ov.z = pk2(o[4], o[5]); ov.w = pk2(o[6], o[7]);
                *(v4u*)(AIN + (size_t)(tr0 + r0 + rr) * K4 + ch) = ov;
#pragma unroll
                for (int i = 0; i < 8; ++i) { zm2[i] = zm1[i]; zm1[i] = z[i]; }
            }
        }
    }
}

__device__ __forceinline__ void p3c_unit(const Args& a, LAS unsigned char* lds, int unit, int tid, int lane, int wave) {
    const int n = unit % NCH, bh = unit / NCH, h = bh % RH, b = bh / RH;
    const bf16* U = (const bf16*)(a.ws + WS_U);
    const size_t t0 = (size_t)b * SEQ + (size_t)n * CHUNK;
    const float log_g = log1pf(-exp2f(-5.f - (float)h));
    __syncthreads();
    const int g = lane >> 4, fr = lane & 15, q = fr >> 2, p = lane & 3;
    const int il = 16 * wave + fr;
    v4u kk[4], spv[8], vv[8]; bf16x8 bq[4];
    const bf16* SP = (const bf16*)(a.ws + WS_SPT) + (size_t)unit * DV * DK;
#pragma unroll
    for (int it = 0; it < 4; ++it) { const int task = tid + 512 * it; const int r_ = task >> 4, c = task & 15; kk[it] = *(const v4u*)(U + (t0 + r_) * INC + OFF_K + h * DK + c * 8); }
    if (n > 0) {
#pragma unroll
        for (int it = 0; it < 8; ++it) { const int task = tid + 512 * it; spv[it] = *(const v4u*)(SP + (size_t)task * 8); }
    }
#pragma unroll
    for (int ks = 0; ks < 4; ++ks) bq[ks] = *(const bf16x8*)(U + (t0 + il) * INC + OFF_Q + h * DK + 32 * ks + 8 * g);
#pragma unroll
    for (int it = 0; it < 4; ++it) { const int task = tid + 512 * it; const int r_ = task >> 4, c = task & 15; *(LAS v4u*)(lds + KS_OFF + r_ * RS_K + c * 16) = kk[it]; }
    f32x4 acc[16];
#pragma unroll
    for (int et = 0; et < 16; ++et) acc[et] = (f32x4){0.f, 0.f, 0.f, 0.f};
    if (n > 0) {
#pragma unroll
        for (int it = 0; it < 8; ++it) { const int task = tid + 512 * it; const int e_ = task >> 4, c = task & 15; *(LAS v4u*)(lds + VS_OFF + e_ * RS_K + c * 16) = spv[it]; }
        __syncthreads();
    }
#pragma unroll
    for (int it = 0; it < 8; ++it) { const int task = tid + 512 * it; const int r_ = task >> 5, c = task & 31; vv[it] = *(const v4u*)(U + (t0 + r_) * INC + OFF_V + h * DV + c * 8); }
    if (n > 0) {
        const LAS unsigned char* sp = lds + VS_OFF + fr * RS_K + 16 * g;
#pragma unroll
        for (int ks = 0; ks < 4; ++ks)
#pragma unroll
            for (int eh = 0; eh < 2; ++eh) {
                bf16x8 as[8];
#pragma unroll
                for (int e8 = 0; e8 < 8; ++e8) as[e8] = *(const LAS bf16x8*)(sp + (16 * (eh * 8 + e8)) * RS_K + 64 * ks);
#pragma unroll
                for (int e8 = 0; e8 < 8; ++e8) acc[eh * 8 + e8] = __builtin_amdgcn_mfma_f32_16x16x32_bf16(as[e8], bq[ks], acc[eh * 8 + e8], 0, 0, 0);
                SBAR();
            }
        const float qd = __expf(log_g * (float)(il + 1));
#pragma unroll
        for (int et = 0; et < 16; ++et) acc[et] = acc[et] * qd;
        __syncthreads();
    }
#pragma unroll
    for (int it = 0; it < 8; ++it) { const int task = tid + 512 * it; const int r_ = task >> 5, c = task & 31; *(LAS v4u*)(lds + VS_OFF + r_ * RS_V + c * 16) = vv[it]; }
    __syncthreads();
    const unsigned aV = (unsigned)(uintptr_t)(lds + VS_OFF) + (unsigned)((4 * g + q) * RS_V + 8 * p);
    const int npair = (wave >> 1) + 1;
#pragma unroll 1
    for (int pp = 0; pp < npair; ++pp) {
        f32x4 st[2];
#pragma unroll
        for (int hh = 0; hh < 2; ++hh) {
            const LAS unsigned char* kp = lds + KS_OFF + (32 * pp + 16 * hh + fr) * RS_K + 16 * g;
            f32x4 s = {0.f, 0.f, 0.f, 0.f};
#pragma unroll
            for (int ks = 0; ks < 4; ++ks) { const bf16x8 ak = *(const LAS bf16x8*)(kp + 64 * ks); s = __builtin_amdgcn_mfma_f32_16x16x32_bf16(ak, bq[ks], s, 0, 0, 0); }
#pragma unroll
            for (int r = 0; r < 4; ++r) { const int jl = 32 * pp + 16 * hh + 4 * g + r; const float f = (il >= jl) ? __expf(log_g * (float)(il - jl)) : 0.f; s[r] *= f; }
            st[hh] = s;
        }
        v4u pw; pw.x = pk2(st[0][0], st[0][1]); pw.y = pk2(st[0][2], st[0][3]); pw.z = pk2(st[1][0], st[1][1]); pw.w = pk2(st[1][2], st[1][3]);
        const bf16x8 bp = __builtin_bit_cast(bf16x8, pw);
        const unsigned av = aV + (unsigned)(pp * 32 * RS_V);
#pragma unroll
        for (int eh = 0; eh < 2; ++eh) {
            s16x4 vl[8], vh[8];
#pragma unroll
            for (int e8 = 0; e8 < 8; ++e8) { TR_READ(vl[e8], av, (eh * 8 + e8) * 32); TR_READ(vh[e8], av, 16 * RS_V + (eh * 8 + e8) * 32); }
            asm volatile("s_waitcnt lgkmcnt(0)" ::: "memory"); SBAR();
#pragma unroll
            for (int e8 = 0; e8 < 8; ++e8) acc[eh * 8 + e8] = __builtin_amdgcn_mfma_f32_16x16x32_bf16(PK8(vl[e8], vh[e8]), bp, acc[eh * 8 + e8], 0, 0, 0);
        }
    }
    float ss = 0.f;
#pragma unroll
    for (int et = 0; et < 16; ++et) ss += (acc[et][0] * acc[et][0] + acc[et][1] * acc[et][1]) + (acc[et][2] * acc[et][2] + acc[et][3] * acc[et][3]);
    ss += __shfl_xor(ss, 16); ss += __shfl_xor(ss, 32);
    const float rstd = rsqrtf(ss * (1.f / DV) + EPS);
    const bf16* rgp = U + (t0 + il) * INC + OFF_RG + h * DV + 4 * g;
    bf16* rnp = (bf16*)(a.ws + WS_A4) + (t0 + il) * K4 + CONV_CH + h * DV + 4 * g;
#pragma unroll
    for (int et = 0; et < 16; ++et) {
        const v2u rg = *(const v2u*)(rgp + 16 * et);
        const float o0 = acc[et][0] * rstd * silu_f(bflo(rg.x)), o1 = acc[et][1] * rstd * silu_f(bfhi(rg.x)), o2 = acc[et][2] * rstd * silu_f(bflo(rg.y)), o3 = acc[et][3] * rstd * silu_f(bfhi(rg.y));
        v2u w; w.x = pk2(o0, o1); w.y = pk2(o2, o3); *(v2u*)(rnp + 16 * et) = w;
    }
}
__device__ __forceinline__ int* route_eid(unsigned char* ws) { return (int*)(ws + WS_ROUTE); }
__device__ __forceinline__ int* route_pos(unsigned char* ws) { return (int*)(ws + WS_ROUTE) + NA; }
__device__ __forceinline__ float* route_cw(unsigned char* ws) { return (float*)(ws + WS_ROUTE) + 2 * NA; }
__device__ __forceinline__ int* route_list(unsigned char* ws) { return (int*)(ws + WS_ROUTE + al256((size_t)NA * 12)); }

constexpr int P6_TAB = 0, P6_HI = 16384, P6_RS = 1040, P6_LO = P6_HI + 32 * P6_RS, P6_LG = P6_LO + 32 * P6_RS, P6_CP = 0;
__device__ __forceinline__ void p6_route(const Args& a, LAS unsigned char* lds, int tid, int lane, int wave, int G) {
    unsigned char* ws = a.ws;
    const float* MOD = (const float*)(ws + WS_MOD); const float* X1 = (const float*)(ws + WS_X1); bf16* H2 = (bf16*)(ws + WS_H);
    const float* g = a.in[I_N2G]; const bf16* WRT = (const bf16*)(ws + WS_WRT);
    LAS float* tsc = (LAS float*)(lds + P6_TAB); LAS float* tsh = tsc + D; LAS float* lg = (LAS float*)(lds + P6_LG);
    int* cnt = (int*)(ws + WS_CTL) + CW_CNT;
    const int fr = lane & 15, fq = lane >> 4;
    for (int rb = blockIdx.x; rb < T / 32; rb += G) {
        const int b = (rb * 32) / SEQ;
        __syncthreads();
        for (int d = tid; d < D; d += 512) { tsh[d] = MOD[(size_t)b * MODC + 3 * D + d]; tsc[d] = 1.f + MOD[(size_t)b * MODC + 4 * D + d]; }
        __syncthreads();
        float rstd[4];
        { f32x4 gg[8], v[8];
#pragma unroll
          for (int j = 0; j < 8; ++j) { gg[j] = *(const f32x4*)(g + 4 * lane + 256 * j); v[j] = ((const GAS f32x4*)(X1 + (size_t)(rb * 32 + wave * 4) * D) + lane)[64 * j]; }
#pragma unroll
          for (int rr = 0; rr < 4; ++rr) {
            const int row = rb * 32 + wave * 4 + rr;
            f32x4 vn[8];
            if (rr < 3) {
#pragma unroll
                for (int j = 0; j < 8; ++j) vn[j] = ((const GAS f32x4*)(X1 + (size_t)(row + 1) * D) + lane)[64 * j]; }
            float s = 0.f;
#pragma unroll
            for (int j = 0; j < 8; ++j) s += (v[j].x * v[j].x + v[j].y * v[j].y) + (v[j].z * v[j].z + v[j].w * v[j].w);
            rstd[rr] = rsqrtf(wave_sum(s) * (1.f / D) + EPS);
            GAS v2u* o8 = (GAS v2u*)(H2 + (size_t)row * D) + lane;
#pragma unroll
            for (int j = 0; j < 8; ++j) { const int d = 4 * lane + 256 * j; const f32x4 cs = *(const LAS f32x4*)(tsc + d), sh = *(const LAS f32x4*)(tsh + d);
                const f32x4 hv = v[j] * rstd[rr] * gg[j] * cs + sh; v2u w; w.x = pk2(hv.x, hv.y); w.y = pk2(hv.z, hv.w); o8[64 * j] = w; }
            if (rr < 3) {
#pragma unroll
                for (int j = 0; j < 8; ++j) v[j] = vn[j]; }
          } }
        f32x4 acc[2][3];
#pragma unroll
        for (int mt = 0; mt < 2; ++mt)
#pragma unroll
            for (int n = 0; n < 3; ++n) acc[mt][n] = (f32x4){0.f, 0.f, 0.f, 0.f};
#pragma unroll 1
        for (int c = 0; c < 4; ++c) {
#pragma unroll
            for (int rr = 0; rr < 4; ++rr) { const int rl = wave * 4 + rr; const size_t row = (size_t)rb * 32 + rl;
#pragma unroll
                for (int jj = 0; jj < 2; ++jj) { const int dl = 4 * lane + 256 * jj, d = 512 * c + dl;
                    const f32x4 gg = *(const f32x4*)(g + d); const f32x4 cs = *(const LAS f32x4*)(tsc + d), sh = *(const LAS f32x4*)(tsh + d);
                    const f32x4 hv = *(const f32x4*)(X1 + row * D + d) * rstd[rr] * gg * cs + sh;
                    const unsigned h0 = f2bf(hv.x), h1 = f2bf(hv.y), h2_ = f2bf(hv.z), h3 = f2bf(hv.w);
                    const float l0 = hv.x - __builtin_bit_cast(float, h0 << 16), l1 = hv.y - __builtin_bit_cast(float, h1 << 16), l2 = hv.z - __builtin_bit_cast(float, h2_ << 16), l3 = hv.w - __builtin_bit_cast(float, h3 << 16);
                    v2u wh, wl; wh.x = h0 | (h1 << 16); wh.y = h2_ | (h3 << 16); wl.x = pk2(l0, l1); wl.y = pk2(l2, l3);
                    *(LAS v2u*)(lds + P6_HI + rl * P6_RS + dl * 2) = wh; *(LAS v2u*)(lds + P6_LO + rl * P6_RS + dl * 2) = wl; } }
            __syncthreads();
#pragma unroll
            for (int kk = 0; kk < 2; ++kk) { const int ks = 2 * wave + kk;
                bf16x8 ah[2], al[2], bh[3], bl[3];
#pragma unroll
                for (int mt = 0; mt < 2; ++mt) { ah[mt] = *(const LAS bf16x8*)(lds + P6_HI + (mt * 16 + fr) * P6_RS + (ks * 32 + 8 * fq) * 2); al[mt] = *(const LAS bf16x8*)(lds + P6_LO + (mt * 16 + fr) * P6_RS + (ks * 32 + 8 * fq) * 2); }
#pragma unroll
                for (int n = 0; n < 3; ++n) { const bf16* wp = WRT + (size_t)(n * 16 + fr) * D + 512 * c + ks * 32 + 8 * fq; bh[n] = *(const bf16x8*)wp; bl[n] = *(const bf16x8*)(wp + 48 * D); }
#pragma unroll
                for (int mt = 0; mt < 2; ++mt)
#pragma unroll
                    for (int n = 0; n < 3; ++n) { f32x4 t = acc[mt][n];
                        t = __builtin_amdgcn_mfma_f32_16x16x32_bf16(al[mt], bl[n], t, 0, 0, 0); t = __builtin_amdgcn_mfma_f32_16x16x32_bf16(al[mt], bh[n], t, 0, 0, 0);
                        t = __builtin_amdgcn_mfma_f32_16x16x32_bf16(ah[mt], bl[n], t, 0, 0, 0); t = __builtin_amdgcn_mfma_f32_16x16x32_bf16(ah[mt], bh[n], t, 0, 0, 0); acc[mt][n] = t; } }
            __syncthreads();
        }
#pragma unroll
        for (int mt = 0; mt < 2; ++mt)
#pragma unroll
            for (int n = 0; n < 3; ++n) *(LAS f32x4*)(lds + P6_CP + ((wave * 6 + mt * 3 + n) * 64 + lane) * 16) = acc[mt][n];
        __syncthreads();
        for (int idx = tid; idx < 6 * 256; idx += 512) { const int tile = idx >> 8, ln = (idx >> 2) & 63, reg = idx & 3; float s = 0.f;
#pragma unroll
            for (int w = 0; w < 8; ++w) s += *(const LAS float*)(lds + P6_CP + ((w * 6 + tile) * 64 + ln) * 16 + reg * 4);
            const int mt = tile / 3, n = tile % 3, row = mt * 16 + 4 * (ln >> 4) + reg, o = n * 16 + (ln & 15);
            lg[row * 48 + o] = s + (o < 4 ? a.in[I_BRG][o] : (o < 36 ? a.in[I_BRE][o - 4] : 0.f)); }
        __syncthreads();
        if (tid < 32) {
            const LAS float* l = lg + tid * 48;
            int gs = 0; float m = l[0];
#pragma unroll
            for (int q = 1; q < 4; ++q) { const float v = l[q]; if (v > m) { m = v; gs = q; } }
            float den = 0.f;
#pragma unroll
            for (int q = 0; q < 4; ++q) den += __expf(l[q] - m);
            const float gw = 1.f / den;
            float el[8];
#pragma unroll
            for (int i = 0; i < 8; ++i) el[i] = l[4 + gs * 8 + i];
            float m2 = el[0];
#pragma unroll
            for (int i = 1; i < 8; ++i) m2 = fmaxf(m2, el[i]);
            float pr[8];
#pragma unroll
            for (int i = 0; i < 8; ++i) pr[i] = __expf(el[i] - m2);
            int i1 = 0; float p1 = pr[0];
#pragma unroll
            for (int i = 1; i < 8; ++i) if (pr[i] > p1) { p1 = pr[i]; i1 = i; }
            int i2 = -1; float p2 = -1.f;
#pragma unroll
            for (int i = 0; i < 8; ++i) if (i != i1 && pr[i] > p2) { p2 = pr[i]; i2 = i; }
            const float sden = 1.f / (p1 + p2);
            const int t = rb * 32 + tid; const int e0 = gs * 8 + i1, e1 = gs * 8 + i2;
            const int q0 = atomicAdd(&cnt[e0], 1), q1 = atomicAdd(&cnt[e1], 1);
            route_eid(ws)[2 * t] = e0; route_eid(ws)[2 * t + 1] = e1; route_pos(ws)[2 * t] = q0; route_pos(ws)[2 * t + 1] = q1;
            route_cw(ws)[2 * t] = gw * p1 * sden; route_cw(ws)[2 * t + 1] = gw * p2 * sden;
            route_list(ws)[(size_t)e0 * T + q0] = t; route_list(ws)[(size_t)e1 * T + q1] = t;
        }
    }
}

constexpr int MT = MOE_MT;
struct MoeTab { LAS int* cnt; LAS int* tpre; LAS int* tile_e; LAS int* gstart; LAS int* gtile; };
__device__ __forceinline__ MoeTab moe_tab(LAS unsigned char* lds) { MoeTab t; t.cnt = (LAS int*)(lds + LDSTAB_OFF); t.tpre = t.cnt + 32; t.tile_e = t.tpre + 40; t.gstart = t.tile_e + 168; t.gtile = t.gstart + 16; return t; }
__device__ __forceinline__ void moe_build_tab(const Args& a, LAS unsigned char* lds, int tid) {
    MoeTab t = moe_tab(lds); const int* cnt = (const int*)(a.ws + WS_CTL) + CW_CNT;
    LAS int* gexp = t.gtile + 168;
    __syncthreads();
    if (tid < 64) {
        const int e = tid & 31; const int c = cnt[e]; const int n = (c + MT - 1) / MT;
        int incl = n;
#pragma unroll
        for (int o = 1; o < 32; o <<= 1) { const int v = __shfl_up(incl, o, 32); if (e >= o) incl += v; }
        const int pre = incl - n;
        int rank = 0;
#pragma unroll
        for (int j = 0; j < 32; ++j) { const int nj = __shfl(n, j, 32); rank += (nj > n || (nj == n && j < e)) ? 1 : 0; }
        const int pass = rank >> 3, col = rank & 7, grp = (pass & 1) ? 7 - col : col;
        if (tid < 32) { t.cnt[e] = c; t.tpre[e] = pre; if (e == 31) t.tpre[NE] = incl; gexp[grp * 4 + pass] = e;
            for (int i = 0; i < n; ++i) t.tile_e[pre + i] = e; }
        asm volatile("s_waitcnt lgkmcnt(0)" ::: "memory");
        const int x = tid & 7; int ex[4], nx[4], tot = 0;
#pragma unroll
        for (int p = 0; p < 4; ++p) { ex[p] = gexp[x * 4 + p]; nx[p] = __shfl(n, ex[p], 32); tot += nx[p]; }
        int gi = tot;
#pragma unroll
        for (int o = 1; o < 8; o <<= 1) { const int v = __shfl_up(gi, o, 8); if (x >= o) gi += v; }
        if (tid < 8) { t.gstart[x] = gi - tot; if (x == 7) t.gstart[8] = gi; }
        int k0s[4];
#pragma unroll
        for (int p = 0; p < 4; ++p) k0s[p] = __shfl(pre, ex[p], 32);
        if (tid < 8) { int pos = gi - tot;
#pragma unroll
            for (int p = 0; p < 4; ++p) for (int i = 0; i < nx[p]; ++i) t.gtile[pos++] = k0s[p] + i; }
    }
    __syncthreads();
}
template <bool GATHER> struct MoeOrder {
    MoeTab tab; const char* A; const char* Bt; const int* list; int G, c, K, ldb; size_t eBstride;
    __device__ __forceinline__ bool next(int i, Unit& u) const {
        const int L = i * G + c; const int total = tab.tpre[NE] * 8; if (L >= total) return false;
        const int rtg = L >> 3; u.pn = L & 7; u.e = tab.tile_e[rtg]; u.pm = rtg - tab.tpre[u.e]; u.row0 = rtg * 256; u.half = 0; return true;
    }
    __device__ __forceinline__ const char* a_tile(const Unit& u, size_t tstep) const { return GATHER ? A : A + (size_t)(u.row0 / 256) * tstep; }
    __device__ __forceinline__ const char* b_tile(const Unit& u, size_t tstep) const { return Bt + (size_t)u.e * eBstride + (ldb ? (size_t)u.pn * 512 : (size_t)u.pn * tstep); }
    __device__ __forceinline__ void a_offsets(const Unit& u, const int (&R)[2], const int (&C)[2], int K_, unsigned (&vo)[2][2]) const {
        const int ce = tab.cnt[u.e];
#pragma unroll
        for (int h = 0; h < 2; ++h)
#pragma unroll
            for (int i = 0; i < 2; ++i) { int idx = u.pm * 256 + h * 128 + R[i]; idx = idx < ce ? idx : ce - 1; const int tok = list[(size_t)u.e * T + idx]; vo[h][i] = (unsigned)(tok * K_ + C[i]) * 2u; }
    }
};
struct EpiHM {
    static constexpr bool PERM = true; bf16* HM;
    __device__ __forceinline__ void operator()(const f32x4 (&acc)[2][2][4][2], const Unit& u, int wr, int wc, int fr, int fq) const {
        const int row0 = u.row0 + wr * 64 + fr, col0 = u.pn * 128 + wc * 32 + 8 * fq;
#pragma unroll
        for (int ai = 0; ai < 2; ++ai)
#pragma unroll
            for (int m = 0; m < 4; ++m) { const f32x4 g0 = acc[ai][0][m][0], g1 = acc[ai][0][m][1], u0 = acc[ai][1][m][0], u1 = acc[ai][1][m][1];
                u32x4 w; w.x = cvt_pk_bf16(silu_f(g0[0]) * u0[0], silu_f(g0[1]) * u0[1]); w.y = cvt_pk_bf16(silu_f(g0[2]) * u0[2], silu_f(g0[3]) * u0[3]);
                w.z = cvt_pk_bf16(silu_f(g1[0]) * u1[0], silu_f(g1[1]) * u1[1]); w.w = cvt_pk_bf16(silu_f(g1[2]) * u1[2], silu_f(g1[3]) * u1[3]);
                *(u32x4*)(HM + (size_t)(row0 + ai * 128 + m * 16) * DE + col0) = w; }
    }
};

struct EpiHMn {
    static constexpr bool PERM = false; bf16* HM;
    __device__ __forceinline__ void operator()(const f32x4 (&acc)[2][2][4][2], const Unit& u, int wr, int wc, int fr, int fq) const {
        const int row0 = u.row0 + wr * 64 + fr, col0 = u.pn * 128 + wc * 32 + 4 * fq;
#pragma unroll
        for (int ai = 0; ai < 2; ++ai)
#pragma unroll
            for (int m = 0; m < 4; ++m)
#pragma unroll
                for (int n = 0; n < 2; ++n) { const f32x4 g0 = acc[ai][0][m][n], u0 = acc[ai][1][m][n];
                    v2u w; w.x = cvt_pk_bf16(silu_f(g0[0]) * u0[0], silu_f(g0[1]) * u0[1]); w.y = cvt_pk_bf16(silu_f(g0[2]) * u0[2], silu_f(g0[3]) * u0[3]);
                    *(v2u*)(HM + (size_t)(row0 + ai * 128 + m * 16) * DE + col0 + 16 * n) = w; }
    }
};
struct EpiBf16n {
    static constexpr bool PERM = false; bf16* O; int ldc;
    __device__ __forceinline__ void operator()(const f32x4 (&acc)[2][2][4][2], const Unit& u, int wr, int wc, int fr, int fq) const {
        const int row0 = u.row0 + wr * 64 + fr, col0 = u.pn * 256 + wc * 32 + 4 * fq;
#pragma unroll
        for (int ai = 0; ai < 2; ++ai)
#pragma unroll
            for (int m = 0; m < 4; ++m) { bf16* rowp = O + (size_t)(row0 + ai * 128 + m * 16) * ldc + col0;
#pragma unroll
                for (int bj = 0; bj < 2; ++bj)
#pragma unroll
                    for (int n = 0; n < 2; ++n) { const f32x4 v = acc[ai][bj][m][n]; v2u w; w.x = cvt_pk_bf16(v[0], v[1]); w.y = cvt_pk_bf16(v[2], v[3]); *(v2u*)(rowp + bj * 128 + 16 * n) = w; } }
    }
};

constexpr int PGM_A = 0, PGM_B = 49152, PGM_LDS = PGM_B + 65536;
struct MoeUnit { int e, pn, rt, row0, hs, tq; };
template <bool GATHER, class Epi>
__device__ __forceinline__ void moe_gemm(LAS unsigned char* lds, const int K, const MoeTab tab, const int G, const int c, const char* A, const int* list,
                                          const float* B0, const float* B1, const size_t eB, const int ldb, const int colstep, const Epi& E) {
    const int tid = threadIdx.x, wid = __builtin_amdgcn_readfirstlane(tid >> 6), lane = tid & 63, wr = wid >> 2, wc = wid & 3, fr = lane & 15, fq = lane >> 4;
    const int nt = K / 64, ntiles = tab.tpre[NE];
    int stR[2], stC[2];
#pragma unroll
    for (int i = 0; i < 2; ++i) pg8::stage_rc(tid * 16 + i * 8192, stR[i], stC[i]);
    const int aoff = pg8::lds_byte(wr * 64 + fr, fq * 8);
    const int kb = 8 * wid + (lane >> 5), cl = lane & 31;
    const unsigned bvo = (unsigned)((kb * ldb + 4 * cl) * 4);
    const size_t ktB = (size_t)64 * ldb * 4, rowB2 = (size_t)2 * ldb * 4;
    unsigned bw[4];
#pragma unroll
    for (int j = 0; j < 4; ++j) { const int k = kb + 2 * j; bw[j] = (unsigned)(256 * k + 16 * ((cl >> 1) ^ (((k & 3) << 2) | ((k >> 2) & 3))) + 8 * (cl & 1)); }
    unsigned tb[2][2];
    { const int q = fr >> 2, p = lane & 3;
#pragma unroll
      for (int n = 0; n < 2; ++n)
#pragma unroll
        for (int t = 0; t < 2; ++t) { const int row = 8 * fq + 4 * t + q, ch = 2 * (2 * wc + n) + (p >> 1);
            tb[n][t] = (unsigned)(uintptr_t)lds + PGM_B + (unsigned)(256 * row + 16 * (ch ^ (((row & 3) << 2) | ((row >> 2) & 3))) + 8 * (p & 1)); } }
    const bool grouped = false; const int gsz = G, gj = c, gn = ntiles;
    (void)grouped;
#define PGM_UNIT(q, u, sb0, sb1, aBp, vop) do { (u).pn = (q) / gn; const int _rtg = (q) - (u).pn * gn; (u).e = tab.tile_e[_rtg]; (u).rt = _rtg - tab.tpre[(u).e]; (u).row0 = _rtg * 128; \
        (sb0) = (const char*)(B0 + (size_t)(u).e * eB + (size_t)(u).pn * colstep); (sb1) = (const char*)(B1 + (size_t)(u).e * eB + (size_t)(u).pn * colstep); \
        if constexpr (GATHER) { const int _ce = tab.cnt[(u).e]; _Pragma("unroll") for (int _i = 0; _i < 2; ++_i) { int _idx = (u).rt * 128 + stR[_i]; _idx = _idx < _ce ? _idx : _ce - 1; \
                const int _tok = list[(size_t)(u).e * T + _idx]; (vop)[_i] = (unsigned)(_tok * K + stC[_i]) * 2u; } (aBp) = A; } \
        else { _Pragma("unroll") for (int _i = 0; _i < 2; ++_i) (vop)[_i] = (unsigned)(stR[_i] * K + stC[_i]) * 2u; (aBp) = A + (size_t)(u).row0 * K * 2; } } while (0)
#define PGM_TR(dst, vb, off) asm volatile("ds_read_b64_tr_b16 %0, %1 offset:%c2" : "=&v"(dst) : "v"(vb), "i"(off) : "memory")
#define PGM_STAGE_A(buf, ap, vop, kt) do { _Pragma("unroll") for (int _i = 0; _i < 2; ++_i) \
        __builtin_amdgcn_global_load_lds((const unsigned*)((ap) + (size_t)(kt) * 128 + (vop)[_i]), (LAS unsigned*)(lds + PGM_A + (buf) * 16384 + wid * 1024 + _i * 8192), 16, 0, 0); } while (0)
#define PGM_LOAD_B(rs, p0, p1, kt) do { _Pragma("unroll") for (int _j = 0; _j < 4; ++_j) { const char* _a0 = (p0) + (size_t)(kt) * ktB + (size_t)_j * rowB2; const char* _a1 = (p1) + (size_t)(kt) * ktB + (size_t)_j * rowB2; \
        asm volatile("global_load_dwordx4 %0, %1, %2" : "=&v"(rs[0][_j]) : "v"(bvo), "s"(_a0) : "memory"); \
        asm volatile("global_load_dwordx4 %0, %1, %2" : "=&v"(rs[1][_j]) : "v"(bvo), "s"(_a1) : "memory"); } } while (0)
#define PGM_WAIT8(rs) asm volatile("s_waitcnt vmcnt(10)" : "+v"(rs[0][0]), "+v"(rs[0][1]), "+v"(rs[0][2]), "+v"(rs[0][3]), "+v"(rs[1][0]), "+v"(rs[1][1]), "+v"(rs[1][2]), "+v"(rs[1][3]) :: "memory")
#define PGM_WRITE_B(rs, buf) do { _Pragma("unroll") for (int _h = 0; _h < 2; ++_h) _Pragma("unroll") for (int _j = 0; _j < 4; ++_j) { v2u _w; _w.x = cvt_pk_bf16(rs[_h][_j].x, rs[_h][_j].y); _w.y = cvt_pk_bf16(rs[_h][_j].z, rs[_h][_j].w); \
        *(LAS v2u*)(lds + PGM_B + ((buf) * 2 + _h) * 16384 + bw[_j]) = _w; } } while (0)
#define PGM_COMPUTE(cur, abuf) do { bf16x8 At[4][2]; s16x4 bl[2][2][2], bh[2][2][2]; const LAS unsigned char* _ap = lds + PGM_A + (abuf) * 16384 + aoff; \
        _Pragma("unroll") for (int h = 0; h < 2; ++h) _Pragma("unroll") for (int n = 0; n < 2; ++n) _Pragma("unroll") for (int k = 0; k < 2; ++k) { \
            PGM_TR(bl[h][n][k], tb[n][0], ((cur) * 2 + h) * 16384 + k * 8192); PGM_TR(bh[h][n][k], tb[n][1], ((cur) * 2 + h) * 16384 + k * 8192); } \
        _Pragma("unroll") for (int mm = 0; mm < 4; ++mm) _Pragma("unroll") for (int k = 0; k < 2; ++k) At[mm][k] = *(const LAS bf16x8*)(_ap + mm * 2048 + k * 1024); \
        asm volatile("s_waitcnt lgkmcnt(0)" ::: "memory"); SBAR(); __builtin_amdgcn_s_setprio(1); \
        _Pragma("unroll") for (int h = 0; h < 2; ++h) _Pragma("unroll") for (int mm = 0; mm < 4; ++mm) _Pragma("unroll") for (int n = 0; n < 2; ++n) _Pragma("unroll") for (int k = 0; k < 2; ++k) \
            acc[h][mm][n] = __builtin_amdgcn_mfma_f32_16x16x32_bf16(PK8(bl[h][n][k], bh[h][n][k]), At[mm][k], acc[h][mm][n], 0, 0, 0); \
        __builtin_amdgcn_s_setprio(0); SBAR(); } while (0)
#define PGM_BARRIER() do { asm volatile("s_waitcnt lgkmcnt(0)" ::: "memory"); __builtin_amdgcn_s_barrier(); asm volatile("" ::: "memory"); } while (0)
    int q = gj; if (q >= gn * 8) return;
    MoeUnit cur, nxt; const char *cb0, *cb1, *caB, *nb0, *nb1, *naB; unsigned cvo[2], nvo[2];
    PGM_UNIT(q, cur, cb0, cb1, caB, cvo);
    f32x4 rs0[2][4], rs1[2][4];
    asm volatile("s_waitcnt vmcnt(0)" ::: "memory"); PGM_BARRIER();
    int a0 = 0;
    PGM_STAGE_A(0, caB, cvo, 0); PGM_LOAD_B(rs0, cb0, cb1, 0); PGM_STAGE_A(1, caB, cvo, 1); PGM_LOAD_B(rs1, cb0, cb1, 1);
    PGM_WAIT8(rs0); PGM_WRITE_B(rs0, 0); PGM_BARRIER();
    for (;;) {
        const bool has_next = q + gsz < gn * 8;
        if (has_next) { PGM_UNIT(q + gsz, nxt, nb0, nb1, naB, nvo); } else { nxt = cur; nb0 = cb0; nb1 = cb1; naB = caB; nvo[0] = cvo[0]; nvo[1] = cvo[1]; }
        f32x4 acc[2][4][2];
#pragma unroll
        for (int b = 0; b < 2; ++b)
#pragma unroll
            for (int mm = 0; mm < 4; ++mm)
#pragma unroll
                for (int n = 0; n < 2; ++n) acc[b][mm][n] = (f32x4){0.f, 0.f, 0.f, 0.f};
#pragma unroll 1
        for (int t = 0; t < nt; t += 2) {
            const bool lastp = (t == nt - 2);
            const char* p0 = lastp ? nb0 : cb0; const char* p1 = lastp ? nb1 : cb1; const char* pa = lastp ? naB : caB; const int kt2 = lastp ? 0 : t + 2;
            unsigned vo2[2]; vo2[0] = lastp ? nvo[0] : cvo[0]; vo2[1] = lastp ? nvo[1] : cvo[1];
            { const int a2 = a0 >= 1 ? a0 - 1 : 2; PGM_STAGE_A(a2, pa, vo2, kt2); } PGM_LOAD_B(rs0, p0, p1, kt2);
            PGM_COMPUTE(0, a0);
            PGM_WAIT8(rs1); PGM_WRITE_B(rs1, 1); PGM_BARRIER();
            a0 = a0 == 2 ? 0 : a0 + 1;
            { const int a2 = a0 >= 1 ? a0 - 1 : 2; PGM_STAGE_A(a2, pa, vo2, kt2 + 1); } PGM_LOAD_B(rs1, p0, p1, kt2 + 1);
            PGM_COMPUTE(1, a0);
            PGM_WAIT8(rs0); PGM_WRITE_B(rs0, 0); PGM_BARRIER();
            a0 = a0 == 2 ? 0 : a0 + 1;
        }
        E(acc, cur, wr, wc, fr, fq);
        if (!has_next) break;
        cur = nxt; cb0 = nb0; cb1 = nb1; caB = naB; cvo[0] = nvo[0]; cvo[1] = nvo[1]; q += gsz;
    }
    asm volatile("s_waitcnt vmcnt(0)" : "+v"(rs0[0][0]), "+v"(rs0[0][1]), "+v"(rs0[0][2]), "+v"(rs0[0][3]), "+v"(rs0[1][0]), "+v"(rs0[1][1]), "+v"(rs0[1][2]), "+v"(rs0[1][3]) :: "memory");
    asm volatile("" : "+v"(rs1[0][0]), "+v"(rs1[0][1]), "+v"(rs1[0][2]), "+v"(rs1[0][3]), "+v"(rs1[1][0]), "+v"(rs1[1][1]), "+v"(rs1[1][2]), "+v"(rs1[1][3]) :: "memory");
    PGM_BARRIER();
#undef PGM_UNIT
#undef PGM_TR
#undef PGM_STAGE_A
#undef PGM_LOAD_B
#undef PGM_WRITE_B
#undef PGM_WAIT8
#undef PGM_COMPUTE
#undef PGM_BARRIER
}
struct EpiHMm {
    bf16* HM;
    __device__ __forceinline__ void operator()(const f32x4 (&acc)[2][4][2], const MoeUnit& u, int wr, int wc, int fr, int fq) const {
        const int row0 = u.row0 + wr * 64 + fr, col0 = u.pn * 128 + wc * 32 + 4 * fq;
#pragma unroll
        for (int mm = 0; mm < 4; ++mm)
#pragma unroll
            for (int n = 0; n < 2; ++n) { const f32x4 g0 = acc[0][mm][n], u0 = acc[1][mm][n];
                v2u w; w.x = cvt_pk_bf16(silu_f(g0[0]) * u0[0], silu_f(g0[1]) * u0[1]); w.y = cvt_pk_bf16(silu_f(g0[2]) * u0[2], silu_f(g0[3]) * u0[3]);
                *(v2u*)(HM + (size_t)(row0 + mm * 16) * DE + col0 + 16 * n) = w; }
    }
};
struct EpiYm {
    bf16* Y;
    __device__ __forceinline__ void operator()(const f32x4 (&acc)[2][4][2], const MoeUnit& u, int wr, int wc, int fr, int fq) const {
        const int row0 = u.row0 + wr * 64 + fr, col0 = u.pn * 256 + wc * 32 + 4 * fq;
#pragma unroll
        for (int mm = 0; mm < 4; ++mm)
#pragma unroll
            for (int bj = 0; bj < 2; ++bj)
#pragma unroll
                for (int n = 0; n < 2; ++n) { const f32x4 v = acc[bj][mm][n]; v2u w; w.x = cvt_pk_bf16(v[0], v[1]); w.y = cvt_pk_bf16(v[2], v[3]); *(v2u*)(Y + (size_t)(row0 + mm * 16) * D + col0 + bj * 128 + 16 * n) = w; }
    }
};

constexpr int PGX_A = 0, PGX_B = 65536;
template <bool GATHER, class Epi, bool KSPLIT = false>
__device__ __forceinline__ void moe_gemm256(LAS unsigned char* lds, const int K, const MoeTab tab, const int G, const int c, const char* A, const int* list,
                                             const float* B0, const float* B1, const size_t eB, const int ldb, const int colstep, const Epi& E) {
    const int tid = threadIdx.x, wid = __builtin_amdgcn_readfirstlane(tid >> 6), lane = tid & 63, wr = wid >> 2, wc = wid & 3, fr = lane & 15, fq = lane >> 4;
    const int nt = K / 64, gn = tab.tpre[NE];
    int stR[2], stC[2];
#pragma unroll
    for (int i = 0; i < 2; ++i) pg8::stage_rc(tid * 16 + i * 8192, stR[i], stC[i]);
    const int aoff = pg8::lds_byte(wr * 64 + fr, fq * 8);
    const int kb = 8 * wid + (lane >> 5), cl = lane & 31;
    const unsigned bvo = (unsigned)((kb * ldb + 4 * cl) * 4);
    const size_t ktB = (size_t)64 * ldb * 4, rowB2 = (size_t)2 * ldb * 4;
    unsigned bw0; { const int k = kb; bw0 = (unsigned)(256 * k + 8 * (cl & 1)); }
    unsigned tb[2][2];
    { const int q = fr >> 2, p = lane & 3;
#pragma unroll
      for (int n = 0; n < 2; ++n)
#pragma unroll
        for (int t = 0; t < 2; ++t) { const int row = 8 * fq + 4 * t + q, ch = 2 * (2 * wc + n) + (p >> 1);
            tb[n][t] = (unsigned)(uintptr_t)lds + PGX_B + (unsigned)(256 * row + 16 * (ch ^ (((row & 3) << 2) | ((row >> 2) & 3))) + 8 * (p & 1)); } }
#define PGX_UNIT(q, u, sb0, sb1, aBp, vop) do { const int _q = (x_split && (q) >= x_full) ? x_full + (((q) - x_full) >> 1) : (q); (u).hs = (x_split && (q) >= x_full) ? (((q) - x_full) & 1) : -1; \
        (u).pn = _q / gn; const int _rtg = _q - (u).pn * gn; (u).e = tab.tile_e[_rtg]; (u).rt = _rtg - tab.tpre[(u).e]; (u).row0 = _rtg * 256; \
        (u).tq = (x_split && (q) >= x_full) ? (((q) - x_full) >> 1) : 0; \
        { const size_t _bo = KSPLIT ? ((u).hs > 0 ? (size_t)(K / 2) * ldb : 0) : ((u).hs > 0 ? 64 : 0); \
          (sb0) = (const char*)(B0 + (size_t)(u).e * eB + (size_t)(u).pn * colstep + _bo); (sb1) = (const char*)(B1 + (size_t)(u).e * eB + (size_t)(u).pn * colstep + _bo); } \
        if constexpr (GATHER) { const int _ce = tab.cnt[(u).e]; _Pragma("unroll") for (int _h = 0; _h < 2; ++_h) _Pragma("unroll") for (int _i = 0; _i < 2; ++_i) { int _idx = (u).rt * 256 + _h * 128 + stR[_i]; _idx = _idx < _ce ? _idx : _ce - 1; \
                const int _tok = list[(size_t)(u).e * T + _idx]; (vop)[_h][_i] = (unsigned)(_tok * K + stC[_i]) * 2u; } (aBp) = A; } \
        else { _Pragma("unroll") for (int _h = 0; _h < 2; ++_h) _Pragma("unroll") for (int _i = 0; _i < 2; ++_i) (vop)[_h][_i] = (unsigned)((_h * 128 + stR[_i]) * K + stC[_i]) * 2u; (aBp) = A + (size_t)(u).row0 * K * 2 + ((KSPLIT && (u).hs > 0) ? (size_t)K : 0); } } while (0)
#define PGX_TR(dst, vb, off) asm volatile("ds_read_b64_tr_b16 %0, %1 offset:%c2" : "=&v"(dst) : "v"(vb), "i"(off) : "memory")
#define PGX_STAGE_A(buf, ap, vop, kt) do { _Pragma("unroll") for (int _h = 0; _h < 2; ++_h) _Pragma("unroll") for (int _i = 0; _i < 2; ++_i) \
        __builtin_amdgcn_global_load_lds((const unsigned*)((ap) + (size_t)(kt) * 128 + (vop)[_h][_i]), (LAS unsigned*)(lds + PGX_A + ((buf) * 2 + _h) * 16384 + wid * 1024 + _i * 8192), 16, 0, 0); } while (0)
#define PGX_LOAD_B(rs, p0, p1, kt, hf) do { if (!(hf) || cl < 16) _Pragma("unroll") for (int _j = 0; _j < 4; ++_j) { const char* _a0 = (p0) + (size_t)(kt) * ktB + (size_t)_j * rowB2; const char* _a1 = (p1) + (size_t)(kt) * ktB + (size_t)_j * rowB2; \
        asm volatile("global_load_dwordx4 %0, %1, %2" : "=&v"(rs[0][_j]) : "v"(bvo), "s"(_a0) : "memory"); \
        asm volatile("global_load_dwordx4 %0, %1, %2" : "=&v"(rs[1][_j]) : "v"(bvo), "s"(_a1) : "memory"); } } while (0)
#define PGX_WAIT0(rs) asm volatile("s_waitcnt vmcnt(0)" : "+v"(rs[0][0]), "+v"(rs[0][1]), "+v"(rs[0][2]), "+v"(rs[0][3]), "+v"(rs[1][0]), "+v"(rs[1][1]), "+v"(rs[1][2]), "+v"(rs[1][3]) :: "memory")
#define PGX_WRITE_B(rs, buf) do { _Pragma("unroll") for (int _j = 0; _j < 4; ++_j) { const int _k = kb + 2 * _j; const unsigned _o = bw0 + 512u * _j + 16u * (unsigned)((cl >> 1) ^ (((_k & 3) << 2) | ((_k >> 2) & 3))); \
        _Pragma("unroll") for (int _h = 0; _h < 2; ++_h) { v2u _w; _w.x = cvt_pk_bf16(rs[_h][_j].x, rs[_h][_j].y); _w.y = cvt_pk_bf16(rs[_h][_j].z, rs[_h][_j].w); *(LAS v2u*)(lds + PGX_B + ((buf) * 2 + _h) * 16384 + _o) = _w; } } } while (0)
#define PGX_COMPUTE(cur) do { _Pragma("unroll") for (int h = 0; h < 2; ++h) { s16x4 bl[2][2], bh[2][2]; \
        _Pragma("unroll") for (int n = 0; n < 2; ++n) _Pragma("unroll") for (int k = 0; k < 2; ++k) { PGX_TR(bl[n][k], tb[n][0], ((cur) * 2 + h) * 16384 + k * 8192); PGX_TR(bh[n][k], tb[n][1], ((cur) * 2 + h) * 16384 + k * 8192); } \
        _Pragma("unroll") for (int ai = 0; ai < 2; ++ai) { bf16x8 At[4][2]; \
            _Pragma("unroll") for (int mm = 0; mm < 4; ++mm) _Pragma("unroll") for (int k = 0; k < 2; ++k) At[mm][k] = *(const LAS bf16x8*)(lds + PGX_A + ((cur) * 2 + ai) * 16384 + aoff + mm * 2048 + k * 1024); \
            asm volatile("s_waitcnt lgkmcnt(0)" ::: "memory"); SBAR(); __builtin_amdgcn_s_setprio(1); \
            _Pragma("unroll") for (int mm = 0; mm < 4; ++mm) _Pragma("unroll") for (int n = 0; n < 2; ++n) _Pragma("unroll") for (int k = 0; k < 2; ++k) \
                acc[ai][h][mm][n] = __builtin_amdgcn_mfma_f32_16x16x32_bf16(PK8(bl[n][k], bh[n][k]), At[mm][k], acc[ai][h][mm][n], 0, 0, 0); \
            __builtin_amdgcn_s_setprio(0); SBAR(); } } } while (0)
#define PGX_BARRIER() do { asm volatile("s_waitcnt lgkmcnt(0)" ::: "memory"); __builtin_amdgcn_s_barrier(); asm volatile("" ::: "memory"); } while (0)
    const int x_total = gn * 8, x_full = (x_total / G) * G, x_tail = x_total - x_full; const bool x_split = MOE_TAILSPLIT && x_tail > 0 && 2 * x_tail <= G;
    const int x_n = x_split ? x_full + 2 * x_tail : x_total;
    const int r_full = (x_n / G) * G, r_rem = x_n - r_full; int tq = -1;
    if (r_rem > 0) { if (G % 8 == 0) { const int per = G / 8, xg = c / per, ig = c % per, lo_ = (xg * r_rem) / 8, hi_ = ((xg + 1) * r_rem) / 8; if (lo_ + ig < hi_) tq = r_full + lo_ + ig; } else if (c < r_rem) tq = r_full + c; }
    int q = c < r_full ? c : tq; if (q < 0) return;
    MoeUnit cur, nxt; const char *cb0, *cb1, *caB, *nb0, *nb1, *naB; unsigned cvo[2][2], nvo[2][2];
    PGX_UNIT(q, cur, cb0, cb1, caB, cvo);
    f32x4 rs[2][4];
    asm volatile("s_waitcnt vmcnt(0)" ::: "memory"); PGX_BARRIER();
    PGX_STAGE_A(0, caB, cvo, 0); PGX_LOAD_B(rs, cb0, cb1, 0, !KSPLIT && cur.hs >= 0);
    PGX_WAIT0(rs); PGX_WRITE_B(rs, 0); PGX_LOAD_B(rs, cb0, cb1, 1, !KSPLIT && cur.hs >= 0); PGX_BARRIER();
    for (;;) {
        const int qn = (q + G < r_full) ? q + G : (q < r_full ? tq : -1); const bool has_next = qn >= 0;
        if (has_next) { PGX_UNIT(qn, nxt, nb0, nb1, naB, nvo); } else { nxt = cur; nb0 = cb0; nb1 = cb1; naB = caB;
#pragma unroll
            for (int h = 0; h < 2; ++h) { nvo[h][0] = cvo[h][0]; nvo[h][1] = cvo[h][1]; } }
        f32x4 acc[2][2][4][2];
#pragma unroll
        for (int a = 0; a < 2; ++a)
#pragma unroll
            for (int b = 0; b < 2; ++b)
#pragma unroll
                for (int mm = 0; mm < 4; ++mm)
#pragma unroll
                    for (int n = 0; n < 2; ++n) acc[a][b][mm][n] = (f32x4){0.f, 0.f, 0.f, 0.f};
        const int ntu = (KSPLIT && cur.hs >= 0) ? nt / 2 : nt;
#pragma unroll 1
        for (int t = 0; t < ntu; t += 2) {
            const bool lastp = (t == ntu - 2);
            int ts = t; asm volatile("" : "+s"(ts));
            const char* p0 = lastp ? nb0 : cb0; const char* p1 = lastp ? nb1 : cb1; const char* pa = lastp ? naB : caB; const int kt2 = lastp ? 0 : ts + 2; const bool hf2 = !KSPLIT && (lastp ? nxt.hs : cur.hs) >= 0;
            PGX_STAGE_A(1, caB, cvo, ts + 1);
            PGX_COMPUTE(0);
            PGX_WAIT0(rs); PGX_WRITE_B(rs, 1); PGX_LOAD_B(rs, p0, p1, kt2, hf2); PGX_BARRIER();
            { unsigned vo2[2][2];
#pragma unroll
              for (int h = 0; h < 2; ++h) { vo2[h][0] = lastp ? nvo[h][0] : cvo[h][0]; vo2[h][1] = lastp ? nvo[h][1] : cvo[h][1]; }
              PGX_STAGE_A(0, pa, vo2, kt2); }
            PGX_COMPUTE(1);
            PGX_WAIT0(rs); PGX_WRITE_B(rs, 0); PGX_LOAD_B(rs, p0, p1, kt2 + 1, hf2); PGX_BARRIER();
        }
        E(acc, cur, wr, wc, fr, fq);
        if (!has_next) break;
        cur = nxt; cb0 = nb0; cb1 = nb1; caB = naB; q = qn;
#pragma unroll
        for (int h = 0; h < 2; ++h) { cvo[h][0] = nvo[h][0]; cvo[h][1] = nvo[h][1]; }
    }
    PGX_WAIT0(rs); PGX_BARRIER();
#undef PGX_UNIT
#undef PGX_TR
#undef PGX_STAGE_A
#undef PGX_LOAD_B
#undef PGX_WAIT0
#undef PGX_WRITE_B
#undef PGX_COMPUTE
#undef PGX_BARRIER
}
struct EpiHMx {
    bf16* HM;
    __device__ __forceinline__ void operator()(const f32x4 (&acc)[2][2][4][2], const MoeUnit& u, int wr, int wc, int fr, int fq) const {
        if (u.hs >= 0 && wc >= 2) return;
        const int row0 = u.row0 + wr * 64 + fr, col0 = u.pn * 128 + (u.hs > 0 ? 64 : 0) + wc * 32 + 4 * fq;
#pragma unroll
        for (int ai = 0; ai < 2; ++ai)
#pragma unroll
            for (int mm = 0; mm < 4; ++mm)
#pragma unroll
                for (int n = 0; n < 2; ++n) { const f32x4 g0 = acc[ai][0][mm][n], u0 = acc[ai][1][mm][n];
                    v2u w; w.x = cvt_pk_bf16(silu_f(g0[0]) * u0[0], silu_f(g0[1]) * u0[1]); w.y = cvt_pk_bf16(silu_f(g0[2]) * u0[2], silu_f(g0[3]) * u0[3]);
                    *(v2u*)(HM + (size_t)(row0 + ai * 128 + mm * 16) * DE + col0 + 16 * n) = w; }
    }
};
struct EpiYx {
    bf16* Y;
    __device__ __forceinline__ void operator()(const f32x4 (&acc)[2][2][4][2], const MoeUnit& u, int wr, int wc, int fr, int fq) const {
        if (u.hs >= 0 && wc >= 2) return;
        const int row0 = u.row0 + wr * 64 + fr, col0 = u.pn * 256 + (u.hs > 0 ? 64 : 0) + wc * 32 + 4 * fq;
#pragma unroll
        for (int ai = 0; ai < 2; ++ai)
#pragma unroll
            for (int mm = 0; mm < 4; ++mm)
#pragma unroll
                for (int bj = 0; bj < 2; ++bj)
#pragma unroll
                    for (int n = 0; n < 2; ++n) { const f32x4 v = acc[ai][bj][mm][n]; v2u w; w.x = cvt_pk_bf16(v[0], v[1]); w.y = cvt_pk_bf16(v[2], v[3]); *(v2u*)(Y + (size_t)(row0 + ai * 128 + mm * 16) * D + col0 + bj * 128 + 16 * n) = w; }
    }
};

struct EpiYk {
    bf16* Y; bf16* Y2;
    template <int PITCH> __device__ __forceinline__ void put(const f32x4 (&acc)[2][2][4][2], bf16* base, int wr, int wc, int fr, int fq) const {
        int r_ = wr * 64 + fr; asm volatile("" : "+v"(r_));
        bf16* p = base + (size_t)r_ * PITCH + wc * 32 + 4 * fq;
#pragma unroll
        for (int ai = 0; ai < 2; ++ai)
#pragma unroll
            for (int mm = 0; mm < 4; ++mm)
#pragma unroll
                for (int bj = 0; bj < 2; ++bj)
#pragma unroll
                    for (int n = 0; n < 2; ++n) { const f32x4 v = acc[ai][bj][mm][n]; v2u w; w.x = cvt_pk_bf16(v[0], v[1]); w.y = cvt_pk_bf16(v[2], v[3]); *(v2u*)(p + (size_t)(ai * 128 + mm * 16) * PITCH + bj * 128 + 16 * n) = w; }
    }
    __device__ __forceinline__ void operator()(const f32x4 (&acc)[2][2][4][2], const MoeUnit& u, int wr, int wc, int fr, int fq) const {
        if (u.hs > 0) put<256>(acc, Y2 + (size_t)u.tq * 65536, wr, wc, fr, fq); else put<D>(acc, Y + (size_t)u.row0 * D + u.pn * 256, wr, wc, fr, fq);
    }
};

template <bool SPLIT>
__device__ __forceinline__ void p9_tokens(const Args& a, const MoeTab& tab, int lane, int gw, int NGW, int ks_gn, int ks_full) {
    unsigned char* ws = a.ws;
    const float* MOD = (const float*)(ws + WS_MOD); const float* X1 = (const float*)(ws + WS_X1); const bf16* Y = (const bf16*)(ws + WS_Y); const float* gf = a.in[I_NFG];
    const bf16* Y2 = (const bf16*)(ws + WS_Y2); const bf16* ZR = (const bf16*)(ws + WS_ZERO);
    f32x4 gfv[8];
#pragma unroll
    for (int j = 0; j < 8; ++j) gfv[j] = *((const f32x4*)gf + lane + 64 * j);
    int ne0 = 0, ne1 = 0, np0 = 0, np1 = 0; float nw0 = 0.f, nw1 = 0.f;
    if (gw < T) { ne0 = route_eid(ws)[2 * gw]; ne1 = route_eid(ws)[2 * gw + 1]; np0 = route_pos(ws)[2 * gw]; np1 = route_pos(ws)[2 * gw + 1]; nw0 = route_cw(ws)[2 * gw]; nw1 = route_cw(ws)[2 * gw + 1]; }
    for (int t = gw; t < T; t += NGW) {
        const int b = t / SEQ;
        const int e0 = ne0, e1 = ne1;
        const int rr0 = __builtin_amdgcn_readfirstlane(tab.tpre[e0] * MT + np0), rr1 = __builtin_amdgcn_readfirstlane(tab.tpre[e1] * MT + np1);
        const size_t r0 = (size_t)rr0, r1 = (size_t)rr1;
        const float w0 = nw0, w1 = nw1;
        { const int tn = t + NGW; if (tn < T) { ne0 = route_eid(ws)[2 * tn]; ne1 = route_eid(ws)[2 * tn + 1]; np0 = route_pos(ws)[2 * tn]; np1 = route_pos(ws)[2 * tn + 1]; nw0 = route_cw(ws)[2 * tn]; nw1 = route_cw(ws)[2 * tn + 1]; } }
        const GAS f32x4* xr = (const GAS f32x4*)(X1 + (size_t)t * D) + lane; const GAS v2u* y0 = (const GAS v2u*)(Y + r0 * D) + lane; const GAS v2u* y1 = (const GAS v2u*)(Y + r1 * D) + lane;
        const f32x4* g2 = (const f32x4*)(MOD + (size_t)b * MODC + 5 * D) + lane;
        f32x4 v[8]; float s = 0.f;
#pragma unroll
        for (int j = 0; j < 8; ++j) { v2u a0 = y0[64 * j], a1 = y1[64 * j]; const f32x4 gg = g2[64 * j];
            float p0[4] = {bflo(a0.x), bfhi(a0.x), bflo(a0.y), bfhi(a0.y)}, p1[4] = {bflo(a1.x), bfhi(a1.x), bflo(a1.y), bfhi(a1.y)};
            if constexpr (SPLIT) {
                const int q0 = j * ks_gn + (rr0 >> 8) - ks_full, q1 = j * ks_gn + (rr1 >> 8) - ks_full;
                const bf16* z0 = q0 >= 0 ? Y2 + ((size_t)q0 * 256 + (rr0 & 255)) * 256 : ZR; const bf16* z1 = q1 >= 0 ? Y2 + ((size_t)q1 * 256 + (rr1 & 255)) * 256 : ZR;
                const v2u b0 = *((const GAS v2u*)z0 + lane), b1 = *((const GAS v2u*)z1 + lane);
                p0[0] += bflo(b0.x); p0[1] += bfhi(b0.x); p0[2] += bflo(b0.y); p0[3] += bfhi(b0.y);
                p1[0] += bflo(b1.x); p1[1] += bfhi(b1.x); p1[2] += bflo(b1.y); p1[3] += bfhi(b1.y); }
            f32x4 y; y.x = w0 * p0[0] + w1 * p1[0]; y.y = w0 * p0[1] + w1 * p1[1]; y.z = w0 * p0[2] + w1 * p1[2]; y.w = w0 * p0[3] + w1 * p1[3];
            v[j] = xr[64 * j] + gg * y; s += (v[j].x * v[j].x + v[j].y * v[j].y) + (v[j].z * v[j].z + v[j].w * v[j].w); }
        const float rstd = rsqrtf(wave_sum(s) * (1.f / D) + EPS);
        GAS f32x4* o = (GAS f32x4*)(a.out + (size_t)t * D) + lane;
#pragma unroll
        for (int j = 0; j < 8; ++j) o[64 * j] = v[j] * rstd * gfv[j];
    }
}
__device__ __forceinline__ void p9_final(const Args& a, LAS unsigned char* lds, int tid, int lane, int wave, int vcu, int G) {
    MoeTab tab = moe_tab(lds);
    const int gw = vcu * NWAVES + wave, NGW = G * NWAVES;
    const int ks_gn = tab.tpre[NE], ks_total = ks_gn * 8, ks_full = (ks_total / G) * G; const bool ks_split = MOE_KSPLIT && (ks_total - ks_full) > 0 && 2 * (ks_total - ks_full) <= G;
    if (ks_split) p9_tokens<true>(a, tab, lane, gw, NGW, ks_gn, ks_full); else p9_tokens<false>(a, tab, lane, gw, NGW, ks_gn, ks_full);
}
constexpr size_t NG8 = (size_t)NE * D * DE / 8;
struct SideCvt {
    static constexpr bool ON = true;
    const float* wsrc[3]; bf16* WGU; bf16* WDn; size_t GT; unsigned vsrc, vgu, vdn; int spm, sl, sl_end;
    __device__ __forceinline__ void init(const Args& a, size_t gt, size_t GT_, int first, int last) { wsrc[0] = a.in[I_WG]; wsrc[1] = a.in[I_WU]; wsrc[2] = a.in[I_WD]; WGU = (bf16*)(a.ws + WS_WGU); WDn = (bf16*)(a.ws + WS_WD);
        GT = GT_; spm = (int)(NG8 / GT); sl = first; sl_end = last;
        const size_t i0 = gt * 8; const size_t ek0 = i0 / DE; const int n0 = (int)(i0 % DE);
        vsrc = (unsigned)(i0 * 4); vgu = (unsigned)((ek0 * (2 * DE) + (n0 / 128) * 256 + (n0 % 128)) * 2); vdn = (unsigned)(i0 * 2); }
    __device__ __forceinline__ void load(f32x4 (&v)[2][2]) {
#pragma unroll
        for (int j = 0; j < 2; ++j) { const int s = (sl + j < sl_end) ? sl + j : sl_end - 1; const int which = s >= 2 * spm ? 2 : (s >= spm ? 1 : 0); const int r = s - which * spm;
            const float* sb = (which == 2 ? wsrc[2] : which == 1 ? wsrc[1] : wsrc[0]) + (size_t)r * GT * 8;
            asm volatile("global_load_dwordx4 %0, %1, %2 nt" : "=&v"(v[j][0]) : "v"(vsrc), "s"(sb) : "memory");
            asm volatile("global_load_dwordx4 %0, %1, %2 offset:16 nt" : "=&v"(v[j][1]) : "v"(vsrc), "s"(sb) : "memory"); }
        sl += 2;
    }
    template <int NWAIT> __device__ __forceinline__ void store(f32x4 (&v)[2][2]) {
        if constexpr (NWAIT == 16) asm volatile("s_waitcnt vmcnt(16)" : "+v"(v[0][0]), "+v"(v[0][1]), "+v"(v[1][0]), "+v"(v[1][1]) :: "memory");
        else asm volatile("s_waitcnt vmcnt(0)" : "+v"(v[0][0]), "+v"(v[0][1]), "+v"(v[1][0]), "+v"(v[1][1]) :: "memory");
#pragma unroll
        for (int j = 0; j < 2; ++j) { const int s = (sl - 2 + j < sl_end) ? sl - 2 + j : sl_end - 1; const int which = s >= 2 * spm ? 2 : (s >= spm ? 1 : 0); const int r = s - which * spm;
            v4u o; o.x = cvt_pk_bf16(v[j][0].x, v[j][0].y); o.y = cvt_pk_bf16(v[j][0].z, v[j][0].w); o.z = cvt_pk_bf16(v[j][1].x, v[j][1].y); o.w = cvt_pk_bf16(v[j][1].z, v[j][1].w);
            char* db = which == 2 ? (char*)WDn + (size_t)r * GT * 16 : (char*)WGU + (size_t)r * GT * 32 + (which == 1 ? 256 : 0);
            const unsigned vo = which == 2 ? vdn : vgu;
            *(v4u*)(db + vo) = o; }
    }
};

__global__ void __launch_bounds__(NWAVES * 64, 2) mega(Args args) {
    extern __shared__ __attribute__((aligned(16))) unsigned char lds_raw[];
    LAS unsigned char* lds = (LAS unsigned char*)lds_raw;
    volatile LAS unsigned* MISC = (volatile LAS unsigned*)(lds + MISC_OFF);
    const int tid = threadIdx.x, lane = tid & 63, wave = __builtin_amdgcn_readfirstlane(tid >> 6);
    const int G = gridDim.x; const int bx = blockIdx.x; const int vcu = (G % 8 == 0) ? (bx % 8) * (G / 8) + bx / 8 : bx;
    unsigned char* ws = args.ws;
    gu32* ctl = (gu32*)(ws + WS_CTL);
    for (int u = tid; u < (LDS_BYTES - LDSCTL_OFF) / 4; u += NWAVES * 64) ((LAS unsigned*)(lds + LDSCTL_OFF))[u] = 0u;
    __syncthreads();
    const int lo = args.ph_lo, hi = args.ph_hi;
    XcdBarrier bar; bar.bar = (unsigned*)(ctl + CW_BAR) + lo * XCD_BAR_WORDS; bar.x = 0; bar.st = nullptr;
    if (hi - lo > 1) bar = xcd_barrier_post((unsigned*)(ctl + CW_BAR) + lo * XCD_BAR_WORDS, MISC + 8);
#if SIDE_CVT
    const bool side_ok = (NG8 % ((size_t)G * 512)) == 0; const int side_spm = (int)(NG8 / ((size_t)G * 512));
    int sdn_sl = 2 * side_spm;
#define SDN_BEGIN() SideCvt sdn; sdn.init(args, (size_t)bx * 512 + tid, (size_t)G * 512, sdn_sl, 3 * side_spm)
#define SDN_END() sdn_sl = sdn.sl
#else
    const bool side_ok = false;
#endif
#define IN(k) (lo <= (k) && (k) < hi)
#define SEAM(k) do { if (IN(k) && IN((k) + 1)) xcd_barrier(bar, threadIdx.x == 0); } while (0)

    if (IN(0)) { p0_prologue(args, lds, tid, lane, wave, vcu, G, false); } SEAM(0);
    if (IN(1)) { p1_norm(args, lds, tid, lane, wave, G); } SEAM(1);
    if (IN(2)) {
        pg8::StaticOrder S; S.init((const bf16*)(ws + WS_H), (const bf16*)(ws + WS_WIN), T, INC, G, bx);
        EpiBf16 E{(bf16*)(ws + WS_U), INC};
#if SIDE_CVT
        if (side_ok) {
            SideCvt sd; sd.init(args, (size_t)bx * 512 + tid, (size_t)G * 512, 0, 2 * side_spm);
            pg8::gemm_phase<EpiBf16, pg8::StaticOrder, true, false, false, SideCvt>(lds + RING_OFF, D, S, E, &sd);
            while (sd.sl < sd.sl_end) { f32x4 sv[2][2]; sd.load(sv); sd.store<0>(sv); }
        } else
#endif
        pg8::gemm_phase<EpiBf16, pg8::StaticOrder, true, false>(lds + RING_OFF, D, S, E);
#if PG8_HALF_TAIL
        { pg8::StaticOrder S2 = S; S2.tail = 1; EpiBf16H E2{(bf16*)(ws + WS_U), INC};
          pg8::gemm_phase<EpiBf16H, pg8::StaticOrder, true, false, false, pg8::NoSide, true>(lds + RING_OFF, D, S2, E2); }
#endif
    } SEAM(2);
    if (IN(3)) { for (int u = bx; u < NB * RH * NCH; u += G) p3a_unit(args, lds, u, tid, lane, wave);
#if LATE_W4
        __syncthreads(); late_w4_convert(args, lds, lane, wave, vcu, G);
#endif
    } SEAM(3);
    if (IN(4)) { p3b_scan_conv(args, tid, lane, wave, vcu, G); } SEAM(4);
    if (IN(5)) { for (int u = bx; u < NB * RH * NCH; u += G) p3c_unit(args, lds, u, tid, lane, wave); } SEAM(5);
    if (IN(6)) {
        pg8::StaticOrder S; S.init((const bf16*)(ws + WS_A4), (const bf16*)(ws + WS_W4), T, D, G, bx);
        EpiMG2 E{(const bf16*)(ws + WS_U), (bf16*)(ws + WS_MG)};
        pg8::gemm_phase<EpiMG2, pg8::StaticOrder, true, false, false, pg8::NoSide, false, true>(lds + RING_OFF, K4, S, E);
    } SEAM(6);
    if (IN(7)) {
        pg8::StaticOrder S; S.init((const bf16*)(ws + WS_MG), (const bf16*)(ws + WS_WO), T, D, G, bx);
        EpiX1 E{args.in[I_X], (const float*)(ws + WS_MOD), (float*)(ws + WS_X1)};
#if SIDE_CVT
        if (side_ok) { SDN_BEGIN(); pg8::gemm_phase<EpiX1, pg8::StaticOrder, true, false, false, SideCvt>(lds + RING_OFF, D, S, E, &sdn);
            while (sdn.sl < sdn.sl_end) { f32x4 sv[2][2]; sdn.load(sv); sdn.store<0>(sv); } } else
#endif
        pg8::gemm_phase<EpiX1, pg8::StaticOrder, true, false>(lds + RING_OFF, D, S, E);
    } SEAM(7);
    if (IN(8)) { p6_route(args, lds, tid, lane, wave, G); } SEAM(8);
    if (IN(9)) {
        moe_build_tab(args, lds, tid);
#if MOE_E
        EpiHMe E{(bf16*)(ws + WS_HM)};
        moe_gemmE<true, EpiHMe>(lds, D, moe_tab(lds), G, vcu, (const char*)(ws + WS_H), route_list(ws), args.in[I_WG], args.in[I_WU], (size_t)D * DE, DE, 64, E);
#elif MOE_MT == 256
        EpiHMx E{(bf16*)(ws + WS_HM)};
                moe_gemm256<true, EpiHMx>(lds, D, moe_tab(lds), G, vcu, (const char*)(ws + WS_H), route_list(ws), args.in[I_WG], args.in[I_WU], (size_t)D * DE, DE, 128, E);
#else
        EpiHMm E{(bf16*)(ws + WS_HM)};
        moe_gemm<true, EpiHMm>(lds, D, moe_tab(lds), G, vcu, (const char*)(ws + WS_H), route_list(ws), args.in[I_WG], args.in[I_WU], (size_t)D * DE, DE, 128, E);
#endif
    } SEAM(9);
    if (IN(10)) {
        if (lo == 10) moe_build_tab(args, lds, tid);
#if MOE_E
        EpiYe E{(bf16*)(ws + WS_Y)};
        moe_gemmE<false, EpiYe>(lds, DE, moe_tab(lds), G, vcu, (const char*)(ws + WS_HM), nullptr, args.in[I_WD], args.in[I_WD] + 64, (size_t)DE * D, D, 128, E);
#elif MOE_MT == 256
#if MOE_KSPLIT
        EpiYk E{(bf16*)(ws + WS_Y), (bf16*)(ws + WS_Y2)};
        moe_gemm256<false, EpiYk, true>(lds, DE, moe_tab(lds), G, vcu, (const char*)(ws + WS_HM), nullptr, args.in[I_WD], args.in[I_WD] + 128, (size_t)DE * D, D, 256, E);
#else
        EpiYx E{(bf16*)(ws + WS_Y)};
        moe_gemm256<false, EpiYx>(lds, DE, moe_tab(lds), G, vcu, (const char*)(ws + WS_HM), nullptr, args.in[I_WD], args.in[I_WD] + 128, (size_t)DE * D, D, 256, E);
#endif
#else
        EpiYm E{(bf16*)(ws + WS_Y)};
        moe_gemm<false, EpiYm>(lds, DE, moe_tab(lds), G, vcu, (const char*)(ws + WS_HM), nullptr, args.in[I_WD], args.in[I_WD] + 128, (size_t)DE * D, D, 256, E);
#endif
    }
    if (IN(10) && IN(11)) xcd_barrier(bar, wave == 0 && lane_id() == 0);
    if (IN(11)) { const int lane2 = lane_id(), tid2 = wave * 64 + lane2; if (lo == 11) moe_build_tab(args, lds, tid2); p9_final(args, lds, tid2, lane2, wave, vcu, G); }
#undef IN
#undef SEAM
}
#ifndef MK_ONE_LAUNCH
#define MK_ONE_LAUNCH 0
#endif
constexpr int N_PHASES = 12;
extern "C" void kernel_launch(void* const* d_in, const int* in_sizes, int n_in, void* d_out, int out_size, void* d_ws, size_t ws_size, hipStream_t stream) {
    static int grid = 0;
    if (grid == 0) {
        int dev = 0, cus = 0;
        if (hipGetDevice(&dev) != hipSuccess || hipDeviceGetAttribute(&cus, hipDeviceAttributeMultiprocessorCount, dev) != hipSuccess) { grid = -1; return; }
        if (hipFuncSetAttribute((const void*)mega, hipFuncAttributeMaxDynamicSharedMemorySize, LDS_BYTES) != hipSuccess) { fprintf(stderr, "hipFuncSetAttribute failed\n"); grid = -1; return; }
        if (ws_size < WS_END || n_in != 19) { fprintf(stderr, "ws too small / bad inputs: %zu < %zu\n", ws_size, (size_t)WS_END); grid = -1; return; }
        int per_cu = 0;
        if (hipOccupancyMaxActiveBlocksPerMultiprocessor(&per_cu, (const void*)mega, NWAVES * 64, LDS_BYTES) != hipSuccess || per_cu < 1) fprintf(stderr, "occupancy query: %d\n", per_cu);
        (void)hipGetLastError();
        grid = cus;
    }
    if (grid < 0) return;
    unsigned char* ws = (unsigned char*)d_ws;
    (void)hipMemsetAsync(ws + WS_CTL, 0, CTL_ZERO_BYTES, stream);
    Args a{};
    for (int i = 0; i < 19; ++i) a.in[i] = (const float*)d_in[i];
    a.out = (float*)d_out; a.ws = ws;
#if MK_ONE_LAUNCH
    a.ph_lo = 0; a.ph_hi = N_PHASES; hipLaunchKernelGGL(mega, dim3(grid), dim3(NWAVES * 64), LDS_BYTES, stream, a);
#ifdef PROBE_EXTRA
    a.ph_lo = PROBE_EXTRA; a.ph_hi = PROBE_EXTRA + 1; hipLaunchKernelGGL(mega, dim3(grid), dim3(NWAVES * 64), LDS_BYTES, stream, a);
#endif
#else
    for (int ph = 0; ph < N_PHASES; ++ph) { a.ph_lo = ph; a.ph_hi = ph + 1; hipLaunchKernelGGL(mega, dim3(grid), dim3(NWAVES * 64), LDS_BYTES, stream, a); }
#endif
}
```

```cpp
#define MK_ONE_LAUNCH 1
#include <hip/hip_runtime.h>
#include <cstdint>
#include <cstdio>

constexpr int D = 2048, NB = 4, SEQ = 2048, T = NB * SEQ;
constexpr int CONV_CH = 1024, RH = 8, DK = 128, DV = 256, RQK = 1024, RV = 2048, CHUNK = 128, NCH = SEQ / CHUNK;
constexpr int NE = 32, DE = 1024, NA = T * 2;
constexpr int INC = 13312, MODC = 6 * D;
constexpr int OFF_CB = 0, OFF_CC = 1024, OFF_CX = 2048, OFF_Q = 3072, OFF_K = 4096, OFF_V = 5120, OFF_RG = 7168, OFF_GA = 9216, OFF_GB = 11264;
constexpr float EPS = 1e-6f;
constexpr int ADA_KS = 16;
#ifndef MOE_MT
#define MOE_MT 256
#endif
constexpr int RPAD = NA + NE * MOE_MT;

constexpr size_t al256(size_t x) { return (x + 255) & ~(size_t)255; }
constexpr size_t WS_CTL = 0, CTL_ZERO_BYTES = 1u << 20;
constexpr size_t WS_ZERO = WS_CTL + (768u << 10);
constexpr size_t WS_MODP = WS_CTL + CTL_ZERO_BYTES;
constexpr size_t WS_MOD = WS_MODP + al256((size_t)ADA_KS * 4 * MODC * 4);
constexpr size_t WS_ROPE = WS_MOD + al256((size_t)4 * MODC * 4);
constexpr size_t WS_WRT = WS_ROPE + al256((size_t)2 * SEQ * 64 * 4);
constexpr size_t WS_WIN = WS_WRT + al256((size_t)2 * 48 * D * 2);
constexpr int K4 = CONV_CH + RV;
constexpr size_t WS_W4 = WS_WIN + al256((size_t)INC * D * 2);
constexpr size_t WS_WO = WS_W4 + al256((size_t)D * K4 * 2);
constexpr size_t WS_WGU = WS_WO + al256((size_t)D * D * 2);
constexpr size_t WS_WD = WS_WGU + al256((size_t)NE * 2 * DE * D * 2);
constexpr size_t WS_H = WS_WD + al256((size_t)NE * D * DE * 2);
constexpr size_t WS_U = WS_H + al256((size_t)T * D * 2);
constexpr size_t WS_KVT = WS_U + al256((size_t)T * INC * 2);
constexpr size_t WS_SPT = WS_KVT + al256((size_t)NB * RH * NCH * DV * DK * 2);
constexpr size_t WS_A4 = WS_SPT + al256((size_t)NB * RH * NCH * DV * DK * 2);
constexpr size_t WS_T1 = WS_A4 + al256((size_t)T * K4 * 2);
constexpr size_t WS_MG = WS_T1 + al256((size_t)T * D * 2);
constexpr size_t WS_X1 = WS_MG + al256((size_t)T * D * 2);
constexpr size_t WS_ROUTE = WS_X1 + al256((size_t)T * D * 4);
constexpr size_t WS_END = WS_ROUTE + al256((size_t)NA * 12) + al256((size_t)NE * T * 4);
constexpr size_t WS_HM = WS_U;
constexpr size_t WS_Y = WS_HM + al256((size_t)RPAD * DE * 2);
constexpr size_t WS_Y2 = WS_Y + al256((size_t)RPAD * D * 2);
static_assert(WS_Y2 + (size_t)128 * 65536 * 2 <= WS_KVT, "HM/Y/Y2 overlay fits inside U");
#ifndef P0_T64
#define P0_T64 1
#endif
#ifndef TAIL_W4
#define TAIL_W4 1
#endif
#ifndef P0_V2
#define P0_V2 1
#endif
#ifndef MOE_TAILSPLIT
#define MOE_TAILSPLIT 0
#endif
#ifndef MOE_KSPLIT
#define MOE_KSPLIT 0
#endif
constexpr int CW_CNT = 64;
constexpr int CW_BAR = 4096;

constexpr int RING_OFF = 0, RING_BYTES = 131072;
constexpr int LDSCTL_OFF = RING_BYTES, MISC_OFF = LDSCTL_OFF + 320;
constexpr int LDSTAB_OFF = MISC_OFF + 128;
constexpr int LDS_BYTES = 147456;
constexpr int NWAVES = 8;

#define GAS __attribute__((address_space(1)))
#define LAS __attribute__((address_space(3)))
typedef unsigned short bf16;
typedef unsigned v4u __attribute__((ext_vector_type(4)));
typedef unsigned v2u __attribute__((ext_vector_type(2)));
typedef float f32x4 __attribute__((ext_vector_type(4)));
typedef short bf16x8 __attribute__((ext_vector_type(8)));
typedef short bf16x4 __attribute__((ext_vector_type(4)));
typedef GAS unsigned gu32;
#define RLX_AGENT __ATOMIC_RELAXED, __HIP_MEMORY_SCOPE_AGENT
#define LDS_WAIT() asm volatile("s_waitcnt lgkmcnt(0)" ::: "memory")
#define VM_WAIT() asm volatile("s_waitcnt vmcnt(0)" ::: "memory")
__device__ __forceinline__ unsigned f2bf(float f) { unsigned u = __builtin_bit_cast(unsigned, f); return (u + 0x7fffu + ((u >> 16) & 1u)) >> 16; }
__device__ __forceinline__ unsigned pk2(float lo, float hi) { return f2bf(lo) | (f2bf(hi) << 16); }
__device__ __forceinline__ float bf2f(unsigned short b) { return __builtin_bit_cast(float, (unsigned)b << 16); }
__device__ __forceinline__ float bflo(unsigned w) { return __builtin_bit_cast(float, w << 16); }
__device__ __forceinline__ float bfhi(unsigned w) { return __builtin_bit_cast(float, w & 0xffff0000u); }
__device__ __forceinline__ float silu_f(float v) { return v * __builtin_amdgcn_rcpf(1.f + __expf(-v)); }
__device__ __forceinline__ float sigm_f(float v) { return __builtin_amdgcn_rcpf(1.f + __expf(-v)); }
__device__ __forceinline__ float wave_sum(float v) {
#pragma unroll
    for (int o = 1; o < 64; o <<= 1) v += __shfl_xor(v, o);
    return v;
}

#define XB_TMO      128
#define XB_XCNT(j)  (256  + 64 * (j))
#define XB_XSUB(j)  (1280 + 64 * (j))
#define XB_XGEN(j)  (2304 + 64 * (j))
#define XB_TOP      3328
#define XB_TOPGEN   3392
#define XCD_BAR_WORDS 3456
#define XB_SPIN_CAP (1u << 18)
__device__ __forceinline__ unsigned xb_ld(unsigned* p)              { return __hip_atomic_load(p, __ATOMIC_RELAXED, __HIP_MEMORY_SCOPE_AGENT); }
__device__ __forceinline__ unsigned xb_add(unsigned* p, unsigned v) { return __hip_atomic_fetch_add(p, v, __ATOMIC_RELAXED, __HIP_MEMORY_SCOPE_AGENT); }
__device__ __forceinline__ unsigned xb_xcc_id() { return (unsigned)__builtin_amdgcn_s_getreg((3 << 11) | 20) & 0xFu; }
#define XB_SPIN(cond, bar) do { unsigned _sp = 0; while (cond) { __builtin_amdgcn_s_sleep(1); \
    if ((++_sp & 255u) == 0u) { if (xb_ld(&(bar)[XB_TMO])) break; if (_sp > XB_SPIN_CAP) { atomicAdd(&(bar)[XB_TMO], 1u); break; } } } } while (0)
struct XcdBarrier { unsigned* bar; unsigned x; volatile LAS unsigned* st; };
__device__ __forceinline__ XcdBarrier xcd_barrier_post(unsigned* bar, volatile LAS unsigned* st) {
    XcdBarrier b; b.bar = bar; b.x = xb_xcc_id(); b.st = st;
    if (threadIdx.x == 0) (void)xb_add(&bar[XB_XCNT(b.x)], 1u);
    return b;
}
__device__ __forceinline__ void xcd_barrier_complete(unsigned* bar, unsigned x, unsigned& nloc, unsigned& nx) {
    const unsigned G = gridDim.x * gridDim.y * gridDim.z;
    unsigned sum, cnt, mine, sp = 0u;
    for (;;) {
        sum = 0u; cnt = 0u; mine = 0u;
#pragma unroll
        for (unsigned j = 0; j < 16; ++j) { const unsigned c = xb_ld(&bar[XB_XCNT(j)]); sum += c; cnt += (c > 0u) ? 1u : 0u; mine = (j == x) ? c : mine; }
        if (sum == G) break;
        __builtin_amdgcn_s_sleep(1);
        if ((++sp & 255u) == 0u) { if (xb_ld(&bar[XB_TMO])) break; if (sp > XB_SPIN_CAP) { atomicAdd(&bar[XB_TMO], 1u); break; } }
    }
    nloc = mine > 0u ? mine : 1u; nx = cnt > 0u ? cnt : 1u;
}
__device__ __forceinline__ int lane_id() { return (int)__builtin_amdgcn_mbcnt_hi(~0u, __builtin_amdgcn_mbcnt_lo(~0u, 0u)); }
__device__ __forceinline__ void xcd_barrier(const XcdBarrier& b, const bool t0) {
    asm volatile("s_waitcnt vmcnt(0)" ::: "memory");
    __syncthreads();
    if (t0) {
        unsigned* bar = b.bar;
        __builtin_amdgcn_s_waitcnt(0);
        unsigned nloc = b.st[0], nx = b.st[1];
        if (nloc == 0u) { xcd_barrier_complete(bar, b.x, nloc, nx); b.st[0] = nloc; b.st[1] = nx; }
        const unsigned old = xb_add(&bar[XB_XSUB(b.x)], 1u);
        const unsigned gen = old / nloc;
        if (old + 1u == (gen + 1u) * nloc) {
            __builtin_amdgcn_fence(__ATOMIC_RELEASE, "agent");
            asm volatile("s_waitcnt vmcnt(0)" ::: "memory");
            const unsigned og = xb_add(&bar[XB_TOP], 1u);
            const unsigned tg = og / nx;
            if (og + 1u == (tg + 1u) * nx) xb_add(&bar[XB_TOPGEN], 1u);
            else XB_SPIN(xb_ld(&bar[XB_TOPGEN]) == tg, bar);
            __builtin_amdgcn_fence(__ATOMIC_ACQUIRE, "agent");
            xb_add(&bar[XB_XGEN(b.x)], 1u);
            asm volatile("s_waitcnt vmcnt(0)" ::: "memory");
        } else {
            XB_SPIN(xb_ld(&bar[XB_XGEN(b.x)]) == gen, bar);
            __builtin_amdgcn_fence(__ATOMIC_ACQUIRE, "agent");
            asm volatile("s_waitcnt vmcnt(0)" ::: "memory");
        }
    }
    __syncthreads();
}
namespace pg8 {
#define PG8_LAS __attribute__((address_space(3)))
typedef unsigned short bf16_t;
typedef short bf16x8 __attribute__((ext_vector_type(8)));
typedef float f32x4 __attribute__((ext_vector_type(4)));
typedef float f32x2 __attribute__((ext_vector_type(2)));
typedef unsigned u32x4 __attribute__((ext_vector_type(4)));
typedef unsigned u32x2 __attribute__((ext_vector_type(2)));
constexpr int BM = 256, BK = 64, HALF = 128, HTB = HALF * BK * 2  , STAGE_BYTES = 8 * HTB, NXCD = 8, WGM = 8;

__host__ __device__ __forceinline__ int lds_byte(int r, int c) { const int st = (r >> 4) * 2 + (c >> 5), rr = r & 15, cc = c & 31, ob = rr * 64 + cc * 2; return st * 1024 + (ob ^ (((ob >> 9) & 1) << 5)); }
__host__ __device__ __forceinline__ void stage_rc(int b, int& R, int& C) { const int st = b / 1024, sb = b % 1024, swz = sb ^ (((sb >> 9) & 1) << 5); R = (st >> 1) * 16 + swz / 64; C = (st & 1) * 32 + (swz % 64) / 2; }
__host__ __device__ __forceinline__ int perm32(int rho) { const int n = rho >> 4, i = rho & 15; return 8 * (i >> 2) + 4 * n + (i & 3); }

#ifndef PG8_HALF_TAIL
#define PG8_HALF_TAIL 0
#endif
struct Unit { int pm, pn, e, row0, half; };

struct StaticOrder {
    const bf16_t* A; const bf16_t* Bt; int nM, nN, nwg, G, c, tail = 0; static constexpr int ldb = 0;
    __device__ void init(const bf16_t* A_, const bf16_t* Bt_, int M, int N, int G_, int c_) { A = A_; Bt = Bt_; nM = M / BM; nN = N / BM; nwg = nM * nN; G = G_; c = c_; }
    __device__ bool next(int i, Unit& u) const {
        long L = (long)i * G + c; u.half = 0;
        { const int full = nwg / G, rem = nwg - full * G; const bool halved = PG8_HALF_TAIL && rem > 0 && 2 * rem <= G;
          if (tail) { if (!halved || i > 0 || c >= 2 * rem) return false; L = (long)full * G + (c >> 1); u.half = 1 + (c & 1); }
          else if (halved && i >= full) return false; }
        if (L >= nwg) return false;
        int wgid = (int)L; { const int q = nwg / NXCD, r = nwg % NXCD, xcd = wgid % NXCD, off = wgid / NXCD; wgid = (xcd < r ? xcd * (q + 1) : r * (q + 1) + (xcd - r) * q) + off; }
        const int nig = WGM * nN, gid = wgid / nig, fm = gid * WGM, gsz = (nM - fm) < WGM ? (nM - fm) : WGM;
        u.pm = fm + ((wgid % nig) % gsz); u.pn = (wgid % nig) / gsz; u.e = 0; u.row0 = u.pm * BM; return true;
    }
    __device__ __forceinline__ const char* a_tile(const Unit& u, size_t tstep) const { return (const char*)A + (size_t)u.pm * tstep; }
    __device__ __forceinline__ const char* b_tile(const Unit& u, size_t tstep) const { return (const char*)Bt + (size_t)u.pn * tstep + (u.half == 2 ? tstep / 2 : 0); }
    __device__ __forceinline__ void a_offsets(const Unit&, const int (&)[2], const int (&)[2], int, unsigned (&)[2][2]) const {}
};

__device__ __forceinline__ unsigned cvt_pk_bf16(float lo, float hi) { unsigned r; asm volatile("v_cvt_pk_bf16_f32 %0, %1, %2" : "=v"(r) : "v"(lo), "v"(hi)); return r; }

typedef short s16x4 __attribute__((ext_vector_type(4)));
struct NoSide { static constexpr bool ON = false; __device__ __forceinline__ void load(f32x4 (&)[2][2]) {} template <int N> __device__ __forceinline__ void store(f32x4 (&)[2][2]) {} };
template <class Epi, class Sched, bool ALIGN_EPI, bool GATHER, bool BKN = false, class Side = NoSide, bool HALFN = false, bool MIDHOOK = false>
__device__ __forceinline__ void gemm_phase(PG8_LAS unsigned char* lds, const int K, const Sched& S, const Epi& E, Side* side = nullptr) {
    const int tid = threadIdx.x, wid = __builtin_amdgcn_readfirstlane(tid >> 6), lane = tid & 63, wr = wid >> 2, wc = wid & 3, fr = lane & 15, fq = lane >> 4;
    const int nt = K / BK;
    unsigned voffA[2], voffB[2]; int stR[2], stC[2];
#pragma unroll
    for (int i = 0; i < 2; ++i) { int R, C; stage_rc(tid * 16 + i * 8192, R, C); const int Rb = Epi::PERM ? ((R & ~31) + perm32(R & 31)) : R;
        voffA[i] = (unsigned)(R * K + C) * 2u; voffB[i] = (unsigned)(Rb * K + C) * 2u; stR[i] = R; stC[i] = C;
        if constexpr (BKN) { const int b = tid * 16 + i * 8192, kk = b >> 8, chp = (b & 255) >> 4, ch = chp ^ (((kk & 3) << 2) | ((kk >> 2) & 3)); voffB[i] = (unsigned)(kk * S.ldb + 8 * ch) * 2u; } }
    const size_t kstep = (size_t)(BK * 2);
    const size_t hstep = (size_t)HALF * K * 2;
    const size_t tstep = 2 * hstep;
    const size_t kstepB = BKN ? (size_t)BK * S.ldb * 2 : kstep, hstepB = BKN ? (size_t)(HALF * 2) : hstep;
    const unsigned ldsw = (unsigned)wid * 1024u;
    const int aoff = lds_byte(wr * 64 + fr, fq * 8), boff = lds_byte(wc * 32 + fr, fq * 8);
    unsigned tb[2][2] = {{0u, 0u}, {0u, 0u}};
    if constexpr (BKN) { const int q = fr >> 2, p = lane & 3;
#pragma unroll
        for (int n = 0; n < 2; ++n)
#pragma unroll
            for (int t = 0; t < 2; ++t) { const int row = 8 * fq + 4 * t + q, ch = 2 * (2 * wc + n) + (p >> 1);
                tb[n][t] = (unsigned)(uintptr_t)lds + 4u * HTB + (unsigned)(256 * row + 16 * (ch ^ (((row & 3) << 2) | ((row >> 2) & 3))) + 8 * (p & 1)); } }
#define PG8_SA(b, h) (((b) * 2 + (h)) * HTB)
#define PG8_SB(b, h) ((4 + (b) * 2 + (h)) * HTB)
#define PG8_STAGE(bufoff, gbase, voff) do { _Pragma("unroll") for (int _i = 0; _i < 2; ++_i) \
        __builtin_amdgcn_global_load_lds((const unsigned*)((const char*)(gbase) + (voff)[_i]), (PG8_LAS unsigned*)(lds + (bufoff) + ldsw + _i * 8192), 16, 0, 0); } while (0)
#define PG8_STAGE_A(bufoff, gbase, h, VO) do { if constexpr (GATHER) { PG8_STAGE(bufoff, gbase, VO[h]); } else { PG8_STAGE(bufoff, (gbase) + (h) * hstep, voffA); } } while (0)
#define PG8_LDA(dst, b, h) do { _Pragma("unroll") for (int m = 0; m < 4; ++m) _Pragma("unroll") for (int k = 0; k < 2; ++k) dst[m][k] = *(const PG8_LAS bf16x8*)(lds + PG8_SA(b, h) + aoff + m * 2048 + k * 1024); } while (0)
#define PG8_TR(dst, vb, off) asm volatile("ds_read_b64_tr_b16 %0, %1 offset:%c2" : "=&v"(dst) : "v"(vb), "i"(off) : "memory")
#define PG8_LDB(dst, b, h) do { if constexpr (BKN) { _Pragma("unroll") for (int n = 0; n < 2; ++n) _Pragma("unroll") for (int k = 0; k < 2; ++k) { s16x4 _lo, _hi; \
            PG8_TR(_lo, tb[n][0], ((b) * 2 + (h)) * HTB + k * 8192); PG8_TR(_hi, tb[n][1], ((b) * 2 + (h)) * HTB + k * 8192); dst##L[n][k] = _lo; dst##H[n][k] = _hi; } } \
        else { _Pragma("unroll") for (int n = 0; n < 2; ++n) _Pragma("unroll") for (int k = 0; k < 2; ++k) dst[n][k] = *(const PG8_LAS bf16x8*)(lds + PG8_SB(b, h) + boff + n * 2048 + k * 1024); } } while (0)
#define PG8_BF(Bt, n, k) (BKN ? (bf16x8){Bt##L[n][k][0], Bt##L[n][k][1], Bt##L[n][k][2], Bt##L[n][k][3], Bt##H[n][k][0], Bt##H[n][k][1], Bt##H[n][k][2], Bt##H[n][k][3]} : Bt[n][k])
#define PG8_MMA(ai, bj, At, Bt) do { __builtin_amdgcn_s_setprio(1); _Pragma("unroll") for (int m = 0; m < 4; ++m) _Pragma("unroll") for (int n = 0; n < 2; ++n) _Pragma("unroll") for (int k = 0; k < 2; ++k) \
        acc[ai][bj][m][n] = __builtin_amdgcn_mfma_f32_16x16x32_bf16(PG8_BF(Bt, n, k), At[m][k], acc[ai][bj][m][n], 0, 0, 0); __builtin_amdgcn_s_setprio(0); } while (0)
#define PG8_WAIT_V(n) asm volatile("s_waitcnt vmcnt(" #n ")" ::: "memory")
#define PG8_WAIT_L(n) asm volatile("s_waitcnt lgkmcnt(" #n ")" ::: "memory")
#define PG8_BAR __builtin_amdgcn_s_barrier()
#define PG8_SCHED __builtin_amdgcn_sched_barrier(0)
#define PG8_TRIP(t) do { \
            const bool last = (t == nt - 2); \
            const char* a1 = cA + (size_t)(t + 1) * kstep; \
            const char* a2 = last ? nA : cA + (size_t)(t + 2) * kstep; const char* b2 = last ? nB : cB + (size_t)(t + 2) * kstepB; \
            const char* a3 = a2 + kstep; const char* b3 = b2 + kstepB; \
            unsigned vo2[2][2]; \
_Pragma("unroll") \
            for (int h = 0; h < 2; ++h) \
_Pragma("unroll") \
                for (int i = 0; i < 2; ++i) vo2[h][i] = last ? nxtVO[h][i] : curVO[h][i]; \
            f32x4 sv[2][2]; \
            if constexpr (Side::ON) { side->load(sv); PG8_SCHED; } \
            PG8_LDB(B0, 0, 0); PG8_LDB(B1, 0, 1); PG8_SCHED; PG8_LDA(At, 0, 0); PG8_STAGE_A(PG8_SA(1, 1), a1, 1, curVO); \
            if constexpr (Side::ON) PG8_WAIT_V(14); else PG8_WAIT_V(8); \
            PG8_WAIT_L(0); PG8_BAR; PG8_SCHED; PG8_MMA(0, 0, At, B0); if constexpr (!HALFN) PG8_MMA(0, 1, At, B1); PG8_BAR; PG8_SCHED; \
            PG8_LDA(At, 0, 1); PG8_STAGE(PG8_SB(0, 0), b2, voffB); PG8_STAGE(PG8_SB(0, 1), b2 + hstepB, voffB); PG8_STAGE_A(PG8_SA(0, 0), a2, 0, vo2); \
            if constexpr (Side::ON) PG8_WAIT_V(14); else PG8_WAIT_V(8); \
            PG8_WAIT_L(0); PG8_BAR; PG8_SCHED; PG8_MMA(1, 0, At, B0); if constexpr (!HALFN) PG8_MMA(1, 1, At, B1); PG8_BAR; PG8_SCHED; \
            PG8_LDB(B0, 1, 0); PG8_LDB(B1, 1, 1); PG8_SCHED; PG8_LDA(At, 1, 0); PG8_STAGE_A(PG8_SA(0, 1), a2, 1, vo2); \
            PG8_WAIT_V(8); PG8_WAIT_L(0); PG8_BAR; PG8_SCHED; PG8_MMA(0, 0, At, B0); if constexpr (!HALFN) PG8_MMA(0, 1, At, B1); PG8_BAR; PG8_SCHED; \
            PG8_LDA(At, 1, 1); PG8_STAGE(PG8_SB(1, 0), b3, voffB); PG8_STAGE(PG8_SB(1, 1), b3 + hstepB, voffB); PG8_STAGE_A(PG8_SA(1, 0), a3, 0, vo2); \
            PG8_WAIT_V(8); PG8_WAIT_L(0); PG8_BAR; PG8_SCHED; PG8_MMA(1, 0, At, B0); if constexpr (!HALFN) PG8_MMA(1, 1, At, B1); PG8_BAR; PG8_SCHED; \
            if constexpr (Side::ON) { side->template store<16>(sv); PG8_SCHED; } \
        } while (0)
    Unit cur, nxt; int ui = 0;
    if (!S.next(0, cur)) return;
    f32x4 acc[2][2][4][2];
#pragma unroll
    for (int a = 0; a < 2; ++a)
#pragma unroll
        for (int b = 0; b < 2; ++b)
#pragma unroll
            for (int m = 0; m < 4; ++m)
#pragma unroll
                for (int n = 0; n < 2; ++n) acc[a][b][m][n] = (f32x4){0.f, 0.f, 0.f, 0.f};
    bf16x8 At[4][2], B0[2][2], B1[2][2]; s16x4 B0L[2][2], B0H[2][2], B1L[2][2], B1H[2][2];
    unsigned curVO[2][2] = {{0u, 0u}, {0u, 0u}}, nxtVO[2][2] = {{0u, 0u}, {0u, 0u}};
    const char* cA = S.a_tile(cur, tstep); const char* cB = S.b_tile(cur, tstep);
    if constexpr (GATHER) S.a_offsets(cur, stR, stC, K, curVO);
    PG8_STAGE(PG8_SB(0, 0), cB, voffB); PG8_STAGE(PG8_SB(0, 1), cB + hstepB, voffB); PG8_STAGE_A(PG8_SA(0, 0), cA, 0, curVO); PG8_STAGE_A(PG8_SA(0, 1), cA, 1, curVO);
    if (wr == 1) PG8_BAR;
    PG8_WAIT_V(2); PG8_BAR;
    PG8_STAGE(PG8_SB(1, 0), cB + kstepB, voffB); PG8_STAGE_A(PG8_SA(1, 0), cA + kstep, 0, curVO); PG8_STAGE(PG8_SB(1, 1), cB + hstepB + kstepB, voffB);
    PG8_WAIT_V(6); PG8_BAR;
    for (;;) {
        const bool has_next = S.next(ui + 1, nxt);
        const char* nA = has_next ? S.a_tile(nxt, tstep) : cA; const char* nB = has_next ? S.b_tile(nxt, tstep) : cB;
        if constexpr (GATHER) { if (has_next) S.a_offsets(nxt, stR, stC, K, nxtVO); else {
#pragma unroll
            for (int h = 0; h < 2; ++h)
#pragma unroll
                for (int i = 0; i < 2; ++i) nxtVO[h][i] = curVO[h][i]; } }
        if constexpr (MIDHOOK) {
            for (int t = 0; t < Epi::MID_T; t += 2) PG8_TRIP(t);
            E.mid(acc, cur, wr, wc, fr, fq); PG8_SCHED;
            for (int t = Epi::MID_T; t < nt; t += 2) PG8_TRIP(t);
        } else { for (int t = 0; t < nt; t += 2) PG8_TRIP(t); }
        if constexpr (ALIGN_EPI) { if (wr == 0) PG8_BAR; }
        E(acc, cur, wr, wc, fr, fq);
        if (!has_next) break;
#pragma unroll
        for (int a = 0; a < 2; ++a)
#pragma unroll
            for (int b = 0; b < 2; ++b)
#pragma unroll
                for (int m = 0; m < 4; ++m)
#pragma unroll
                    for (int n = 0; n < 2; ++n) acc[a][b][m][n] = (f32x4){0.f, 0.f, 0.f, 0.f};
        cur = nxt; cA = nA; cB = nB; ++ui;
        if constexpr (GATHER) {
#pragma unroll
            for (int h = 0; h < 2; ++h)
#pragma unroll
                for (int i = 0; i < 2; ++i) curVO[h][i] = nxtVO[h][i]; }
        if constexpr (ALIGN_EPI) { if (wr == 1) PG8_BAR; }
    }
    PG8_WAIT_V(0);
    if constexpr (!ALIGN_EPI) { if (wr == 0) PG8_BAR; }
    PG8_BAR;
#undef PG8_TRIP
#undef PG8_SA
#undef PG8_SB
#undef PG8_STAGE
#undef PG8_STAGE_A
#undef PG8_LDA
#undef PG8_LDB
#undef PG8_TR
#undef PG8_BF
#undef PG8_MMA
#undef PG8_WAIT_V
#undef PG8_WAIT_L
#undef PG8_BAR
#undef PG8_SCHED
}
}
using pg8::Unit; using pg8::u32x4; using pg8::cvt_pk_bf16;
struct EpiBf16 {
    static constexpr bool PERM = true; bf16* O; int ldc;
    __device__ __forceinline__ void operator()(const f32x4 (&acc)[2][2][4][2], const Unit& u, int wr, int wc, int fr, int fq) const {
        const int row0 = u.row0 + wr * 64 + fr, col0 = u.pn * 256 + wc * 32 + 8 * fq;
#pragma unroll
        for (int ai = 0; ai < 2; ++ai)
#pragma unroll
            for (int m = 0; m < 4; ++m) { bf16* rowp = O + (size_t)(row0 + ai * 128 + m * 16) * ldc + col0;
#pragma unroll
                for (int bj = 0; bj < 2; ++bj) { const f32x4 v0 = acc[ai][bj][m][0], v1 = acc[ai][bj][m][1];
                    u32x4 w; w.x = cvt_pk_bf16(v0[0], v0[1]); w.y = cvt_pk_bf16(v0[2], v0[3]); w.z = cvt_pk_bf16(v1[0], v1[1]); w.w = cvt_pk_bf16(v1[2], v1[3]);
                    *(u32x4*)(rowp + bj * 128) = w; } }
    }
};

__device__ __forceinline__ void unpack8(const v4u w, float (&f)[8]) { f[0] = bflo(w.x); f[1] = bfhi(w.x); f[2] = bflo(w.y); f[3] = bfhi(w.y); f[4] = bflo(w.z); f[5] = bfhi(w.z); f[6] = bflo(w.w); f[7] = bfhi(w.w); }
struct EpiBf16H {
    static constexpr bool PERM = true; bf16* O; int ldc;
    __device__ __forceinline__ void operator()(const f32x4 (&acc)[2][2][4][2], const Unit& u, int wr, int wc, int fr, int fq) const {
        const int row0 = u.row0 + wr * 64 + fr, col0 = u.pn * 256 + (u.half == 2 ? 128 : 0) + wc * 32 + 8 * fq;
#pragma unroll
        for (int ai = 0; ai < 2; ++ai)
#pragma unroll
            for (int m = 0; m < 4; ++m) { const f32x4 v0 = acc[ai][0][m][0], v1 = acc[ai][0][m][1];
                u32x4 w; w.x = cvt_pk_bf16(v0[0], v0[1]); w.y = cvt_pk_bf16(v0[2], v0[3]); w.z = cvt_pk_bf16(v1[0], v1[1]); w.w = cvt_pk_bf16(v1[2], v1[3]);
                *(u32x4*)(O + (size_t)(row0 + ai * 128 + m * 16) * ldc + col0) = w; }
    }
};

struct EpiT1 {
    static constexpr bool PERM = true; const bf16* U; bf16* T1;
    __device__ __forceinline__ void operator()(const f32x4 (&acc)[2][2][4][2], const Unit& u, int wr, int wc, int fr, int fq) const {
        const int row0 = u.row0 + wr * 64 + fr, col0 = u.pn * 256 + wc * 32 + 8 * fq;
#pragma unroll
        for (int ai = 0; ai < 2; ++ai)
#pragma unroll
            for (int m = 0; m < 4; ++m) { const size_t r = (size_t)(row0 + ai * 128 + m * 16);
#pragma unroll
                for (int bj = 0; bj < 2; ++bj) { const int c = col0 + bj * 128; float ga[8]; unpack8(*(const v4u*)(U + r * INC + OFF_GA + c), ga);
                    const f32x4 v0 = acc[ai][bj][m][0], v1 = acc[ai][bj][m][1];
                    u32x4 w; w.x = cvt_pk_bf16(sigm_f(ga[0]) * v0[0], sigm_f(ga[1]) * v0[1]); w.y = cvt_pk_bf16(sigm_f(ga[2]) * v0[2], sigm_f(ga[3]) * v0[3]);
                    w.z = cvt_pk_bf16(sigm_f(ga[4]) * v1[0], sigm_f(ga[5]) * v1[1]); w.w = cvt_pk_bf16(sigm_f(ga[6]) * v1[2], sigm_f(ga[7]) * v1[3]);
                    *(u32x4*)(T1 + r * D + c) = w; } }
    }
};
struct EpiMG {
    static constexpr bool PERM = true; const bf16* U; const bf16* T1; bf16* MG;
    __device__ __forceinline__ void operator()(const f32x4 (&acc)[2][2][4][2], const Unit& u, int wr, int wc, int fr, int fq) const {
        const int row0 = u.row0 + wr * 64 + fr, col0 = u.pn * 256 + wc * 32 + 8 * fq;
#pragma unroll
        for (int ai = 0; ai < 2; ++ai)
#pragma unroll
            for (int m = 0; m < 4; ++m) { const size_t r = (size_t)(row0 + ai * 128 + m * 16);
#pragma unroll
                for (int bj = 0; bj < 2; ++bj) { const int c = col0 + bj * 128; float gb[8], t1[8]; unpack8(*(const v4u*)(U + r * INC + OFF_GB + c), gb); unpack8(*(const v4u*)(T1 + r * D + c), t1);
                    const f32x4 v0 = acc[ai][bj][m][0], v1 = acc[ai][bj][m][1];
                    u32x4 w; w.x = cvt_pk_bf16(t1[0] + sigm_f(gb[0]) * v0[0], t1[1] + sigm_f(gb[1]) * v0[1]); w.y = cvt_pk_bf16(t1[2] + sigm_f(gb[2]) * v0[2], t1[3] + sigm_f(gb[3]) * v0[3]);
                    w.z = cvt_pk_bf16(t1[4] + sigm_f(gb[4]) * v1[0], t1[5] + sigm_f(gb[5]) * v1[1]); w.w = cvt_pk_bf16(t1[6] + sigm_f(gb[6]) * v1[2], t1[7] + sigm_f(gb[7]) * v1[3]);
                    *(u32x4*)(MG + r * D + c) = w; } }
    }
};
struct EpiMG2 {
    static constexpr bool PERM = true; static constexpr int MID_T = CONV_CH / 64; const bf16* U; bf16* MG;
    __device__ __forceinline__ void mid(f32x4 (&acc)[2][2][4][2], const Unit& u, int wr, int wc, int fr, int fq) const {
        const unsigned vb0 = (unsigned)(((size_t)(u.row0 + wr * 64 + fr) * INC + (size_t)(u.pn * 256 + wc * 32 + 8 * fq)) * 2);
#pragma unroll
        for (int ai = 0; ai < 2; ++ai)
#pragma unroll
            for (int mp = 0; mp < 2; ++mp) {
                v4u va[2][2], vb[2][2];
#pragma unroll
                for (int mm = 0; mm < 2; ++mm)
#pragma unroll
                    for (int bj = 0; bj < 2; ++bj) { const unsigned off = vb0 + (unsigned)((((ai * 128 + (mp * 2 + mm) * 16) * INC) + bj * 128) * 2);
                        asm volatile("global_load_dwordx4 %0, %1, %2" : "=&v"(va[mm][bj]) : "v"(off + (unsigned)(OFF_GA * 2)), "s"(U) : "memory");
                        asm volatile("global_load_dwordx4 %0, %1, %2" : "=&v"(vb[mm][bj]) : "v"(off + (unsigned)(OFF_GB * 2)), "s"(U) : "memory"); }
                asm volatile("s_waitcnt vmcnt(0)" : "+v"(va[0][0]), "+v"(va[0][1]), "+v"(va[1][0]), "+v"(va[1][1]), "+v"(vb[0][0]), "+v"(vb[0][1]), "+v"(vb[1][0]), "+v"(vb[1][1]) :: "memory");
#pragma unroll
                for (int mm = 0; mm < 2; ++mm)
#pragma unroll
                    for (int bj = 0; bj < 2; ++bj) { const int m = mp * 2 + mm;
                        const unsigned wa[4] = {va[mm][bj].x, va[mm][bj].y, va[mm][bj].z, va[mm][bj].w}, wb[4] = {vb[mm][bj].x, vb[mm][bj].y, vb[mm][bj].z, vb[mm][bj].w};
#pragma unroll
                        for (int i = 0; i < 2; ++i) {
                            acc[ai][bj][m][0][2 * i] *= (1.f + __expf(-bflo(wb[i]))) * __builtin_amdgcn_rcpf(1.f + __expf(-bflo(wa[i])));
                            acc[ai][bj][m][0][2 * i + 1] *= (1.f + __expf(-bfhi(wb[i]))) * __builtin_amdgcn_rcpf(1.f + __expf(-bfhi(wa[i])));
                            acc[ai][bj][m][1][2 * i] *= (1.f + __expf(-bflo(wb[2 + i]))) * __builtin_amdgcn_rcpf(1.f + __expf(-bflo(wa[2 + i])));
                            acc[ai][bj][m][1][2 * i + 1] *= (1.f + __expf(-bfhi(wb[2 + i]))) * __builtin_amdgcn_rcpf(1.f + __expf(-bfhi(wa[2 + i]))); }
                        asm volatile("" : "+v"(acc[ai][bj][m][0]), "+v"(acc[ai][bj][m][1]) :: "memory"); }
                __builtin_amdgcn_sched_barrier(0); }
    }
    __device__ __forceinline__ void operator()(const f32x4 (&acc)[2][2][4][2], const Unit& u, int wr, int wc, int fr, int fq) const {
        const int row0 = u.row0 + wr * 64 + fr, col0 = u.pn * 256 + wc * 32 + 8 * fq;
        v4u gt[2][4][2];
#pragma unroll
        for (int ai = 0; ai < 2; ++ai)
#pragma unroll
            for (int m = 0; m < 4; ++m)
#pragma unroll
                for (int bj = 0; bj < 2; ++bj) gt[ai][m][bj] = *(const v4u*)(U + (size_t)(row0 + ai * 128 + m * 16) * INC + OFF_GB + col0 + bj * 128);
#pragma unroll
        for (int ai = 0; ai < 2; ++ai)
#pragma unroll
            for (int m = 0; m < 4; ++m) { const size_t r = (size_t)(row0 + ai * 128 + m * 16);
#pragma unroll
                for (int bj = 0; bj < 2; ++bj) { const int c = col0 + bj * 128; float gb[8]; unpack8(gt[ai][m][bj], gb);
                    const f32x4 v0 = acc[ai][bj][m][0], v1 = acc[ai][bj][m][1];
                    u32x4 w; w.x = cvt_pk_bf16(sigm_f(gb[0]) * v0[0], sigm_f(gb[1]) * v0[1]); w.y = cvt_pk_bf16(sigm_f(gb[2]) * v0[2], sigm_f(gb[3]) * v0[3]);
                    w.z = cvt_pk_bf16(sigm_f(gb[4]) * v1[0], sigm_f(gb[5]) * v1[1]); w.w = cvt_pk_bf16(sigm_f(gb[6]) * v1[2], sigm_f(gb[7]) * v1[3]);
                    *(u32x4*)(MG + r * D + c) = w; } }
    }
};

struct EpiX1 {
    static constexpr bool PERM = true; const float* X; const float* MOD; float* X1;
    __device__ __forceinline__ void operator()(const f32x4 (&acc)[2][2][4][2], const Unit& u, int wr, int wc, int fr, int fq) const {
        const int row0 = u.row0 + wr * 64 + fr, col0 = u.pn * 256 + wc * 32 + 8 * fq; const int b = u.row0 / SEQ;
        f32x4 gv[2][2];
#pragma unroll
        for (int bj = 0; bj < 2; ++bj)
#pragma unroll
            for (int n = 0; n < 2; ++n) gv[bj][n] = *(const f32x4*)(MOD + (size_t)b * MODC + 2 * D + col0 + bj * 128 + 4 * n);
#pragma unroll
        for (int ai = 0; ai < 2; ++ai) {
            f32x4 xv[4][2][2];
#pragma unroll
            for (int m = 0; m < 4; ++m)
#pragma unroll
                for (int bj = 0; bj < 2; ++bj)
#pragma unroll
                    for (int n = 0; n < 2; ++n) xv[m][bj][n] = *(const f32x4*)(X + (size_t)(row0 + ai * 128 + m * 16) * D + col0 + bj * 128 + 4 * n);
#pragma unroll
            for (int m = 0; m < 4; ++m)
#pragma unroll
                for (int bj = 0; bj < 2; ++bj)
#pragma unroll
                    for (int n = 0; n < 2; ++n) *(f32x4*)(X1 + (size_t)(row0 + ai * 128 + m * 16) * D + col0 + bj * 128 + 4 * n) = xv[m][bj][n] + gv[bj][n] * acc[ai][bj][m][n]; }
    }
};

struct Args { const float* in[19]; float* out; unsigned char* ws; int ph_lo, ph_hi; };
enum { I_X = 0, I_C, I_WADA, I_BADA, I_N1G, I_WIN, I_CONVW, I_WCO, I_WRO, I_WO, I_N2G, I_WRG, I_BRG, I_WRE, I_BRE, I_WG, I_WU, I_WD, I_NFG };

constexpr int I_WIN_N_ = (D / 64) * (INC / 32), I_WCO_N_ = (CONV_CH / 64) * (D / 32), I_WRO_N_ = (RV / 64) * (D / 32), I_WO_N_ = (D / 64) * (D / 32), I_TR_ALL = I_WIN_N_ + I_WCO_N_ + I_WRO_N_ + I_WO_N_;
__device__ __forceinline__ void transpose_item(const float* W, int ldw, int k0, int n0, bf16* dst, int ldk, LAS float* scr, int lane) {
#pragma unroll 8
    for (int i = 0; i < 32; ++i) { const int kk = 2 * i + (lane >> 5); scr[kk * 33 + (lane & 31)] = W[(size_t)(k0 + kk) * ldw + n0 + (lane & 31)]; }
    LDS_WAIT(); asm volatile("" ::: "memory");
    const int c = lane & 7;
#pragma unroll
    for (int j = 0; j < 4; ++j) { const int n = (lane >> 3) + 8 * j; const LAS float* s = scr + (8 * c) * 33 + n;
        v4u o; o.x = pk2(s[0 * 33], s[1 * 33]); o.y = pk2(s[2 * 33], s[3 * 33]); o.z = pk2(s[4 * 33], s[5 * 33]); o.w = pk2(s[6 * 33], s[7 * 33]);
        *(GAS v4u*)(dst + (size_t)n * ldk + 8 * c) = o; }
    LDS_WAIT(); asm volatile("" ::: "memory");
}
__device__ __forceinline__ void transpose_load(const float* W, int ldw, int k0, int n0, int lane, float (&v)[32]) {
#pragma unroll
    for (int i = 0; i < 32; ++i) { const int kk = 2 * i + (lane >> 5); v[i] = W[(size_t)(k0 + kk) * ldw + n0 + (lane & 31)]; }
}
__device__ __forceinline__ void transpose_finish(const float (&v)[32], bf16* dst, int ldk, LAS float* scr, int lane) {
#pragma unroll
    for (int i = 0; i < 32; ++i) { const int kk = 2 * i + (lane >> 5); scr[kk * 33 + (lane & 31)] = v[i]; }
    LDS_WAIT(); asm volatile("" ::: "memory");
    const int c = lane & 7;
#pragma unroll
    for (int j = 0; j < 4; ++j) { const int n = (lane >> 3) + 8 * j; const LAS float* s = scr + (8 * c) * 33 + n;
        v4u o; o.x = pk2(s[0 * 33], s[1 * 33]); o.y = pk2(s[2 * 33], s[3 * 33]); o.z = pk2(s[4 * 33], s[5 * 33]); o.w = pk2(s[6 * 33], s[7 * 33]);
        *(GAS v4u*)(dst + (size_t)n * ldk + 8 * c) = o; }
    LDS_WAIT(); asm volatile("" ::: "memory");
}
struct TrItem { const float* W; int ldw, k0, n0; bf16* dst; int ldk; };
__device__ __forceinline__ TrItem tr_item(const Args& a, int r) {
    unsigned char* ws = a.ws; TrItem t;
    if (r < I_WIN_N_) { const int nblk = INC / 32, kb = r / nblk, nb = r % nblk; t = TrItem{a.in[I_WIN], INC, 64 * kb, 32 * nb, (bf16*)(ws + WS_WIN) + (size_t)(32 * nb) * D + 64 * kb, D}; return t; } r -= I_WIN_N_;
    if (r < I_WCO_N_) { const int nblk = D / 32, kb = r / nblk, nb = r % nblk; t = TrItem{a.in[I_WCO], D, 64 * kb, 32 * nb, (bf16*)(ws + WS_W4) + (size_t)(32 * nb) * K4 + 64 * kb, K4}; return t; } r -= I_WCO_N_;
    if (r < I_WRO_N_) { const int nblk = D / 32, kb = r / nblk, nb = r % nblk; t = TrItem{a.in[I_WRO], D, 64 * kb, 32 * nb, (bf16*)(ws + WS_W4) + (size_t)(32 * nb) * K4 + CONV_CH + 64 * kb, K4}; return t; } r -= I_WRO_N_;
    { const int nblk = D / 32, kb = r / nblk, nb = r % nblk; t = TrItem{a.in[I_WO], D, 64 * kb, 32 * nb, (bf16*)(ws + WS_WO) + (size_t)(32 * nb) * D + 64 * kb, D}; return t; }
}
typedef float f32x2 __attribute__((ext_vector_type(2)));
constexpr int I_WIN64 = (D / 64) * (INC / 64);
__device__ __forceinline__ void tr64_load(const float* W, int r, int lane, f32x2 (&v)[32]) {
    const int nblk = INC / 64, kb = r / nblk, nb = r % nblk; const float* src = W + (size_t)(64 * kb) * INC + 64 * nb + 2 * (lane & 31);
#pragma unroll
    for (int i = 0; i < 32; ++i) v[i] = *(const f32x2*)(src + (size_t)(2 * i + (lane >> 5)) * INC);
}
__device__ __forceinline__ void tr64_finish(const f32x2 (&v)[32], bf16* WT, int r, LAS float* scr, int lane) {
    const int nblk = INC / 64, kb = r / nblk, nb = r % nblk;
#pragma unroll
    for (int i = 0; i < 32; ++i) { const int kk = 2 * i + (lane >> 5); scr[kk * 65 + 2 * (lane & 31)] = v[i].x; scr[kk * 65 + 2 * (lane & 31) + 1] = v[i].y; }
    LDS_WAIT(); asm volatile("" ::: "memory");
    const int c = lane & 7; bf16* dst = WT + (size_t)(64 * nb) * D + 64 * kb;
#pragma unroll
    for (int j = 0; j < 8; ++j) { const int n = (lane >> 3) + 8 * j; const LAS float* s = scr + (8 * c) * 65 + n;
        v4u o; o.x = pk2(s[0 * 65], s[1 * 65]); o.y = pk2(s[2 * 65], s[3 * 65]); o.z = pk2(s[4 * 65], s[5 * 65]); o.w = pk2(s[6 * 65], s[7 * 65]);
        *(GAS v4u*)(dst + (size_t)n * D + 8 * c) = o; }
    LDS_WAIT(); asm volatile("" ::: "memory");
}
constexpr int I_WIN128 = (D / 128) * (INC / 32);
__device__ __forceinline__ void tr128_load(const float* W, int r, int lane, float (&v)[64]) {
    const int nblk = INC / 32, kb = r / nblk, nb = r % nblk; const float* src = W + (size_t)(128 * kb) * INC + 32 * nb + (lane & 31);
#pragma unroll
    for (int i = 0; i < 64; ++i) v[i] = src[(size_t)(2 * i + (lane >> 5)) * INC];
}
__device__ __forceinline__ void tr128_finish(const float (&v)[64], bf16* WT, int r, LAS float* scr, int lane) {
    const int nblk = INC / 32, kb = r / nblk, nb = r % nblk;
#pragma unroll
    for (int i = 0; i < 64; ++i) { const int kk = 2 * i + (lane >> 5); scr[kk * 33 + (lane & 31)] = v[i]; }
    LDS_WAIT(); asm volatile("" ::: "memory");
    const int c = lane & 15; bf16* dst = WT + (size_t)(32 * nb) * D + 128 * kb;
#pragma unroll
    for (int j = 0; j < 8; ++j) { const int n = (lane >> 4) + 4 * j; const LAS float* s = scr + (8 * c) * 33 + n;
        v4u o; o.x = pk2(s[0 * 33], s[1 * 33]); o.y = pk2(s[2 * 33], s[3 * 33]); o.z = pk2(s[4 * 33], s[5 * 33]); o.w = pk2(s[6 * 33], s[7 * 33]);
        *(GAS v4u*)(dst + (size_t)n * D + 8 * c) = o; }
    LDS_WAIT(); asm volatile("" ::: "memory");
}
__device__ __forceinline__ void tr_range(const Args& a, LAS float* scr, int lane, int r0, int stride, int r_end) {
    int r = r0; float v[32]; TrItem cur{}; if (r < r_end) { cur = tr_item(a, r); transpose_load(cur.W, cur.ldw, cur.k0, cur.n0, lane, v); }
    while (r < r_end) {
        const int rn = r + stride; float vn[32]; TrItem nx{};
        if (rn < r_end) { nx = tr_item(a, rn); transpose_load(nx.W, nx.ldw, nx.k0, nx.n0, lane, vn); }
        transpose_finish(v, cur.dst, cur.ldk, scr, lane);
        if (rn < r_end) {
#pragma unroll
            for (int i = 0; i < 32; ++i) v[i] = vn[i]; }
        cur = nx; r = rn;
    }
}
constexpr int I_ADA = (MODC / 256) * ADA_KS;
constexpr int I_WIN_N = (D / 64) * (INC / 32), I_WCO_N = (CONV_CH / 64) * (D / 32), I_WRO_N = (RV / 64) * (D / 32), I_WO_N = (D / 64) * (D / 32);
constexpr int I_GU1 = (D / 64) * (DE / 32), I_DN1 = (DE / 64) * (D / 32), I_EXP1 = 2 * I_GU1 + I_DN1;
#ifndef MOE_E
#define MOE_E 0
#endif
#ifndef SIDE_CVT
#define SIDE_CVT 0
#endif
#ifndef LATE_W4
#define LATE_W4 0
#endif
constexpr int P0_ITEMS = I_ADA + I_WIN_N + (LATE_W4 ? 0 : I_WCO_N + I_WRO_N + I_WO_N);

__device__ __forceinline__ void p0_prologue(const Args& a, LAS unsigned char* lds, int tid, int lane, int wave, int vcu, int G, bool cvt_experts, unsigned long long* ts_items = nullptr) {
    unsigned char* ws = a.ws;
    LAS float* sc = (LAS float*)(lds + 98304);
    for (int i = tid; i < 4 * D; i += 512) sc[i] = silu_f(a.in[I_C][i]);
    __syncthreads();
    LAS float* scr = (LAS float*)(lds + wave * 12288);
    const int gw = vcu * NWAVES + wave, NGW = G * NWAVES;
#if P0_V2 && !LATE_W4
    const bool ada_wave = wave < 3; const int aw = vcu * 3 + wave, NAW = G * 3;
    if (ada_wave) for (int r = aw; r < I_ADA; r += NAW) {
        const int cc = r % (MODC / 256), ks = r / (MODC / 256);
        const float* wp = a.in[I_WADA] + (size_t)(ks * 128) * MODC + cc * 256 + lane * 4;
        f32x4 a0 = {0.f, 0.f, 0.f, 0.f}, a1 = a0, a2 = a0, a3 = a0;
#pragma unroll 1
        for (int k0 = 0; k0 < 128; k0 += 32) { f32x4 w[32];
#pragma unroll
            for (int k = 0; k < 32; ++k) w[k] = *(const f32x4*)(wp + (size_t)(k0 + k) * MODC);
            __builtin_amdgcn_sched_barrier(0);
#pragma unroll
            for (int k = 0; k < 32; ++k) { const int kk = ks * 128 + k0 + k; a0 += sc[kk] * w[k]; a1 += sc[D + kk] * w[k]; a2 += sc[2 * D + kk] * w[k]; a3 += sc[3 * D + kk] * w[k]; } }
        float* pp = (float*)(ws + WS_MODP) + (size_t)(ks * 4) * MODC + cc * 256 + lane * 4;
        *(f32x4*)(pp) = a0; *(f32x4*)(pp + MODC) = a1; *(f32x4*)(pp + 2 * MODC) = a2; *(f32x4*)(pp + 3 * MODC) = a3;
    }
    if (ts_items) ts_items[1] = __builtin_amdgcn_s_memrealtime();
#if TAIL_W4 && P0_T64
    if (!ada_wave) {
        LAS float* sc64 = (LAS float*)(lds + (wave - 3) * 16896);
        const int nw = vcu * 5 + (wave - 3), NNW = G * 5;
#if P0_T64 == 2
        { int r = nw; float v[64]; if (r < I_WIN128) tr128_load(a.in[I_WIN], r, lane, v);
          while (r < I_WIN128) {
            const int rn = r + NNW; float vn[64];
            if (rn < I_WIN128) tr128_load(a.in[I_WIN], rn, lane, vn);
            tr128_finish(v, (bf16*)(ws + WS_WIN), r, sc64, lane);
            if (rn < I_WIN128) {
#pragma unroll
                for (int i = 0; i < 64; ++i) v[i] = vn[i]; }
            r = rn;
          } }
        if (false) {
#else
        {
#endif
        int r = nw; f32x2 v[32]; if (r < I_WIN64) tr64_load(a.in[I_WIN], r, lane, v);
        while (r < I_WIN64) {
            const int rn = r + NNW; f32x2 vn[32];
            if (rn < I_WIN64) tr64_load(a.in[I_WIN], rn, lane, vn);
            tr64_finish(v, (bf16*)(ws + WS_WIN), r, sc64, lane);
            if (rn < I_WIN64) {
#pragma unroll
                for (int i = 0; i < 32; ++i) v[i] = vn[i]; }
            r = rn;
        } } }
#else
    {
      const int nw = vcu * 5 + (wave - 3), NNW = G * 5;
      int round = 0; int r = gw;
      constexpr int I_TR_P0 = TAIL_W4 ? I_WIN_N_ : I_TR_ALL;
      constexpr int NSR = TAIL_W4 ? 1 : 2;
      auto next_item = [&](int rd) -> int { if (rd < NSR) return rd * NGW + gw; if (ada_wave) return I_TR_ALL; return NSR * NGW + (rd - NSR) * NNW + nw; };
      r = next_item(0);
      float v[32]; TrItem cur{}; if (r < I_TR_P0) { cur = tr_item(a, r); transpose_load(cur.W, cur.ldw, cur.k0, cur.n0, lane, v); }
      while (r < I_TR_P0) {
          ++round; const int rn = next_item(round);
          float vn[32]; TrItem nx{};
          if (rn < I_TR_P0) { nx = tr_item(a, rn); transpose_load(nx.W, nx.ldw, nx.k0, nx.n0, lane, vn); }
          transpose_finish(v, cur.dst, cur.ldk, scr, lane);
          if (rn < I_TR_P0) {
#pragma unroll
              for (int i = 0; i < 32; ++i) v[i] = vn[i]; }
          cur = nx; r = rn;
      } }
#endif
#else
    for (int it = gw; it < P0_ITEMS; it += NGW) {
        int r = it;
        if (r < I_ADA) {
            const int cc = r % (MODC / 256), ks = r / (MODC / 256);
            const float* wp = a.in[I_WADA] + (size_t)(ks * 128) * MODC + cc * 256 + lane * 4;
            f32x4 a0 = {0.f, 0.f, 0.f, 0.f}, a1 = a0, a2 = a0, a3 = a0;
#pragma unroll 8
            for (int k = 0; k < 128; ++k) { const f32x4 w = *(const f32x4*)(wp + (size_t)k * MODC); const int kk = ks * 128 + k;
                a0 += sc[kk] * w; a1 += sc[D + kk] * w; a2 += sc[2 * D + kk] * w; a3 += sc[3 * D + kk] * w; }
            float* pp = (float*)(ws + WS_MODP) + (size_t)(ks * 4) * MODC + cc * 256 + lane * 4;
            *(f32x4*)(pp) = a0; *(f32x4*)(pp + MODC) = a1; *(f32x4*)(pp + 2 * MODC) = a2; *(f32x4*)(pp + 3 * MODC) = a3;
            continue;
        }
        r -= I_ADA;
        if (r < I_WIN_N) { const int nblk = INC / 32, kb = r / nblk, nb = r % nblk; transpose_item(a.in[I_WIN], INC, 64 * kb, 32 * nb, (bf16*)(ws + WS_WIN) + (size_t)(32 * nb) * D + 64 * kb, D, scr, lane); continue; } r -= I_WIN_N;
#if !LATE_W4
        if (r < I_WCO_N) { const int nblk = D / 32, kb = r / nblk, nb = r % nblk; transpose_item(a.in[I_WCO], D, 64 * kb, 32 * nb, (bf16*)(ws + WS_W4) + (size_t)(32 * nb) * K4 + 64 * kb, K4, scr, lane); continue; } r -= I_WCO_N;
        if (r < I_WRO_N) { const int nblk = D / 32, kb = r / nblk, nb = r % nblk; transpose_item(a.in[I_WRO], D, 64 * kb, 32 * nb, (bf16*)(ws + WS_W4) + (size_t)(32 * nb) * K4 + CONV_CH + 64 * kb, K4, scr, lane); continue; } r -= I_WRO_N;
        { const int nblk = D / 32, kb = r / nblk, nb = r % nblk; transpose_item(a.in[I_WO], D, 64 * kb, 32 * nb, (bf16*)(ws + WS_WO) + (size_t)(32 * nb) * D + 64 * kb, D, scr, lane); }
#endif
    }
#endif
    if (ts_items) ts_items[0] = __builtin_amdgcn_s_memrealtime();
    if (cvt_experts) {
        const size_t NG8 = (size_t)NE * D * DE / 8;
        const size_t gt = (size_t)vcu * 512 + tid, GT = (size_t)G * 512;
        for (size_t it0 = gt; it0 < 3 * NG8; it0 += 4 * GT) {
            f32x4 v0[4], v1[4];
#pragma unroll
            for (int j = 0; j < 4; ++j) { const size_t it = it0 + (size_t)j * GT; if (it < 3 * NG8) { const int which = (int)(it / NG8); const size_t i = (it % NG8) * 8;
                const float* src = a.in[which == 0 ? I_WG : which == 1 ? I_WU : I_WD] + i; v0[j] = __builtin_nontemporal_load((const f32x4*)src); v1[j] = __builtin_nontemporal_load((const f32x4*)(src + 4)); } }
#pragma unroll
            for (int j = 0; j < 4; ++j) { const size_t it = it0 + (size_t)j * GT; if (it < 3 * NG8) { const int which = (int)(it / NG8); const size_t i = (it % NG8) * 8;
                v4u o; o.x = pk2(v0[j].x, v0[j].y); o.y = pk2(v0[j].z, v0[j].w); o.z = pk2(v1[j].x, v1[j].y); o.w = pk2(v1[j].z, v1[j].w);
                if (which == 2) *(v4u*)((bf16*)(ws + WS_WD) + i) = o;
                else { const size_t ek = i / DE; const int n = (int)(i % DE); *(v4u*)((bf16*)(ws + WS_WGU) + ek * (2 * DE) + (n / 128) * 256 + (n % 128) + (which ? 128 : 0)) = o; } } }
        }
    }
    { bf16* wrt = (bf16*)(ws + WS_WRT);
      for (int idx = vcu * 512 + tid; idx < 48 * D; idx += G * 512) { const int o = idx / D, d = idx % D;
          const float w = o < 4 ? a.in[I_WRG][d * 4 + o] : (o < 36 ? a.in[I_WRE][d * 32 + (o - 4)] : 0.f);
          const unsigned hi = f2bf(w); const float r = w - __builtin_bit_cast(float, hi << 16); wrt[idx] = (bf16)hi; wrt[48 * D + idx] = (bf16)f2bf(r); } }
    float* rc = (float*)(ws + WS_ROPE);
    for (int idx = vcu * 512 + tid; idx < SEQ * 64; idx += G * 512) { const int pos = idx >> 6, j = idx & 63;
        const float inv = powf(10000.f, -(float)(2 * j) / 128.f); const float ang = (float)pos * inv; rc[idx] = cosf(ang); rc[SEQ * 64 + idx] = sinf(ang); }
}

__device__ __forceinline__ void late_w4_convert(const Args& a, LAS unsigned char* lds, int lane, int wave, int vcu, int G) {
    unsigned char* ws = a.ws; LAS float* scr = (LAS float*)(lds + wave * 12288);
    const int gw = vcu * NWAVES + wave, NGW = G * NWAVES;
    for (int it = gw; it < I_WCO_N + I_WRO_N + I_WO_N; it += NGW) { int r = it;
        if (r < I_WCO_N) { const int nblk = D / 32, kb = r / nblk, nb = r % nblk; transpose_item(a.in[I_WCO], D, 64 * kb, 32 * nb, (bf16*)(ws + WS_W4) + (size_t)(32 * nb) * K4 + 64 * kb, K4, scr, lane); continue; } r -= I_WCO_N;
        if (r < I_WRO_N) { const int nblk = D / 32, kb = r / nblk, nb = r % nblk; transpose_item(a.in[I_WRO], D, 64 * kb, 32 * nb, (bf16*)(ws + WS_W4) + (size_t)(32 * nb) * K4 + CONV_CH + 64 * kb, K4, scr, lane); continue; } r -= I_WRO_N;
        { const int nblk = D / 32, kb = r / nblk, nb = r % nblk; transpose_item(a.in[I_WO], D, 64 * kb, 32 * nb, (bf16*)(ws + WS_WO) + (size_t)(32 * nb) * D + 64 * kb, D, scr, lane); }
    }
}

__device__ __forceinline__ float mod_value(const Args& a, int b, int j) {
    const float* pp = (const float*)(a.ws + WS_MODP) + (size_t)b * MODC + j; float s = a.in[I_BADA][j];
#pragma unroll
    for (int ks = 0; ks < ADA_KS; ++ks) s += pp[(size_t)ks * 4 * MODC];
    return s;
}
__device__ __forceinline__ void p1_norm(const Args& a, LAS unsigned char* lds, int tid, int lane, int wave, int G) {
    float* MOD = (float*)(a.ws + WS_MOD);
    for (int idx = blockIdx.x * 512 + tid; idx < 4 * MODC; idx += G * 512) MOD[idx] = mod_value(a, idx / MODC, idx % MODC);
    LAS float* tsc = (LAS float*)lds; LAS float* tsh = tsc + D;
    bf16* H = (bf16*)(a.ws + WS_H); const float* g = a.in[I_N1G];
    for (int rb = blockIdx.x; rb < T / 32; rb += G) {
        const int b = (rb * 32) / SEQ;
        __syncthreads();
        {
          const float* pp = (const float*)(a.ws + WS_MODP) + (size_t)b * MODC + tid; float pv[ADA_KS][8], bv[8];
#pragma unroll
          for (int i = 0; i < 8; ++i) bv[i] = a.in[I_BADA][(i >> 2) * D + (i & 3) * 512 + tid];
#pragma unroll
          for (int ks = 0; ks < ADA_KS; ++ks)
#pragma unroll
              for (int i = 0; i < 8; ++i) pv[ks][i] = pp[(size_t)ks * 4 * MODC + (i >> 2) * D + (i & 3) * 512];
          __builtin_amdgcn_sched_barrier(0);
#pragma unroll
          for (int i = 0; i < 8; ++i) { float s = bv[i];
#pragma unroll
              for (int ks = 0; ks < ADA_KS; ++ks) s += pv[ks][i];
              if (i < 4) tsh[(i & 3) * 512 + tid] = s; else tsc[(i & 3) * 512 + tid] = 1.f + s; } }
        __syncthreads();
        f32x4 gg[8], v[8];
#pragma unroll
        for (int j = 0; j < 8; ++j) { gg[j] = *(const f32x4*)(g + 4 * lane + 256 * j); v[j] = ((const GAS f32x4*)(a.in[I_X] + (size_t)(rb * 32 + wave * 4) * D) + lane)[64 * j]; }
#pragma unroll
        for (int rr = 0; rr < 4; ++rr) {
            const int row = rb * 32 + wave * 4 + rr;
            f32x4 vn[8];
            if (rr < 3) {
#pragma unroll
                for (int j = 0; j < 8; ++j) vn[j] = ((const GAS f32x4*)(a.in[I_X] + (size_t)(row + 1) * D) + lane)[64 * j]; }
            float s = 0.f;
#pragma unroll
            for (int j = 0; j < 8; ++j) s += (v[j].x * v[j].x + v[j].y * v[j].y) + (v[j].z * v[j].z + v[j].w * v[j].w);
            const float rstd = rsqrtf(wave_sum(s) * (1.f / D) + EPS);
            GAS v2u* o8 = (GAS v2u*)(H + (size_t)row * D) + lane;
#pragma unroll
            for (int j = 0; j < 8; ++j) { const int d = 4 * lane + 256 * j; const f32x4 cs = *(const LAS f32x4*)(tsc + d), sh = *(const LAS f32x4*)(tsh + d);
                const f32x4 o = v[j] * rstd * gg[j] * cs + sh; v2u w; w.x = pk2(o.x, o.y); w.y = pk2(o.z, o.w); o8[64 * j] = w; }
            if (rr < 3) {
#pragma unroll
                for (int j = 0; j < 8; ++j) v[j] = vn[j]; }
        }
    }
}

typedef short s16x4 __attribute__((ext_vector_type(4)));
constexpr int RS_K = 288, RS_V = 544;
constexpr int KS_OFF = 0, VS_OFF = 128 * RS_K;
#define TR_READ(dst, vb, off) asm volatile("ds_read_b64_tr_b16 %0, %1 offset:%c2" : "=&v"(dst) : "v"(vb), "i"(off) : "memory")
#define SBAR() __builtin_amdgcn_sched_barrier(0)
#define PK8(L, H) (bf16x8){L[0], L[1], L[2], L[3], H[0], H[1], H[2], H[3]}

__device__ __forceinline__ void p3a_unit(const Args& a, LAS unsigned char* lds, int unit, int tid, int lane, int wave) {
    const int n = unit % NCH, bh = unit / NCH, h = bh % RH, b = bh / RH;
    bf16* U = (bf16*)(a.ws + WS_U); const float* rc = (const float*)(a.ws + WS_ROPE);
    const size_t t0 = (size_t)b * SEQ + (size_t)n * CHUNK;
    const float log_g = log1pf(-exp2f(-5.f - (float)h));
    __syncthreads();
    {
        v4u x1[4], x2[4]; f32x4 c0[4], c1[4], s0[4], s1[4]; v4u vv[8];
#pragma unroll
        for (int it = 0; it < 4; ++it) { const int task = tid + 512 * it; const int isk = task >> 10, r_ = (task >> 3) & 127, c8 = task & 7;
            const bf16* p = U + (t0 + r_) * INC + (isk ? OFF_K : OFF_Q) + h * DK + c8 * 8; x1[it] = *(const v4u*)p; x2[it] = *(const v4u*)(p + 64);
            const float* cp = rc + (size_t)(n * CHUNK + r_) * 64 + c8 * 8; const float* sp = cp + SEQ * 64;
            c0[it] = *(const f32x4*)cp; c1[it] = *(const f32x4*)(cp + 4); s0[it] = *(const f32x4*)sp; s1[it] = *(const f32x4*)(sp + 4); }
#pragma unroll
        for (int it = 0; it < 8; ++it) { const int task = tid + 512 * it; const int r_ = task >> 5, c = task & 31; vv[it] = *(const v4u*)(U + (t0 + r_) * INC + OFF_V + h * DV + c * 8); }
#pragma unroll
        for (int it = 0; it < 4; ++it) { const int task = tid + 512 * it; const int isk = task >> 10, r_ = (task >> 3) & 127, c8 = task & 7;
            bf16* p = U + (t0 + r_) * INC + (isk ? OFF_K : OFF_Q) + h * DK + c8 * 8;
            const float cs[8] = {c0[it].x, c0[it].y, c0[it].z, c0[it].w, c1[it].x, c1[it].y, c1[it].z, c1[it].w}, sn[8] = {s0[it].x, s0[it].y, s0[it].z, s0[it].w, s1[it].x, s1[it].y, s1[it].z, s1[it].w};
            const unsigned w1[4] = {x1[it].x, x1[it].y, x1[it].z, x1[it].w}, w2[4] = {x2[it].x, x2[it].y, x2[it].z, x2[it].w};
            const float sc = isk ? 0.08838834764831845f : 1.f;
            const float kd = isk ? __expf(log_g * (float)(127 - r_)) : 0.f;
            float o1[8], o2[8];
#pragma unroll
            for (int i = 0; i < 4; ++i) {
                const float a0 = bflo(w1[i]), a1 = bfhi(w1[i]), b0 = bflo(w2[i]), b1 = bfhi(w2[i]);
                o1[2 * i] = (a0 * cs[2 * i] - b0 * sn[2 * i]) * sc; o1[2 * i + 1] = (a1 * cs[2 * i + 1] - b1 * sn[2 * i + 1]) * sc;
                o2[2 * i] = (a0 * sn[2 * i] + b0 * cs[2 * i]) * sc; o2[2 * i + 1] = (a1 * sn[2 * i + 1] + b1 * cs[2 * i + 1]) * sc;
            }
            v4u y1, y2; y1.x = pk2(o1[0], o1[1]); y1.y = pk2(o1[2], o1[3]); y1.z = pk2(o1[4], o1[5]); y1.w = pk2(o1[6], o1[7]);
            y2.x = pk2(o2[0], o2[1]); y2.y = pk2(o2[2], o2[3]); y2.z = pk2(o2[4], o2[5]); y2.w = pk2(o2[6], o2[7]);
            *(v4u*)p = y1; *(v4u*)(p + 64) = y2;
            if (isk) {
                v4u z1, z2; z1.x = pk2(o1[0] * kd, o1[1] * kd); z1.y = pk2(o1[2] * kd, o1[3] * kd); z1.z = pk2(o1[4] * kd, o1[5] * kd); z1.w = pk2(o1[6] * kd, o1[7] * kd);
                z2.x = pk2(o2[0] * kd, o2[1] * kd); z2.y = pk2(o2[2] * kd, o2[3] * kd); z2.z = pk2(o2[4] * kd, o2[5] * kd); z2.w = pk2(o2[6] * kd, o2[7] * kd);
                *(LAS v4u*)(lds + KS_OFF + r_ * RS_K + c8 * 16) = z1; *(LAS v4u*)(lds + KS_OFF + r_ * RS_K + 128 + c8 * 16) = z2;
            }
        }
#pragma unroll
        for (int it = 0; it < 8; ++it) { const int task = tid + 512 * it; const int r_ = task >> 5, c = task & 31; *(LAS v4u*)(lds + VS_OFF + r_ * RS_V + c * 16) = vv[it]; }
    }
    __syncthreads();
    const int g = lane >> 4, q = (lane & 15) >> 2, p = lane & 3;
    const unsigned aK = (unsigned)(uintptr_t)(lds + KS_OFF) + (unsigned)((8 * g + q) * RS_K + 8 * p);
    const unsigned aV = (unsigned)(uintptr_t)(lds + VS_OFF) + (unsigned)((8 * g + q) * RS_V + 64 * wave + 8 * p);
    f32x4 acc[8][2];
#pragma unroll
    for (int mt = 0; mt < 8; ++mt) { acc[mt][0] = (f32x4){0.f, 0.f, 0.f, 0.f}; acc[mt][1] = (f32x4){0.f, 0.f, 0.f, 0.f}; }
#pragma unroll
    for (int ks = 0; ks < 4; ++ks) {
        s16x4 al[8], ah[8], bl[2], bhh[2];
#pragma unroll
        for (int mt = 0; mt < 8; ++mt) { TR_READ(al[mt], aK, ks * 32 * RS_K + mt * 32); TR_READ(ah[mt], aK, ks * 32 * RS_K + 4 * RS_K + mt * 32); }
#pragma unroll
        for (int nt = 0; nt < 2; ++nt) { TR_READ(bl[nt], aV, ks * 32 * RS_V + nt * 32); TR_READ(bhh[nt], aV, ks * 32 * RS_V + 4 * RS_V + nt * 32); }
        asm volatile("s_waitcnt lgkmcnt(0)" ::: "memory"); SBAR();
#pragma unroll
        for (int mt = 0; mt < 8; ++mt)
#pragma unroll
            for (int nt = 0; nt < 2; ++nt) acc[mt][nt] = __builtin_amdgcn_mfma_f32_16x16x32_bf16(PK8(al[mt], ah[mt]), PK8(bl[nt], bhh[nt]), acc[mt][nt], 0, 0, 0);
    }
    bf16* KVT = (bf16*)(a.ws + WS_KVT) + (size_t)unit * DV * DK;
#pragma unroll
    for (int mt = 0; mt < 8; ++mt)
#pragma unroll
        for (int nt = 0; nt < 2; ++nt) { const int e = 32 * wave + 16 * nt + (lane & 15), d = 16 * mt + 4 * g;
            v2u w; w.x = pk2(acc[mt][nt][0], acc[mt][nt][1]); w.y = pk2(acc[mt][nt][2], acc[mt][nt][3]); *(v2u*)(KVT + (size_t)e * DK + d) = w; }
}

__device__ __forceinline__ void p3b_scan_conv(const Args& a, int tid, int lane, int wave, int vcu, int G) {
    const bf16* KVT = (const bf16*)(a.ws + WS_KVT); bf16* SPT = (bf16*)(a.ws + WS_SPT);
    for (int idx = blockIdx.x * 512 + tid; idx < NB * RH * DV * DK / 8; idx += G * 512) {
        const int bh = idx / (DV * DK / 8), o8 = (idx % (DV * DK / 8)) * 8, h = bh % RH;
        const float cd = __expf(log1pf(-exp2f(-5.f - (float)h)) * 128.f);
        float s[8];
#pragma unroll
        for (int i = 0; i < 8; ++i) s[i] = 0.f;
        v4u kvv[NCH - 1];
#pragma unroll
        for (int n = 1; n < NCH; ++n) kvv[n - 1] = *(const v4u*)(KVT + ((size_t)(bh * NCH + n - 1)) * DV * DK + o8);
#pragma unroll
        for (int n = 1; n < NCH; ++n) {
            const v4u kv = kvv[n - 1];
            const unsigned w[4] = {kv.x, kv.y, kv.z, kv.w};
#pragma unroll
            for (int i = 0; i < 4; ++i) { s[2 * i] = cd * s[2 * i] + bflo(w[i]); s[2 * i + 1] = cd * s[2 * i + 1] + bfhi(w[i]); }
            v4u o; o.x = pk2(s[0], s[1]); o.y = pk2(s[2], s[3]); o.z = pk2(s[4], s[5]); o.w = pk2(s[6], s[7]);
            *(v4u*)(SPT + ((size_t)(bh * NCH + n)) * DV * DK + o8) = o;
        }
    }
    const bf16* U = (const bf16*)(a.ws + WS_U); bf16* AIN = (bf16*)(a.ws + WS_A4); const float* cw = a.in[I_CONVW];
    const int gw = vcu * NWAVES + wave, NGW = G * NWAVES;
    for (int task = gw; task < (T / 16) * 2; task += NGW) {
        const int tb = task >> 1, ch = (task & 1) * 512 + lane * 8, tr0 = tb * 16;
        float w0[8], w1[8], w2[8];
#pragma unroll
        for (int i = 0; i < 8; ++i) { w0[i] = cw[ch + i]; w1[i] = cw[CONV_CH + ch + i]; w2[i] = cw[2 * CONV_CH + ch + i]; }
        float zm2[8], zm1[8];
        const bool first = (tr0 % SEQ) == 0;
#pragma unroll
        for (int i = 0; i < 8; ++i) { zm2[i] = 0.f; zm1[i] = 0.f; }
        if (!first) {
            const v4u c2 = *(const v4u*)(U + (size_t)(tr0 - 2) * INC + OFF_CC + ch), x2 = *(const v4u*)(U + (size_t)(tr0 - 2) * INC + OFF_CX + ch);
            const v4u c1 = *(const v4u*)(U + (size_t)(tr0 - 1) * INC + OFF_CC + ch), x1 = *(const v4u*)(U + (size_t)(tr0 - 1) * INC + OFF_CX + ch);
            const unsigned a2[4] = {c2.x, c2.y, c2.z, c2.w}, b2[4] = {x2.x, x2.y, x2.z, x2.w}, a1[4] = {c1.x, c1.y, c1.z, c1.w}, b1[4] = {x1.x, x1.y, x1.z, x1.w};
#pragma unroll
            for (int i = 0; i < 4; ++i) { zm2[2 * i] = bflo(a2[i]) * bflo(b2[i]); zm2[2 * i + 1] = bfhi(a2[i]) * bfhi(b2[i]); zm1[2 * i] = bflo(a1[i]) * bflo(b1[i]); zm1[2 * i + 1] = bfhi(a1[i]) * bfhi(b1[i]); }
        }
#pragma unroll 1
        for (int r0 = 0; r0 < 16; r0 += 4) {
            v4u ccv[4], cxv[4], cbv[4];
#pragma unroll
            for (int rr = 0; rr < 4; ++rr) { const size_t row = (size_t)(tr0 + r0 + rr) * INC; ccv[rr] = *(const v4u*)(U + row + OFF_CC + ch); cxv[rr] = *(const v4u*)(U + row + OFF_CX + ch); cbv[rr] = *(const v4u*)(U + row + OFF_CB + ch); }
#pragma unroll
            for (int rr = 0; rr < 4; ++rr) {
                const unsigned ac[4] = {ccv[rr].x, ccv[rr].y, ccv[rr].z, ccv[rr].w}, ax[4] = {cxv[rr].x, cxv[rr].y, cxv[rr].z, cxv[rr].w}, ab[4] = {cbv[rr].x, cbv[rr].y, cbv[rr].z, cbv[rr].w};
                float z[8], o[8];
#pragma unroll
                for (int i = 0; i < 4; ++i) { z[2 * i] = bflo(ac[i]) * bflo(ax[i]); z[2 * i + 1] = bfhi(ac[i]) * bfhi(ax[i]); }
#pragma unroll
                for (int i = 0; i < 8; ++i) o[i] = w0[i] * zm2[i] + w1[i] * zm1[i] + w2[i] * z[i];
#pragma unroll
                for (int i = 0; i < 4; ++i) { o[2 * i] *= bflo(ab[i]); o[2 * i + 1] *= bfhi(ab[i]); }
                v4u ov; ov.x = pk2(o[0], o[1]); ov.y = pk2(o[2], o[3]); ov.z = pk2(o[4], o[5]); ov.w = pk2(o[6], o[7]);
                *(v4u*)(AIN + (size_t)(tr0 + r0 + rr) * K4 + ch) = ov;
#pragma unroll
                for (int i = 0; i < 8; ++i) { zm2[i] = zm1[i]; zm1[i] = z[i]; }
            }
        }
    }
}

__device__ __forceinline__ void p3c_unit(const Args& a, LAS unsigned char* lds, int unit, int tid, int lane, int wave) {
    const int n = unit % NCH, bh = unit / NCH, h = bh % RH, b = bh / RH;
    const bf16* U = (const bf16*)(a.ws + WS_U);
    const size_t t0 = (size_t)b * SEQ + (size_t)n * CHUNK;
    const float log_g = log1pf(-exp2f(-5.f - (float)h));
    __syncthreads();
    const int g = lane >> 4, fr = lane & 15, q = fr >> 2, p = lane & 3;
    const int il = 16 * wave + fr;
    v4u kk[4], spv[8], vv[8]; bf16x8 bq[4];
    const bf16* SP = (const bf16*)(a.ws + WS_SPT) + (size_t)unit * DV * DK;
#pragma unroll
    for (int it = 0; it < 4; ++it) { const int task = tid + 512 * it; const int r_ = task >> 4, c = task & 15; kk[it] = *(const v4u*)(U + (t0 + r_) * INC + OFF_K + h * DK + c * 8); }
    if (n > 0) {
#pragma unroll
        for (int it = 0; it < 8; ++it) { const int task = tid + 512 * it; spv[it] = *(const v4u*)(SP + (size_t)task * 8); }
    }
#pragma unroll
    for (int ks = 0; ks < 4; ++ks) bq[ks] = *(const bf16x8*)(U + (t0 + il) * INC + OFF_Q + h * DK + 32 * ks + 8 * g);
#pragma unroll
    for (int it = 0; it < 4; ++it) { const int task = tid + 512 * it; const int r_ = task >> 4, c = task & 15; *(LAS v4u*)(lds + KS_OFF + r_ * RS_K + c * 16) = kk[it]; }
    f32x4 acc[16];
#pragma unroll
    for (int et = 0; et < 16; ++et) acc[et] = (f32x4){0.f, 0.f, 0.f, 0.f};
    if (n > 0) {
#pragma unroll
        for (int it = 0; it < 8; ++it) { const int task = tid + 512 * it; const int e_ = task >> 4, c = task & 15; *(LAS v4u*)(lds + VS_OFF + e_ * RS_K + c * 16) = spv[it]; }
        __syncthreads();
    }
#pragma unroll
    for (int it = 0; it < 8; ++it) { const int task = tid + 512 * it; const int r_ = task >> 5, c = task & 31; vv[it] = *(const v4u*)(U + (t0 + r_) * INC + OFF_V + h * DV + c * 8); }
    if (n > 0) {
        const LAS unsigned char* sp = lds + VS_OFF + fr * RS_K + 16 * g;
#pragma unroll
        for (int ks = 0; ks < 4; ++ks)
#pragma unroll
            for (int eh = 0; eh < 2; ++eh) {
                bf16x8 as[8];
#pragma unroll
                for (int e8 = 0; e8 < 8; ++e8) as[e8] = *(const LAS bf16x8*)(sp + (16 * (eh * 8 + e8)) * RS_K + 64 * ks);
#pragma unroll
                for (int e8 = 0; e8 < 8; ++e8) acc[eh * 8 + e8] = __builtin_amdgcn_mfma_f32_16x16x32_bf16(as[e8], bq[ks], acc[eh * 8 + e8], 0, 0, 0);
                SBAR();
            }
        const float qd = __expf(log_g * (float)(il + 1));
#pragma unroll
        for (int et = 0; et < 16; ++et) acc[et] = acc[et] * qd;
        __syncthreads();
    }
#pragma unroll
    for (int it = 0; it < 8; ++it) { const int task = tid + 512 * it; const int r_ = task >> 5, c = task & 31; *(LAS v4u*)(lds + VS_OFF + r_ * RS_V + c * 16) = vv[it]; }
    __syncthreads();
    const unsigned aV = (unsigned)(uintptr_t)(lds + VS_OFF) + (unsigned)((4 * g + q) * RS_V + 8 * p);
    const int npair = (wave >> 1) + 1;
#pragma unroll 1
    for (int pp = 0; pp < npair; ++pp) {
        f32x4 st[2];
#pragma unroll
        for (int hh = 0; hh < 2; ++hh) {
            const LAS unsigned char* kp = lds + KS_OFF + (32 * pp + 16 * hh + fr) * RS_K + 16 * g;
            f32x4 s = {0.f, 0.f, 0.f, 0.f};
#pragma unroll
            for (int ks = 0; ks < 4; ++ks) { const bf16x8 ak = *(const LAS bf16x8*)(kp + 64 * ks); s = __builtin_amdgcn_mfma_f32_16x16x32_bf16(ak, bq[ks], s, 0, 0, 0); }
#pragma unroll
            for (int r = 0; r < 4; ++r) { const int jl = 32 * pp + 16 * hh + 4 * g + r; const float f = (il >= jl) ? __expf(log_g * (float)(il - jl)) : 0.f; s[r] *= f; }
            st[hh] = s;
        }
        v4u pw; pw.x = pk2(st[0][0], st[0][1]); pw.y = pk2(st[0][2], st[0][3]); pw.z = pk2(st[1][0], st[1][1]); pw.w = pk2(st[1][2], st[1][3]);
        const bf16x8 bp = __builtin_bit_cast(bf16x8, pw);
        const unsigned av = aV + (unsigned)(pp * 32 * RS_V);
#pragma unroll
        for (int eh = 0; eh < 2; ++eh) {
            s16x4 vl[8], vh[8];
#pragma unroll
            for (int e8 = 0; e8 < 8; ++e8) { TR_READ(vl[e8], av, (eh * 8 + e8) * 32); TR_READ(vh[e8], av, 16 * RS_V + (eh * 8 + e8) * 32); }
            asm volatile("s_waitcnt lgkmcnt(0)" ::: "memory"); SBAR();
#pragma unroll
            for (int e8 = 0; e8 < 8; ++e8) acc[eh * 8 + e8] = __builtin_amdgcn_mfma_f32_16x16x32_bf16(PK8(vl[e8], vh[e8]), bp, acc[eh * 8 + e8], 0, 0, 0);
        }
    }
    float ss = 0.f;
#pragma unroll
    for (int et = 0; et < 16; ++et) ss += (acc[et][0] * acc[et][0] + acc[et][1] * acc[et][1]) + (acc[et][2] * acc[et][2] + acc[et][3] * acc[et][3]);
    ss += __shfl_xor(ss, 16); ss += __shfl_xor(ss, 32);
    const float rstd = rsqrtf(ss * (1.f / DV) + EPS);
    const bf16* rgp = U + (t0 + il) * INC + OFF_RG + h * DV + 4 * g;
    bf16* rnp = (bf16*)(a.ws + WS_A4) + (t0 + il) * K4 + CONV_CH + h * DV + 4 * g;
#pragma unroll
    for (int et = 0; et < 16; ++et) {
        const v2u rg = *(const v2u*)(rgp + 16 * et);
        const float o0 = acc[et][0] * rstd * silu_f(bflo(rg.x)), o1 = acc[et][1] * rstd * silu_f(bfhi(rg.x)), o2 = acc[et][2] * rstd * silu_f(bflo(rg.y)), o3 = acc[et][3] * rstd * silu_f(bfhi(rg.y));
        v2u w; w.x = pk2(o0, o1); w.y = pk2(o2, o3); *(v2u*)(rnp + 16 * et) = w;
    }
}
__device__ __forceinline__ int* route_eid(unsigned char* ws) { return (int*)(ws + WS_ROUTE); }
__device__ __forceinline__ int* route_pos(unsigned char* ws) { return (int*)(ws + WS_ROUTE) + NA; }
__device__ __forceinline__ float* route_cw(unsigned char* ws) { return (float*)(ws + WS_ROUTE) + 2 * NA; }
__device__ __forceinline__ int* route_list(unsigned char* ws) { return (int*)(ws + WS_ROUTE + al256((size_t)NA * 12)); }

__device__ __forceinline__ const GAS char* uni_ptr(const void* p) { const unsigned long long v = (unsigned long long)p;
    return (const GAS char*)(((unsigned long long)(unsigned)__builtin_amdgcn_readfirstlane((int)(v >> 32)) << 32) | (unsigned long long)(unsigned)__builtin_amdgcn_readfirstlane((int)(v & 0xffffffffu))); }
constexpr int P6_TAB = 0, P6_HI = 16384, P6_RS = 1040, P6_LO = P6_HI + 32 * P6_RS, P6_LG = P6_LO + 32 * P6_RS, P6_CP = 0;
__device__ __forceinline__ void p6_route(const Args& a, LAS unsigned char* lds, int tid, int lane, int wave, int G, unsigned long long* tsv = nullptr) {
    unsigned char* ws = a.ws;
    const float* MOD = (const float*)(ws + WS_MOD); const float* X1 = (const float*)(ws + WS_X1); bf16* H2 = (bf16*)(ws + WS_H);
    const float* g = a.in[I_N2G]; const bf16* WRT = (const bf16*)(ws + WS_WRT);
    LAS float* tsc = (LAS float*)(lds + P6_TAB); LAS float* tsh = tsc + D; LAS float* lg = (LAS float*)(lds + P6_LG);
    int* cnt = (int*)(ws + WS_CTL) + CW_CNT;
    const int fr = lane & 15, fq = lane >> 4;
    for (int rb = blockIdx.x; rb < T / 32; rb += G) {
        const int b = (rb * 32) / SEQ;
        asm volatile("" : "+s"(WRT), "+s"(g));
        __syncthreads();
        { const GAS char* mb = uni_ptr(MOD + (size_t)b * MODC + 3 * D);
          for (int d = tid; d < D; d += 512) { tsh[d] = *(const GAS float*)(mb + (unsigned)d * 4u); tsc[d] = 1.f + *(const GAS float*)(mb + (unsigned)(D + d) * 4u); } }
        __syncthreads();
#define P6_PUT(rr_, c_) do { const int rl = wave * 4 + (rr_); _Pragma("unroll") for (int jj = 0; jj < 2; ++jj) { const int dl = 4 * lane + 256 * jj; const f32x4 x = hv[rr_][2 * (c_) + jj]; \
            const unsigned h0 = f2bf(x.x), h1 = f2bf(x.y), h2_ = f2bf(x.z), h3 = f2bf(x.w); \
            const float l0 = x.x - __builtin_bit_cast(float, h0 << 16), l1 = x.y - __builtin_bit_cast(float, h1 << 16), l2 = x.z - __builtin_bit_cast(float, h2_ << 16), l3 = x.w - __builtin_bit_cast(float, h3 << 16); \
            v2u wh, wl; wh.x = h0 | (h1 << 16); wh.y = h2_ | (h3 << 16); wl.x = pk2(l0, l1); wl.y = pk2(l2, l3); \
            *(LAS v2u*)(lds + P6_HI + rl * P6_RS + dl * 2) = wh; *(LAS v2u*)(lds + P6_LO + rl * P6_RS + dl * 2) = wl; } } while (0)
        f32x4 hv[4][8];
        { f32x4 gg[8];
#pragma unroll
          for (int rr = 0; rr < 4; ++rr)
#pragma unroll
            for (int j = 0; j < 8; ++j) hv[rr][j] = *(const GAS f32x4*)(uni_ptr(X1 + (size_t)(rb * 32 + wave * 4 + rr) * D + 256 * j) + lane * 16);
#pragma unroll
          for (int j = 0; j < 8; ++j) gg[j] = *(const GAS f32x4*)(uni_ptr(g + 256 * j) + lane * 16);
#pragma unroll
          for (int rr = 0; rr < 4; ++rr) {
            float s = 0.f;
#pragma unroll
            for (int j = 0; j < 8; ++j) s += (hv[rr][j].x * hv[rr][j].x + hv[rr][j].y * hv[rr][j].y) + (hv[rr][j].z * hv[rr][j].z + hv[rr][j].w * hv[rr][j].w);
            const float rstd = rsqrtf(wave_sum(s) * (1.f / D) + EPS);
            GAS char* o8 = (GAS char*)uni_ptr(H2 + (size_t)(rb * 32 + wave * 4 + rr) * D);
#pragma unroll
            for (int j = 0; j < 8; ++j) { const int d = 4 * lane + 256 * j; const f32x4 cs = *(const LAS f32x4*)(tsc + d), sh = *(const LAS f32x4*)(tsh + d);
                hv[rr][j] = hv[rr][j] * rstd * gg[j] * cs + sh; v2u w; w.x = pk2(hv[rr][j].x, hv[rr][j].y); w.y = pk2(hv[rr][j].z, hv[rr][j].w); *(GAS v2u*)(o8 + 512 * j + lane * 8) = w; }
            P6_PUT(rr, 0);
          } }
        if (tsv) tsv[0] = __builtin_amdgcn_s_memrealtime();
        f32x4 acc[2][3];
#pragma unroll
        for (int mt = 0; mt < 2; ++mt)
#pragma unroll
            for (int n = 0; n < 3; ++n) acc[mt][n] = (f32x4){0.f, 0.f, 0.f, 0.f};
        bf16x8 bq[2][2][3];
#define P6_LOADB(c_, dst) do { const unsigned vo_ = (unsigned)((fr * D + 8 * fq) * 2); _Pragma("unroll") for (int kk = 0; kk < 2; ++kk) _Pragma("unroll") for (int n = 0; n < 3; ++n) { \
            const bf16* w0_ = WRT + (size_t)(n * 16) * D + 512 * (c_) + (2 * wave + kk) * 32; \
            dst[kk][0][n] = *(const GAS bf16x8*)(uni_ptr(w0_) + vo_); dst[kk][1][n] = *(const GAS bf16x8*)(uni_ptr(w0_ + (size_t)48 * D) + vo_); } } while (0)
#pragma unroll
        for (int c = 0; c < 4; ++c) {
            P6_LOADB(c, bq);
            if (c > 0) {
#pragma unroll
                for (int rr = 0; rr < 4; ++rr) P6_PUT(rr, c); }
            __syncthreads();
#pragma unroll
            for (int kk = 0; kk < 2; ++kk) { const int ks = 2 * wave + kk;
                bf16x8 ah[2], al[2];
#pragma unroll
                for (int mt = 0; mt < 2; ++mt) { ah[mt] = *(const LAS bf16x8*)(lds + P6_HI + (mt * 16 + fr) * P6_RS + (ks * 32 + 8 * fq) * 2); al[mt] = *(const LAS bf16x8*)(lds + P6_LO + (mt * 16 + fr) * P6_RS + (ks * 32 + 8 * fq) * 2); }
#pragma unroll
                for (int mt = 0; mt < 2; ++mt)
#pragma unroll
                    for (int n = 0; n < 3; ++n) { f32x4 t = acc[mt][n];
                        t = __builtin_amdgcn_mfma_f32_16x16x32_bf16(al[mt], bq[kk][1][n], t, 0, 0, 0); t = __builtin_amdgcn_mfma_f32_16x16x32_bf16(al[mt], bq[kk][0][n], t, 0, 0, 0);
                        t = __builtin_amdgcn_mfma_f32_16x16x32_bf16(ah[mt], bq[kk][1][n], t, 0, 0, 0); t = __builtin_amdgcn_mfma_f32_16x16x32_bf16(ah[mt], bq[kk][0][n], t, 0, 0, 0); acc[mt][n] = t; } }
            __syncthreads();
        }
#undef P6_LOADB
#undef P6_PUT
        if (tsv) tsv[1] = __builtin_amdgcn_s_memrealtime();
#pragma unroll
        for (int mt = 0; mt < 2; ++mt)
#pragma unroll
            for (int n = 0; n < 3; ++n) *(LAS f32x4*)(lds + P6_CP + ((wave * 6 + mt * 3 + n) * 64 + lane) * 16) = acc[mt][n];
        __syncthreads();
        for (int idx = tid; idx < 6 * 256; idx += 512) { const int tile = idx >> 8, ln = (idx >> 2) & 63, reg = idx & 3; float s = 0.f;
#pragma unroll
            for (int w = 0; w < 8; ++w) s += *(const LAS float*)(lds + P6_CP + ((w * 6 + tile) * 64 + ln) * 16 + reg * 4);
            const int mt = tile / 3, n = tile % 3, row = mt * 16 + 4 * (ln >> 4) + reg, o = n * 16 + (ln & 15);
            lg[row * 48 + o] = s + (o < 4 ? a.in[I_BRG][o] : (o < 36 ? a.in[I_BRE][o - 4] : 0.f)); }
        __syncthreads();
        if (tsv) tsv[2] = __builtin_amdgcn_s_memrealtime();
        if (tid < 32) {
            const LAS float* l = lg + tid * 48;
            int gs = 0; float m = l[0];
#pragma unroll
            for (int q = 1; q < 4; ++q) { const float v = l[q]; if (v > m) { m = v; gs = q; } }
            float den = 0.f;
#pragma unroll
            for (int q = 0; q < 4; ++q) den += __expf(l[q] - m);
            const float gw = 1.f / den;
            float el[8];
#pragma unroll
            for (int i = 0; i < 8; ++i) el[i] = l[4 + gs * 8 + i];
            float m2 = el[0];
#pragma unroll
            for (int i = 1; i < 8; ++i) m2 = fmaxf(m2, el[i]);
            float pr[8];
#pragma unroll
            for (int i = 0; i < 8; ++i) pr[i] = __expf(el[i] - m2);
            int i1 = 0; float p1 = pr[0];
#pragma unroll
            for (int i = 1; i < 8; ++i) if (pr[i] > p1) { p1 = pr[i]; i1 = i; }
            int i2 = -1; float p2 = -1.f;
#pragma unroll
            for (int i = 0; i < 8; ++i) if (i != i1 && pr[i] > p2) { p2 = pr[i]; i2 = i; }
            const float sden = 1.f / (p1 + p2);
            const int t = rb * 32 + tid; const int e0 = gs * 8 + i1, e1 = gs * 8 + i2;
            const int sh = rb & 7;
            const int q0 = sh * 1024 + atomicAdd(&cnt[sh * 32 + e0], 1), q1 = sh * 1024 + atomicAdd(&cnt[sh * 32 + e1], 1);
            route_eid(ws)[2 * t] = e0; route_eid(ws)[2 * t + 1] = e1; route_pos(ws)[2 * t] = q0; route_pos(ws)[2 * t + 1] = q1;
            route_cw(ws)[2 * t] = gw * p1 * sden; route_cw(ws)[2 * t + 1] = gw * p2 * sden;
            route_list(ws)[(size_t)e0 * T + q0] = t; route_list(ws)[(size_t)e1 * T + q1] = t;
        }
    }
}

constexpr int MT = MOE_MT;
struct MoeTab { LAS int* cnt; LAS int* tpre; LAS int* tile_e; LAS int* gstart; LAS int* gtile; LAS int* spre; };
__device__ __forceinline__ MoeTab moe_tab(LAS unsigned char* lds) { MoeTab t; t.cnt = (LAS int*)(lds + LDSTAB_OFF); t.tpre = t.cnt + 32; t.tile_e = t.tpre + 40; t.gstart = t.tile_e + 168; t.gtile = t.gstart + 16; t.spre = t.gtile + 200; return t; }
__device__ __forceinline__ int moe_lidx(const LAS int* spre, int e, int idx) { const LAS int* p = spre + e * 8; int s = 0;
#pragma unroll
    for (int j = 1; j < 8; ++j) s += (idx >= p[j]) ? 1 : 0;
    return s * 1024 + idx - p[s]; }
__device__ __forceinline__ void moe_build_tab(const Args& a, LAS unsigned char* lds, int tid) {
    MoeTab t = moe_tab(lds); const int* cnt = (const int*)(a.ws + WS_CTL) + CW_CNT;
    LAS int* gexp = t.gtile + 168;
    __syncthreads();
    if (tid < 64) {
        const int e = tid & 31; int c = 0; int cs[8];
#pragma unroll
        for (int s = 0; s < 8; ++s) cs[s] = cnt[s * 32 + e];
        __builtin_amdgcn_sched_barrier(0);
#pragma unroll
        for (int s = 0; s < 8; ++s) { if (tid < 32) t.spre[e * 8 + s] = c; c += cs[s]; }
        const int n = (c + MT - 1) / MT;
        int incl = n;
#pragma unroll
        for (int o = 1; o < 32; o <<= 1) { const int v = __shfl_up(incl, o, 32); if (e >= o) incl += v; }
        const int pre = incl - n;
        int rank = 0;
#pragma unroll
        for (int j = 0; j < 32; ++j) { const int nj = __shfl(n, j, 32); rank += (nj > n || (nj == n && j < e)) ? 1 : 0; }
        const int pass = rank >> 3, col = rank & 7, grp = (pass & 1) ? 7 - col : col;
        if (tid < 32) { t.cnt[e] = c; t.tpre[e] = pre; if (e == 31) t.tpre[NE] = incl; gexp[grp * 4 + pass] = e;
            for (int i = 0; i < n; ++i) t.tile_e[pre + i] = e; }
        asm volatile("s_waitcnt lgkmcnt(0)" ::: "memory");
        const int x = tid & 7; int ex[4], nx[4], tot = 0;
#pragma unroll
        for (int p = 0; p < 4; ++p) { ex[p] = gexp[x * 4 + p]; nx[p] = __shfl(n, ex[p], 32); tot += nx[p]; }
        int gi = tot;
#pragma unroll
        for (int o = 1; o < 8; o <<= 1) { const int v = __shfl_up(gi, o, 8); if (x >= o) gi += v; }
        if (tid < 8) { t.gstart[x] = gi - tot; if (x == 7) t.gstart[8] = gi; }
        int k0s[4];
#pragma unroll
        for (int p = 0; p < 4; ++p) k0s[p] = __shfl(pre, ex[p], 32);
        if (tid < 8) { int pos = gi - tot;
#pragma unroll
            for (int p = 0; p < 4; ++p) for (int i = 0; i < nx[p]; ++i) t.gtile[pos++] = k0s[p] + i; }
    }
    __syncthreads();
}
template <bool GATHER> struct MoeOrder {
    MoeTab tab; const char* A; const char* Bt; const int* list; int G, c, K, ldb; size_t eBstride;
    __device__ __forceinline__ bool next(int i, Unit& u) const {
        const int L = i * G + c; const int total = tab.tpre[NE] * 8; if (L >= total) return false;
        const int rtg = L >> 3; u.pn = L & 7; u.e = tab.tile_e[rtg]; u.pm = rtg - tab.tpre[u.e]; u.row0 = rtg * 256; u.half = 0; return true;
    }
    __device__ __forceinline__ const char* a_tile(const Unit& u, size_t tstep) const { return GATHER ? A : A + (size_t)(u.row0 / 256) * tstep; }
    __device__ __forceinline__ const char* b_tile(const Unit& u, size_t tstep) const { return Bt + (size_t)u.e * eBstride + (ldb ? (size_t)u.pn * 512 : (size_t)u.pn * tstep); }
    __device__ __forceinline__ void a_offsets(const Unit& u, const int (&R)[2], const int (&C)[2], int K_, unsigned (&vo)[2][2]) const {
        const int ce = tab.cnt[u.e];
#pragma unroll
        for (int h = 0; h < 2; ++h)
#pragma unroll
            for (int i = 0; i < 2; ++i) { int idx = u.pm * 256 + h * 128 + R[i]; idx = idx < ce ? idx : ce - 1; const int tok = list[(size_t)u.e * T + moe_lidx(tab.spre, u.e, idx)]; vo[h][i] = (unsigned)(tok * K_ + C[i]) * 2u; }
    }
};
struct EpiHM {
    static constexpr bool PERM = true; bf16* HM;
    __device__ __forceinline__ void operator()(const f32x4 (&acc)[2][2][4][2], const Unit& u, int wr, int wc, int fr, int fq) const {
        const int row0 = u.row0 + wr * 64 + fr, col0 = u.pn * 128 + wc * 32 + 8 * fq;
#pragma unroll
        for (int ai = 0; ai < 2; ++ai)
#pragma unroll
            for (int m = 0; m < 4; ++m) { const f32x4 g0 = acc[ai][0][m][0], g1 = acc[ai][0][m][1], u0 = acc[ai][1][m][0], u1 = acc[ai][1][m][1];
                u32x4 w; w.x = cvt_pk_bf16(silu_f(g0[0]) * u0[0], silu_f(g0[1]) * u0[1]); w.y = cvt_pk_bf16(silu_f(g0[2]) * u0[2], silu_f(g0[3]) * u0[3]);
                w.z = cvt_pk_bf16(silu_f(g1[0]) * u1[0], silu_f(g1[1]) * u1[1]); w.w = cvt_pk_bf16(silu_f(g1[2]) * u1[2], silu_f(g1[3]) * u1[3]);
                *(u32x4*)(HM + (size_t)(row0 + ai * 128 + m * 16) * DE + col0) = w; }
    }
};

struct EpiHMn {
    static constexpr bool PERM = false; bf16* HM;
    __device__ __forceinline__ void operator()(const f32x4 (&acc)[2][2][4][2], const Unit& u, int wr, int wc, int fr, int fq) const {
        const int row0 = u.row0 + wr * 64 + fr, col0 = u.pn * 128 + wc * 32 + 4 * fq;
#pragma unroll
        for (int ai = 0; ai < 2; ++ai)
#pragma unroll
            for (int m = 0; m < 4; ++m)
#pragma unroll
                for (int n = 0; n < 2; ++n) { const f32x4 g0 = acc[ai][0][m][n], u0 = acc[ai][1][m][n];
                    v2u w; w.x = cvt_pk_bf16(silu_f(g0[0]) * u0[0], silu_f(g0[1]) * u0[1]); w.y = cvt_pk_bf16(silu_f(g0[2]) * u0[2], silu_f(g0[3]) * u0[3]);
                    *(v2u*)(HM + (size_t)(row0 + ai * 128 + m * 16) * DE + col0 + 16 * n) = w; }
    }
};
struct EpiBf16n {
    static constexpr bool PERM = false; bf16* O; int ldc;
    __device__ __forceinline__ void operator()(const f32x4 (&acc)[2][2][4][2], const Unit& u, int wr, int wc, int fr, int fq) const {
        const int row0 = u.row0 + wr * 64 + fr, col0 = u.pn * 256 + wc * 32 + 4 * fq;
#pragma unroll
        for (int ai = 0; ai < 2; ++ai)
#pragma unroll
            for (int m = 0; m < 4; ++m) { bf16* rowp = O + (size_t)(row0 + ai * 128 + m * 16) * ldc + col0;
#pragma unroll
                for (int bj = 0; bj < 2; ++bj)
#pragma unroll
                    for (int n = 0; n < 2; ++n) { const f32x4 v = acc[ai][bj][m][n]; v2u w; w.x = cvt_pk_bf16(v[0], v[1]); w.y = cvt_pk_bf16(v[2], v[3]); *(v2u*)(rowp + bj * 128 + 16 * n) = w; } }
    }
};

constexpr int PGM_A = 0, PGM_B = 49152, PGM_LDS = PGM_B + 65536;
struct MoeUnit { int e, pn, rt, row0, hs, tq; };
template <bool GATHER, class Epi>
__device__ __forceinline__ void moe_gemm(LAS unsigned char* lds, const int K, const MoeTab tab, const int G, const int c, const char* A, const int* list,
                                          const float* B0, const float* B1, const size_t eB, const int ldb, const int colstep, const Epi& E) {
    const int tid = threadIdx.x, wid = __builtin_amdgcn_readfirstlane(tid >> 6), lane = tid & 63, wr = wid >> 2, wc = wid & 3, fr = lane & 15, fq = lane >> 4;
    const int nt = K / 64, ntiles = tab.tpre[NE];
    int stR[2], stC[2];
#pragma unroll
    for (int i = 0; i < 2; ++i) pg8::stage_rc(tid * 16 + i * 8192, stR[i], stC[i]);
    const int aoff = pg8::lds_byte(wr * 64 + fr, fq * 8);
    const int kb = 8 * wid + (lane >> 5), cl = lane & 31;
    const unsigned bvo = (unsigned)((kb * ldb + 4 * cl) * 4);
    const size_t ktB = (size_t)64 * ldb * 4, rowB2 = (size_t)2 * ldb * 4;
    unsigned bw[4];
#pragma unroll
    for (int j = 0; j < 4; ++j) { const int k = kb + 2 * j; bw[j] = (unsigned)(256 * k + 16 * ((cl >> 1) ^ (((k & 3) << 2) | ((k >> 2) & 3))) + 8 * (cl & 1)); }
    unsigned tb[2][2];
    { const int q = fr >> 2, p = lane & 3;
#pragma unroll
      for (int n = 0; n < 2; ++n)
#pragma unroll
        for (int t = 0; t < 2; ++t) { const int row = 8 * fq + 4 * t + q, ch = 2 * (2 * wc + n) + (p >> 1);
            tb[n][t] = (unsigned)(uintptr_t)lds + PGM_B + (unsigned)(256 * row + 16 * (ch ^ (((row & 3) << 2) | ((row >> 2) & 3))) + 8 * (p & 1)); } }
    const bool grouped = false; const int gsz = G, gj = c, gn = ntiles;
    (void)grouped;
#define PGM_UNIT(q, u, sb0, sb1, aBp, vop) do { (u).pn = (q) / gn; const int _rtg = (q) - (u).pn * gn; (u).e = tab.tile_e[_rtg]; (u).rt = _rtg - tab.tpre[(u).e]; (u).row0 = _rtg * 128; \
        (sb0) = (const char*)(B0 + (size_t)(u).e * eB + (size_t)(u).pn * colstep); (sb1) = (const char*)(B1 + (size_t)(u).e * eB + (size_t)(u).pn * colstep); \
        if constexpr (GATHER) { const int _ce = tab.cnt[(u).e]; _Pragma("unroll") for (int _i = 0; _i < 2; ++_i) { int _idx = (u).rt * 128 + stR[_i]; _idx = _idx < _ce ? _idx : _ce - 1; \
                const int _tok = list[(size_t)(u).e * T + moe_lidx(tab.spre, (u).e, _idx)]; (vop)[_i] = (unsigned)(_tok * K + stC[_i]) * 2u; } (aBp) = A; } \
        else { _Pragma("unroll") for (int _i = 0; _i < 2; ++_i) (vop)[_i] = (unsigned)(stR[_i] * K + stC[_i]) * 2u; (aBp) = A + (size_t)(u).row0 * K * 2; } } while (0)
#define PGM_TR(dst, vb, off) asm volatile("ds_read_b64_tr_b16 %0, %1 offset:%c2" : "=&v"(dst) : "v"(vb), "i"(off) : "memory")
#define PGM_STAGE_A(buf, ap, vop, kt) do { _Pragma("unroll") for (int _i = 0; _i < 2; ++_i) \
        __builtin_amdgcn_global_load_lds((const unsigned*)((ap) + (size_t)(kt) * 128 + (vop)[_i]), (LAS unsigned*)(lds + PGM_A + (buf) * 16384 + wid * 1024 + _i * 8192), 16, 0, 0); } while (0)
#define PGM_LOAD_B(rs, p0, p1, kt) do { _Pragma("unroll") for (int _j = 0; _j < 4; ++_j) { const char* _a0 = (p0) + (size_t)(kt) * ktB + (size_t)_j * rowB2; const char* _a1 = (p1) + (size_t)(kt) * ktB + (size_t)_j * rowB2; \
        asm volatile("global_load_dwordx4 %0, %1, %2" : "=&v"(rs[0][_j]) : "v"(bvo), "s"(_a0) : "memory"); \
        asm volatile("global_load_dwordx4 %0, %1, %2" : "=&v"(rs[1][_j]) : "v"(bvo), "s"(_a1) : "memory"); } } while (0)
#define PGM_WAIT8(rs) asm volatile("s_waitcnt vmcnt(10)" : "+v"(rs[0][0]), "+v"(rs[0][1]), "+v"(rs[0][2]), "+v"(rs[0][3]), "+v"(rs[1][0]), "+v"(rs[1][1]), "+v"(rs[1][2]), "+v"(rs[1][3]) :: "memory")
#define PGM_WRITE_B(rs, buf) do { _Pragma("unroll") for (int _h = 0; _h < 2; ++_h) _Pragma("unroll") for (int _j = 0; _j < 4; ++_j) { v2u _w; _w.x = cvt_pk_bf16(rs[_h][_j].x, rs[_h][_j].y); _w.y = cvt_pk_bf16(rs[_h][_j].z, rs[_h][_j].w); \
        *(LAS v2u*)(lds + PGM_B + ((buf) * 2 + _h) * 16384 + bw[_j]) = _w; } } while (0)
#define PGM_COMPUTE(cur, abuf) do { bf16x8 At[4][2]; s16x4 bl[2][2][2], bh[2][2][2]; const LAS unsigned char* _ap = lds + PGM_A + (abuf) * 16384 + aoff; \
        _Pragma("unroll") for (int h = 0; h < 2; ++h) _Pragma("unroll") for (int n = 0; n < 2; ++n) _Pragma("unroll") for (int k = 0; k < 2; ++k) { \
            PGM_TR(bl[h][n][k], tb[n][0], ((cur) * 2 + h) * 16384 + k * 8192); PGM_TR(bh[h][n][k], tb[n][1], ((cur) * 2 + h) * 16384 + k * 8192); } \
        _Pragma("unroll") for (int mm = 0; mm < 4; ++mm) _Pragma("unroll") for (int k = 0; k < 2; ++k) At[mm][k] = *(const LAS bf16x8*)(_ap + mm * 2048 + k * 1024); \
        asm volatile("s_waitcnt lgkmcnt(0)" ::: "memory"); SBAR(); __builtin_amdgcn_s_setprio(1); \
        _Pragma("unroll") for (int h = 0; h < 2; ++h) _Pragma("unroll") for (int mm = 0; mm < 4; ++mm) _Pragma("unroll") for (int n = 0; n < 2; ++n) _Pragma("unroll") for (int k = 0; k < 2; ++k) \
            acc[h][mm][n] = __builtin_amdgcn_mfma_f32_16x16x32_bf16(PK8(bl[h][n][k], bh[h][n][k]), At[mm][k], acc[h][mm][n], 0, 0, 0); \
        __builtin_amdgcn_s_setprio(0); SBAR(); } while (0)
#define PGM_BARRIER() do { asm volatile("s_waitcnt lgkmcnt(0)" ::: "memory"); __builtin_amdgcn_s_barrier(); asm volatile("" ::: "memory"); } while (0)
    int q = gj; if (q >= gn * 8) return;
    MoeUnit cur, nxt; const char *cb0, *cb1, *caB, *nb0, *nb1, *naB; unsigned cvo[2], nvo[2];
    PGM_UNIT(q, cur, cb0, cb1, caB, cvo);
    f32x4 rs0[2][4], rs1[2][4];
    asm volatile("s_waitcnt vmcnt(0)" ::: "memory"); PGM_BARRIER();
    int a0 = 0;
    PGM_STAGE_A(0, caB, cvo, 0); PGM_LOAD_B(rs0, cb0, cb1, 0); PGM_STAGE_A(1, caB, cvo, 1); PGM_LOAD_B(rs1, cb0, cb1, 1);
    PGM_WAIT8(rs0); PGM_WRITE_B(rs0, 0); PGM_BARRIER();
    for (;;) {
        const bool has_next = q + gsz < gn * 8;
        if (has_next) { PGM_UNIT(q + gsz, nxt, nb0, nb1, naB, nvo); } else { nxt = cur; nb0 = cb0; nb1 = cb1; naB = caB; nvo[0] = cvo[0]; nvo[1] = cvo[1]; }
        f32x4 acc[2][4][2];
#pragma unroll
        for (int b = 0; b < 2; ++b)
#pragma unroll
            for (int mm = 0; mm < 4; ++mm)
#pragma unroll
                for (int n = 0; n < 2; ++n) acc[b][mm][n] = (f32x4){0.f, 0.f, 0.f, 0.f};
#pragma unroll 1
        for (int t = 0; t < nt; t += 2) {
            const bool lastp = (t == nt - 2);
            const char* p0 = lastp ? nb0 : cb0; const char* p1 = lastp ? nb1 : cb1; const char* pa = lastp ? naB : caB; const int kt2 = lastp ? 0 : t + 2;
            unsigned vo2[2]; vo2[0] = lastp ? nvo[0] : cvo[0]; vo2[1] = lastp ? nvo[1] : cvo[1];
            { const int a2 = a0 >= 1 ? a0 - 1 : 2; PGM_STAGE_A(a2, pa, vo2, kt2); } PGM_LOAD_B(rs0, p0, p1, kt2);
            PGM_COMPUTE(0, a0);
            PGM_WAIT8(rs1); PGM_WRITE_B(rs1, 1); PGM_BARRIER();
            a0 = a0 == 2 ? 0 : a0 + 1;
            { const int a2 = a0 >= 1 ? a0 - 1 : 2; PGM_STAGE_A(a2, pa, vo2, kt2 + 1); } PGM_LOAD_B(rs1, p0, p1, kt2 + 1);
            PGM_COMPUTE(1, a0);
            PGM_WAIT8(rs0); PGM_WRITE_B(rs0, 0); PGM_BARRIER();
            a0 = a0 == 2 ? 0 : a0 + 1;
        }
        E(acc, cur, wr, wc, fr, fq);
        if (!has_next) break;
        cur = nxt; cb0 = nb0; cb1 = nb1; caB = naB; cvo[0] = nvo[0]; cvo[1] = nvo[1]; q += gsz;
    }
    asm volatile("s_waitcnt vmcnt(0)" : "+v"(rs0[0][0]), "+v"(rs0[0][1]), "+v"(rs0[0][2]), "+v"(rs0[0][3]), "+v"(rs0[1][0]), "+v"(rs0[1][1]), "+v"(rs0[1][2]), "+v"(rs0[1][3]) :: "memory");
    asm volatile("" : "+v"(rs1[0][0]), "+v"(rs1[0][1]), "+v"(rs1[0][2]), "+v"(rs1[0][3]), "+v"(rs1[1][0]), "+v"(rs1[1][1]), "+v"(rs1[1][2]), "+v"(rs1[1][3]) :: "memory");
    PGM_BARRIER();
#undef PGM_UNIT
#undef PGM_TR
#undef PGM_STAGE_A
#undef PGM_LOAD_B
#undef PGM_WRITE_B
#undef PGM_WAIT8
#undef PGM_COMPUTE
#undef PGM_BARRIER
}
struct EpiHMm {
    bf16* HM;
    __device__ __forceinline__ void operator()(const f32x4 (&acc)[2][4][2], const MoeUnit& u, int wr, int wc, int fr, int fq) const {
        const int row0 = u.row0 + wr * 64 + fr, col0 = u.pn * 128 + wc * 32 + 4 * fq;
#pragma unroll
        for (int mm = 0; mm < 4; ++mm)
#pragma unroll
            for (int n = 0; n < 2; ++n) { const f32x4 g0 = acc[0][mm][n], u0 = acc[1][mm][n];
                v2u w; w.x = cvt_pk_bf16(silu_f(g0[0]) * u0[0], silu_f(g0[1]) * u0[1]); w.y = cvt_pk_bf16(silu_f(g0[2]) * u0[2], silu_f(g0[3]) * u0[3]);
                *(v2u*)(HM + (size_t)(row0 + mm * 16) * DE + col0 + 16 * n) = w; }
    }
};
struct EpiYm {
    bf16* Y;
    __device__ __forceinline__ void operator()(const f32x4 (&acc)[2][4][2], const MoeUnit& u, int wr, int wc, int fr, int fq) const {
        const int row0 = u.row0 + wr * 64 + fr, col0 = u.pn * 256 + wc * 32 + 4 * fq;
#pragma unroll
        for (int mm = 0; mm < 4; ++mm)
#pragma unroll
            for (int bj = 0; bj < 2; ++bj)
#pragma unroll
                for (int n = 0; n < 2; ++n) { const f32x4 v = acc[bj][mm][n]; v2u w; w.x = cvt_pk_bf16(v[0], v[1]); w.y = cvt_pk_bf16(v[2], v[3]); *(v2u*)(Y + (size_t)(row0 + mm * 16) * D + col0 + bj * 128 + 16 * n) = w; }
    }
};

constexpr int PGX_A = 0, PGX_B = 65536;
template <bool GATHER, class Epi, bool KSPLIT = false>
__device__ __forceinline__ void moe_gemm256(LAS unsigned char* lds, const int K, const MoeTab tab, const int G, const int c, const char* A, const int* list,
                                             const float* B0, const float* B1, const size_t eB, const int ldb, const int colstep, const Epi& E) {
    const int tid = threadIdx.x, wid = __builtin_amdgcn_readfirstlane(tid >> 6), lane = tid & 63, wr = wid >> 2, wc = wid & 3, fr = lane & 15, fq = lane >> 4;
    const int nt = K / 64, gn = tab.tpre[NE];
    int stR[2], stC[2];
#pragma unroll
    for (int i = 0; i < 2; ++i) pg8::stage_rc(tid * 16 + i * 8192, stR[i], stC[i]);
    const int aoff = pg8::lds_byte(wr * 64 + fr, fq * 8);
    const int kb = 8 * wid + (lane >> 5), cl = lane & 31;
    const unsigned bvo = (unsigned)((kb * ldb + 4 * cl) * 4);
    const size_t ktB = (size_t)64 * ldb * 4, rowB2 = (size_t)2 * ldb * 4;
    unsigned bw0; { const int k = kb; bw0 = (unsigned)(256 * k + 8 * (cl & 1)); }
    unsigned tb[2][2];
    { const int q = fr >> 2, p = lane & 3;
#pragma unroll
      for (int n = 0; n < 2; ++n)
#pragma unroll
        for (int t = 0; t < 2; ++t) { const int row = 8 * fq + 4 * t + q, ch = 2 * (2 * wc + n) + (p >> 1);
            tb[n][t] = (unsigned)(uintptr_t)lds + PGX_B + (unsigned)(256 * row + 16 * (ch ^ (((row & 3) << 2) | ((row >> 2) & 3))) + 8 * (p & 1)); } }
#define PGX_UNIT(q, u, sb0, sb1, aBp, vop) do { const int _q = (x_split && (q) >= x_full) ? x_full + (((q) - x_full) >> 1) : (q); (u).hs = (x_split && (q) >= x_full) ? (((q) - x_full) & 1) : -1; \
        (u).pn = _q / gn; const int _rtg = _q - (u).pn * gn; (u).e = tab.tile_e[_rtg]; (u).rt = _rtg - tab.tpre[(u).e]; (u).row0 = _rtg * 256; \
        (u).tq = (x_split && (q) >= x_full) ? (((q) - x_full) >> 1) : 0; \
        { const size_t _bo = KSPLIT ? ((u).hs > 0 ? (size_t)(K / 2) * ldb : 0) : ((u).hs > 0 ? 64 : 0); \
          (sb0) = (const char*)(B0 + (size_t)(u).e * eB + (size_t)(u).pn * colstep + _bo); (sb1) = (const char*)(B1 + (size_t)(u).e * eB + (size_t)(u).pn * colstep + _bo); } \
        if constexpr (GATHER) { const int _ce = tab.cnt[(u).e]; _Pragma("unroll") for (int _h = 0; _h < 2; ++_h) _Pragma("unroll") for (int _i = 0; _i < 2; ++_i) { int _idx = (u).rt * 256 + _h * 128 + stR[_i]; _idx = _idx < _ce ? _idx : _ce - 1; \
                const int _tok = list[(size_t)(u).e * T + moe_lidx(tab.spre, (u).e, _idx)]; (vop)[_h][_i] = (unsigned)(_tok * K + stC[_i]) * 2u; } (aBp) = A; } \
        else { _Pragma("unroll") for (int _h = 0; _h < 2; ++_h) _Pragma("unroll") for (int _i = 0; _i < 2; ++_i) (vop)[_h][_i] = (unsigned)((_h * 128 + stR[_i]) * K + stC[_i]) * 2u; (aBp) = A + (size_t)(u).row0 * K * 2 + ((KSPLIT && (u).hs > 0) ? (size_t)K : 0); } } while (0)
#define PGX_TR(dst, vb, off) asm volatile("ds_read_b64_tr_b16 %0, %1 offset:%c2" : "=&v"(dst) : "v"(vb), "i"(off) : "memory")
#define PGX_STAGE_A(buf, ap, vop, kt) do { _Pragma("unroll") for (int _h = 0; _h < 2; ++_h) _Pragma("unroll") for (int _i = 0; _i < 2; ++_i) \
        __builtin_amdgcn_global_load_lds((const unsigned*)((ap) + (size_t)(kt) * 128 + (vop)[_h][_i]), (LAS unsigned*)(lds + PGX_A + ((buf) * 2 + _h) * 16384 + wid * 1024 + _i * 8192), 16, 0, 0); } while (0)
#define PGX_LOAD_B(rs, p0, p1, kt, hf) do { if (!(hf) || cl < 16) _Pragma("unroll") for (int _j = 0; _j < 4; ++_j) { const char* _a0 = (p0) + (size_t)(kt) * ktB + (size_t)_j * rowB2; const char* _a1 = (p1) + (size_t)(kt) * ktB + (size_t)_j * rowB2; \
        asm volatile("global_load_dwordx4 %0, %1, %2" : "=&v"(rs[0][_j]) : "v"(bvo), "s"(_a0) : "memory"); \
        asm volatile("global_load_dwordx4 %0, %1, %2" : "=&v"(rs[1][_j]) : "v"(bvo), "s"(_a1) : "memory"); } } while (0)
#define PGX_WAIT0(rs) asm volatile("s_waitcnt vmcnt(0)" : "+v"(rs[0][0]), "+v"(rs[0][1]), "+v"(rs[0][2]), "+v"(rs[0][3]), "+v"(rs[1][0]), "+v"(rs[1][1]), "+v"(rs[1][2]), "+v"(rs[1][3]) :: "memory")
#define PGX_WRITE_B(rs, buf) do { _Pragma("unroll") for (int _j = 0; _j < 4; ++_j) { const int _k = kb + 2 * _j; const unsigned _o = bw0 + 512u * _j + 16u * (unsigned)((cl >> 1) ^ (((_k & 3) << 2) | ((_k >> 2) & 3))); \
        _Pragma("unroll") for (int _h = 0; _h < 2; ++_h) { v2u _w; _w.x = cvt_pk_bf16(rs[_h][_j].x, rs[_h][_j].y); _w.y = cvt_pk_bf16(rs[_h][_j].z, rs[_h][_j].w); *(LAS v2u*)(lds + PGX_B + ((buf) * 2 + _h) * 16384 + _o) = _w; } } } while (0)
#define PGX_COMPUTE(cur) do { _Pragma("unroll") for (int h = 0; h < 2; ++h) { s16x4 bl[2][2], bh[2][2]; \
        _Pragma("unroll") for (int n = 0; n < 2; ++n) _Pragma("unroll") for (int k = 0; k < 2; ++k) { PGX_TR(bl[n][k], tb[n][0], ((cur) * 2 + h) * 16384 + k * 8192); PGX_TR(bh[n][k], tb[n][1], ((cur) * 2 + h) * 16384 + k * 8192); } \
        _Pragma("unroll") for (int ai = 0; ai < 2; ++ai) { bf16x8 At[4][2]; \
            _Pragma("unroll") for (int mm = 0; mm < 4; ++mm) _Pragma("unroll") for (int k = 0; k < 2; ++k) At[mm][k] = *(const LAS bf16x8*)(lds + PGX_A + ((cur) * 2 + ai) * 16384 + aoff + mm * 2048 + k * 1024); \
            asm volatile("s_waitcnt lgkmcnt(0)" ::: "memory"); SBAR(); __builtin_amdgcn_s_setprio(1); \
            _Pragma("unroll") for (int mm = 0; mm < 4; ++mm) _Pragma("unroll") for (int n = 0; n < 2; ++n) _Pragma("unroll") for (int k = 0; k < 2; ++k) \
                acc[ai][h][mm][n] = __builtin_amdgcn_mfma_f32_16x16x32_bf16(PK8(bl[n][k], bh[n][k]), At[mm][k], acc[ai][h][mm][n], 0, 0, 0); \
            __builtin_amdgcn_s_setprio(0); SBAR(); } } } while (0)
#define PGX_BARRIER() do { asm volatile("s_waitcnt lgkmcnt(0)" ::: "memory"); __builtin_amdgcn_s_barrier(); asm volatile("" ::: "memory"); } while (0)
    const int x_total = gn * 8, x_full = (x_total / G) * G, x_tail = x_total - x_full; const bool x_split = MOE_TAILSPLIT && x_tail > 0 && 2 * x_tail <= G;
    const int x_n = x_split ? x_full + 2 * x_tail : x_total;
    const int r_full = (x_n / G) * G, r_rem = x_n - r_full; int tq = -1;
    if (r_rem > 0) { if (G % 8 == 0) { const int per = G / 8, xg = c / per, ig = c % per, lo_ = (xg * r_rem) / 8, hi_ = ((xg + 1) * r_rem) / 8; if (lo_ + ig < hi_) tq = r_full + lo_ + ig; } else if (c < r_rem) tq = r_full + c; }
    int q = c < r_full ? c : tq; if (q < 0) return;
    MoeUnit cur, nxt; const char *cb0, *cb1, *caB, *nb0, *nb1, *naB; unsigned cvo[2][2], nvo[2][2];
    PGX_UNIT(q, cur, cb0, cb1, caB, cvo);
    f32x4 rs[2][4];
    asm volatile("s_waitcnt vmcnt(0)" ::: "memory"); PGX_BARRIER();
    PGX_STAGE_A(0, caB, cvo, 0); PGX_LOAD_B(rs, cb0, cb1, 0, !KSPLIT && cur.hs >= 0);
    PGX_WAIT0(rs); PGX_WRITE_B(rs, 0); PGX_LOAD_B(rs, cb0, cb1, 1, !KSPLIT && cur.hs >= 0); PGX_BARRIER();
    for (;;) {
        const int qn = (q + G < r_full) ? q + G : (q < r_full ? tq : -1); const bool has_next = qn >= 0;
        if (has_next) { PGX_UNIT(qn, nxt, nb0, nb1, naB, nvo); } else { nxt = cur; nb0 = cb0; nb1 = cb1; naB = caB;
#pragma unroll
            for (int h = 0; h < 2; ++h) { nvo[h][0] = cvo[h][0]; nvo[h][1] = cvo[h][1]; } }
        f32x4 acc[2][2][4][2];
#pragma unroll
        for (int a = 0; a < 2; ++a)
#pragma unroll
            for (int b = 0; b < 2; ++b)
#pragma unroll
                for (int mm = 0; mm < 4; ++mm)
#pragma unroll
                    for (int n = 0; n < 2; ++n) acc[a][b][mm][n] = (f32x4){0.f, 0.f, 0.f, 0.f};
        const int ntu = (KSPLIT && cur.hs >= 0) ? nt / 2 : nt;
#pragma unroll 1
        for (int t = 0; t < ntu; t += 2) {
            const bool lastp = (t == ntu - 2);
            int ts = t; asm volatile("" : "+s"(ts));
            const char* p0 = lastp ? nb0 : cb0; const char* p1 = lastp ? nb1 : cb1; const char* pa = lastp ? naB : caB; const int kt2 = lastp ? 0 : ts + 2; const bool hf2 = !KSPLIT && (lastp ? nxt.hs : cur.hs) >= 0;
            PGX_STAGE_A(1, caB, cvo, ts + 1);
            PGX_COMPUTE(0);
            PGX_WAIT0(rs); PGX_WRITE_B(rs, 1); PGX_LOAD_B(rs, p0, p1, kt2, hf2); PGX_BARRIER();
            { unsigned vo2[2][2];
#pragma unroll
              for (int h = 0; h < 2; ++h) { vo2[h][0] = lastp ? nvo[h][0] : cvo[h][0]; vo2[h][1] = lastp ? nvo[h][1] : cvo[h][1]; }
              PGX_STAGE_A(0, pa, vo2, kt2); }
            PGX_COMPUTE(1);
            PGX_WAIT0(rs); PGX_WRITE_B(rs, 0); PGX_LOAD_B(rs, p0, p1, kt2 + 1, hf2); PGX_BARRIER();
        }
        E(acc, cur, wr, wc, fr, fq);
        if (!has_next) break;
        cur = nxt; cb0 = nb0; cb1 = nb1; caB = naB; q = qn;
#pragma unroll
        for (int h = 0; h < 2; ++h) { cvo[h][0] = nvo[h][0]; cvo[h][1] = nvo[h][1]; }
    }
    PGX_WAIT0(rs); PGX_BARRIER();
#undef PGX_UNIT
#undef PGX_TR
#undef PGX_STAGE_A
#undef PGX_LOAD_B
#undef PGX_WAIT0
#undef PGX_WRITE_B
#undef PGX_COMPUTE
#undef PGX_BARRIER
}
struct EpiHMx {
    bf16* HM;
    __device__ __forceinline__ void operator()(const f32x4 (&acc)[2][2][4][2], const MoeUnit& u, int wr, int wc, int fr, int fq) const {
        if (u.hs >= 0 && wc >= 2) return;
        const int row0 = u.row0 + wr * 64 + fr, col0 = u.pn * 128 + (u.hs > 0 ? 64 : 0) + wc * 32 + 4 * fq;
#pragma unroll
        for (int ai = 0; ai < 2; ++ai)
#pragma unroll
            for (int mm = 0; mm < 4; ++mm)
#pragma unroll
                for (int n = 0; n < 2; ++n) { const f32x4 g0 = acc[ai][0][mm][n], u0 = acc[ai][1][mm][n];
                    v2u w; w.x = cvt_pk_bf16(silu_f(g0[0]) * u0[0], silu_f(g0[1]) * u0[1]); w.y = cvt_pk_bf16(silu_f(g0[2]) * u0[2], silu_f(g0[3]) * u0[3]);
                    *(v2u*)(HM + (size_t)(row0 + ai * 128 + mm * 16) * DE + col0 + 16 * n) = w; }
    }
};
struct EpiYx {
    bf16* Y;
    __device__ __forceinline__ void operator()(const f32x4 (&acc)[2][2][4][2], const MoeUnit& u, int wr, int wc, int fr, int fq) const {
        if (u.hs >= 0 && wc >= 2) return;
        const int row0 = u.row0 + wr * 64 + fr, col0 = u.pn * 256 + (u.hs > 0 ? 64 : 0) + wc * 32 + 4 * fq;
#pragma unroll
        for (int ai = 0; ai < 2; ++ai)
#pragma unroll
            for (int mm = 0; mm < 4; ++mm)
#pragma unroll
                for (int bj = 0; bj < 2; ++bj)
#pragma unroll
                    for (int n = 0; n < 2; ++n) { const f32x4 v = acc[ai][bj][mm][n]; v2u w; w.x = cvt_pk_bf16(v[0], v[1]); w.y = cvt_pk_bf16(v[2], v[3]); *(v2u*)(Y + (size_t)(row0 + ai * 128 + mm * 16) * D + col0 + bj * 128 + 16 * n) = w; }
    }
};

struct EpiYk {
    bf16* Y; bf16* Y2;
    template <int PITCH> __device__ __forceinline__ void put(const f32x4 (&acc)[2][2][4][2], bf16* base, int wr, int wc, int fr, int fq) const {
        int r_ = wr * 64 + fr; asm volatile("" : "+v"(r_));
        bf16* p = base + (size_t)r_ * PITCH + wc * 32 + 4 * fq;
#pragma unroll
        for (int ai = 0; ai < 2; ++ai)
#pragma unroll
            for (int mm = 0; mm < 4; ++mm)
#pragma unroll
                for (int bj = 0; bj < 2; ++bj)
#pragma unroll
                    for (int n = 0; n < 2; ++n) { const f32x4 v = acc[ai][bj][mm][n]; v2u w; w.x = cvt_pk_bf16(v[0], v[1]); w.y = cvt_pk_bf16(v[2], v[3]); *(v2u*)(p + (size_t)(ai * 128 + mm * 16) * PITCH + bj * 128 + 16 * n) = w; }
    }
    __device__ __forceinline__ void operator()(const f32x4 (&acc)[2][2][4][2], const MoeUnit& u, int wr, int wc, int fr, int fq) const {
        if (u.hs > 0) put<256>(acc, Y2 + (size_t)u.tq * 65536, wr, wc, fr, fq); else put<D>(acc, Y + (size_t)u.row0 * D + u.pn * 256, wr, wc, fr, fq);
    }
};

template <bool SPLIT>
__device__ __forceinline__ void p9_tokens(const Args& a, const MoeTab& tab, int lane, int gw, int NGW, int ks_gn, int ks_full) {
    unsigned char* ws = a.ws;
    const float* MOD = (const float*)(ws + WS_MOD); const float* X1 = (const float*)(ws + WS_X1); const bf16* Y = (const bf16*)(ws + WS_Y); const float* gf = a.in[I_NFG];
    const bf16* Y2 = (const bf16*)(ws + WS_Y2); const bf16* ZR = (const bf16*)(ws + WS_ZERO);
    f32x4 gfv[8];
#pragma unroll
    for (int j = 0; j < 8; ++j) gfv[j] = *((const f32x4*)gf + lane + 64 * j);
    int ne0 = 0, ne1 = 0, np0 = 0, np1 = 0; float nw0 = 0.f, nw1 = 0.f;
    if (gw < T) { ne0 = route_eid(ws)[2 * gw]; ne1 = route_eid(ws)[2 * gw + 1]; np0 = route_pos(ws)[2 * gw]; np1 = route_pos(ws)[2 * gw + 1]; nw0 = route_cw(ws)[2 * gw]; nw1 = route_cw(ws)[2 * gw + 1]; }
    for (int t = gw; t < T; t += NGW) {
        const int b = t / SEQ;
        const int e0 = ne0, e1 = ne1;
        const int rr0 = __builtin_amdgcn_readfirstlane(tab.tpre[e0] * MT + tab.spre[e0 * 8 + (np0 >> 10)] + (np0 & 1023)), rr1 = __builtin_amdgcn_readfirstlane(tab.tpre[e1] * MT + tab.spre[e1 * 8 + (np1 >> 10)] + (np1 & 1023));
        const size_t r0 = (size_t)rr0, r1 = (size_t)rr1;
        const float w0 = nw0, w1 = nw1;
        { const int tn = t + NGW; if (tn < T) { ne0 = route_eid(ws)[2 * tn]; ne1 = route_eid(ws)[2 * tn + 1]; np0 = route_pos(ws)[2 * tn]; np1 = route_pos(ws)[2 * tn + 1]; nw0 = route_cw(ws)[2 * tn]; nw1 = route_cw(ws)[2 * tn + 1]; } }
        const GAS f32x4* xr = (const GAS f32x4*)(X1 + (size_t)t * D) + lane; const GAS v2u* y0 = (const GAS v2u*)(Y + r0 * D) + lane; const GAS v2u* y1 = (const GAS v2u*)(Y + r1 * D) + lane;
        const f32x4* g2 = (const f32x4*)(MOD + (size_t)b * MODC + 5 * D) + lane;
        f32x4 v[8]; float s = 0.f;
#pragma unroll
        for (int j = 0; j < 8; ++j) { v2u a0 = y0[64 * j], a1 = y1[64 * j]; const f32x4 gg = g2[64 * j];
            float p0[4] = {bflo(a0.x), bfhi(a0.x), bflo(a0.y), bfhi(a0.y)}, p1[4] = {bflo(a1.x), bfhi(a1.x), bflo(a1.y), bfhi(a1.y)};
            if constexpr (SPLIT) {
                const int q0 = j * ks_gn + (rr0 >> 8) - ks_full, q1 = j * ks_gn + (rr1 >> 8) - ks_full;
                const bf16* z0 = q0 >= 0 ? Y2 + ((size_t)q0 * 256 + (rr0 & 255)) * 256 : ZR; const bf16* z1 = q1 >= 0 ? Y2 + ((size_t)q1 * 256 + (rr1 & 255)) * 256 : ZR;
                const v2u b0 = *((const GAS v2u*)z0 + lane), b1 = *((const GAS v2u*)z1 + lane);
                p0[0] += bflo(b0.x); p0[1] += bfhi(b0.x); p0[2] += bflo(b0.y); p0[3] += bfhi(b0.y);
                p1[0] += bflo(b1.x); p1[1] += bfhi(b1.x); p1[2] += bflo(b1.y); p1[3] += bfhi(b1.y); }
            f32x4 y; y.x = w0 * p0[0] + w1 * p1[0]; y.y = w0 * p0[1] + w1 * p1[1]; y.z = w0 * p0[2] + w1 * p1[2]; y.w = w0 * p0[3] + w1 * p1[3];
            v[j] = xr[64 * j] + gg * y; s += (v[j].x * v[j].x + v[j].y * v[j].y) + (v[j].z * v[j].z + v[j].w * v[j].w); }
        const float rstd = rsqrtf(wave_sum(s) * (1.f / D) + EPS);
        GAS f32x4* o = (GAS f32x4*)(a.out + (size_t)t * D) + lane;
#pragma unroll
        for (int j = 0; j < 8; ++j) o[64 * j] = v[j] * rstd * gfv[j];
    }
}
__device__ __forceinline__ void p9_final(const Args& a, LAS unsigned char* lds, int tid, int lane, int wave, int vcu, int G) {
    MoeTab tab = moe_tab(lds);
    const int gw = vcu * NWAVES + wave, NGW = G * NWAVES;
    const int ks_gn = tab.tpre[NE], ks_total = ks_gn * 8, ks_full = (ks_total / G) * G; const bool ks_split = MOE_KSPLIT && (ks_total - ks_full) > 0 && 2 * (ks_total - ks_full) <= G;
    if (ks_split) p9_tokens<true>(a, tab, lane, gw, NGW, ks_gn, ks_full); else p9_tokens<false>(a, tab, lane, gw, NGW, ks_gn, ks_full);
}
constexpr size_t NG8 = (size_t)NE * D * DE / 8;
struct SideCvt {
    static constexpr bool ON = true;
    const float* wsrc[3]; bf16* WGU; bf16* WDn; size_t GT; unsigned vsrc, vgu, vdn; int spm, sl, sl_end;
    __device__ __forceinline__ void init(const Args& a, size_t gt, size_t GT_, int first, int last) { wsrc[0] = a.in[I_WG]; wsrc[1] = a.in[I_WU]; wsrc[2] = a.in[I_WD]; WGU = (bf16*)(a.ws + WS_WGU); WDn = (bf16*)(a.ws + WS_WD);
        GT = GT_; spm = (int)(NG8 / GT); sl = first; sl_end = last;
        const size_t i0 = gt * 8; const size_t ek0 = i0 / DE; const int n0 = (int)(i0 % DE);
        vsrc = (unsigned)(i0 * 4); vgu = (unsigned)((ek0 * (2 * DE) + (n0 / 128) * 256 + (n0 % 128)) * 2); vdn = (unsigned)(i0 * 2); }
    __device__ __forceinline__ void load(f32x4 (&v)[2][2]) {
#pragma unroll
        for (int j = 0; j < 2; ++j) { const int s = (sl + j < sl_end) ? sl + j : sl_end - 1; const int which = s >= 2 * spm ? 2 : (s >= spm ? 1 : 0); const int r = s - which * spm;
            const float* sb = (which == 2 ? wsrc[2] : which == 1 ? wsrc[1] : wsrc[0]) + (size_t)r * GT * 8;
            asm volatile("global_load_dwordx4 %0, %1, %2 nt" : "=&v"(v[j][0]) : "v"(vsrc), "s"(sb) : "memory");
            asm volatile("global_load_dwordx4 %0, %1, %2 offset:16 nt" : "=&v"(v[j][1]) : "v"(vsrc), "s"(sb) : "memory"); }
        sl += 2;
    }
    template <int NWAIT> __device__ __forceinline__ void store(f32x4 (&v)[2][2]) {
        if constexpr (NWAIT == 16) asm volatile("s_waitcnt vmcnt(16)" : "+v"(v[0][0]), "+v"(v[0][1]), "+v"(v[1][0]), "+v"(v[1][1]) :: "memory");
        else asm volatile("s_waitcnt vmcnt(0)" : "+v"(v[0][0]), "+v"(v[0][1]), "+v"(v[1][0]), "+v"(v[1][1]) :: "memory");
#pragma unroll
        for (int j = 0; j < 2; ++j) { const int s = (sl - 2 + j < sl_end) ? sl - 2 + j : sl_end - 1; const int which = s >= 2 * spm ? 2 : (s >= spm ? 1 : 0); const int r = s - which * spm;
            v4u o; o.x = cvt_pk_bf16(v[j][0].x, v[j][0].y); o.y = cvt_pk_bf16(v[j][0].z, v[j][0].w); o.z = cvt_pk_bf16(v[j][1].x, v[j][1].y); o.w = cvt_pk_bf16(v[j][1].z, v[j][1].w);
            char* db = which == 2 ? (char*)WDn + (size_t)r * GT * 16 : (char*)WGU + (size_t)r * GT * 32 + (which == 1 ? 256 : 0);
            const unsigned vo = which == 2 ? vdn : vgu;
            *(v4u*)(db + vo) = o; }
    }
};

__global__ void __launch_bounds__(NWAVES * 64, 2) mega(Args args) {
    extern __shared__ __attribute__((aligned(16))) unsigned char lds_raw[];
    LAS unsigned char* lds = (LAS unsigned char*)lds_raw;
    volatile LAS unsigned* MISC = (volatile LAS unsigned*)(lds + MISC_OFF);
    const int tid = threadIdx.x, lane = tid & 63, wave = __builtin_amdgcn_readfirstlane(tid >> 6);
    const int G = gridDim.x; const int bx = blockIdx.x; const int vcu = (G % 8 == 0) ? (bx % 8) * (G / 8) + bx / 8 : bx;
    unsigned char* ws = args.ws;
    gu32* ctl = (gu32*)(ws + WS_CTL);
    for (int u = tid; u < (LDS_BYTES - LDSCTL_OFF) / 4; u += NWAVES * 64) ((LAS unsigned*)(lds + LDSCTL_OFF))[u] = 0u;
    __syncthreads();
    const int lo = args.ph_lo, hi = args.ph_hi;
    XcdBarrier bar; bar.bar = (unsigned*)(ctl + CW_BAR) + lo * XCD_BAR_WORDS; bar.x = 0; bar.st = nullptr;
    if (hi - lo > 1) bar = xcd_barrier_post((unsigned*)(ctl + CW_BAR) + lo * XCD_BAR_WORDS, MISC + 8);
#if SIDE_CVT
    const bool side_ok = (NG8 % ((size_t)G * 512)) == 0; const int side_spm = (int)(NG8 / ((size_t)G * 512));
    int sdn_sl = 2 * side_spm;
#define SDN_BEGIN() SideCvt sdn; sdn.init(args, (size_t)bx * 512 + tid, (size_t)G * 512, sdn_sl, 3 * side_spm)
#define SDN_END() sdn_sl = sdn.sl
#else
    const bool side_ok = false;
#endif
#ifdef PROBE_PH
    unsigned long long pts_a = 0, pts_b = 0;
#endif
#define IN(k) (lo <= (k) && (k) < hi)
#define SEAM(k) do { if (IN(k) && IN((k) + 1)) xcd_barrier(bar, threadIdx.x == 0); } while (0)

#ifdef PROBE_PH
    if (PROBE_PH == 0) pts_a = __builtin_amdgcn_s_memrealtime(); else if (PROBE_PH + 1 == 0) pts_b = __builtin_amdgcn_s_memrealtime();
#endif
#if defined(PROBE_PH) && defined(PROBE_P0SUB)
    unsigned long long ts_iv[2] = {0, 0}; const unsigned long long ts_k0 = __builtin_amdgcn_s_memrealtime();
    if (IN(0)) { p0_prologue(args, lds, tid, lane, wave, vcu, G, false, ts_iv); }
    const unsigned long long ts_it = ts_iv[0];
    if (PROBE_P0SUB == 4) { pts_a = ts_k0; pts_b = ts_iv[1]; }
    if (PROBE_P0SUB == 1) { pts_a = ts_k0; pts_b = ts_it; }
    if (PROBE_P0SUB == 2) { pts_a = ts_it; pts_b = __builtin_amdgcn_s_memrealtime(); }
    if (PROBE_P0SUB == 3) pts_a = __builtin_amdgcn_s_memrealtime();
    SEAM(0);
#else
    if (IN(0)) { p0_prologue(args, lds, tid, lane, wave, vcu, G, false); } SEAM(0);
#endif
#ifdef PROBE_PH
    if (PROBE_PH == 1) pts_a = __builtin_amdgcn_s_memrealtime(); else if (PROBE_PH + 1 == 1) pts_b = __builtin_amdgcn_s_memrealtime();
#endif
    if (IN(1)) { p1_norm(args, lds, tid, lane, wave, G); } SEAM(1);
#ifdef PROBE_PH
    if (PROBE_PH == 2) pts_a = __builtin_amdgcn_s_memrealtime(); else if (PROBE_PH + 1 == 2) pts_b = __builtin_amdgcn_s_memrealtime();
#endif
    if (IN(2)) {
        pg8::StaticOrder S; S.init((const bf16*)(ws + WS_H), (const bf16*)(ws + WS_WIN), T, INC, G, bx);
        EpiBf16 E{(bf16*)(ws + WS_U), INC};
#if SIDE_CVT
        if (side_ok) {
            SideCvt sd; sd.init(args, (size_t)bx * 512 + tid, (size_t)G * 512, 0, 2 * side_spm);
            pg8::gemm_phase<EpiBf16, pg8::StaticOrder, true, false, false, SideCvt>(lds + RING_OFF, D, S, E, &sd);
            while (sd.sl < sd.sl_end) { f32x4 sv[2][2]; sd.load(sv); sd.store<0>(sv); }
        } else
#endif
        pg8::gemm_phase<EpiBf16, pg8::StaticOrder, true, false>(lds + RING_OFF, D, S, E);
#if TAIL_W4 && P0_V2 && !LATE_W4
        { const int nwg2 = (T / 256) * (INC / 256), rem = nwg2 % G; const bool helper = rem == 0 || bx >= rem;
          if (helper) { const int hi_ = rem == 0 ? bx : bx - rem, nh = rem == 0 ? G : G - rem;
              __syncthreads();
              tr_range(args, (LAS float*)(lds + wave * 12288), lane, I_WIN_N_ + hi_ * NWAVES + wave, nh * NWAVES, I_TR_ALL); } }
#endif
#if PG8_HALF_TAIL
        { pg8::StaticOrder S2 = S; S2.tail = 1; EpiBf16H E2{(bf16*)(ws + WS_U), INC};
          pg8::gemm_phase<EpiBf16H, pg8::StaticOrder, true, false, false, pg8::NoSide, true>(lds + RING_OFF, D, S2, E2); }
#endif
    } SEAM(2);
#ifdef PROBE_PH
    if (PROBE_PH == 3) pts_a = __builtin_amdgcn_s_memrealtime(); else if (PROBE_PH + 1 == 3) pts_b = __builtin_amdgcn_s_memrealtime();
#endif
    if (IN(3)) { for (int u = bx; u < NB * RH * NCH; u += G) p3a_unit(args, lds, u, tid, lane, wave);
#if LATE_W4
        __syncthreads(); late_w4_convert(args, lds, lane, wave, vcu, G);
#endif
    } SEAM(3);
#ifdef PROBE_PH
    if (PROBE_PH == 4) pts_a = __builtin_amdgcn_s_memrealtime(); else if (PROBE_PH + 1 == 4) pts_b = __builtin_amdgcn_s_memrealtime();
#endif
    if (IN(4)) { p3b_scan_conv(args, tid, lane, wave, vcu, G); } SEAM(4);
#ifdef PROBE_PH
    if (PROBE_PH == 5) pts_a = __builtin_amdgcn_s_memrealtime(); else if (PROBE_PH + 1 == 5) pts_b = __builtin_amdgcn_s_memrealtime();
#endif
    if (IN(5)) { for (int u = bx; u < NB * RH * NCH; u += G) p3c_unit(args, lds, u, tid, lane, wave); } SEAM(5);
#ifdef PROBE_PH
    if (PROBE_PH == 6) pts_a = __builtin_amdgcn_s_memrealtime(); else if (PROBE_PH + 1 == 6) pts_b = __builtin_amdgcn_s_memrealtime();
#endif
    if (IN(6)) {
        pg8::StaticOrder S; S.init((const bf16*)(ws + WS_A4), (const bf16*)(ws + WS_W4), T, D, G, bx);
        EpiMG2 E{(const bf16*)(ws + WS_U), (bf16*)(ws + WS_MG)};
        pg8::gemm_phase<EpiMG2, pg8::StaticOrder, true, false, false, pg8::NoSide, false, true>(lds + RING_OFF, K4, S, E);
    } SEAM(6);
#ifdef PROBE_PH
    if (PROBE_PH == 7) pts_a = __builtin_amdgcn_s_memrealtime(); else if (PROBE_PH + 1 == 7) pts_b = __builtin_amdgcn_s_memrealtime();
#endif
    if (IN(7)) {
        pg8::StaticOrder S; S.init((const bf16*)(ws + WS_MG), (const bf16*)(ws + WS_WO), T, D, G, bx);
        EpiX1 E{args.in[I_X], (const float*)(ws + WS_MOD), (float*)(ws + WS_X1)};
#if SIDE_CVT
        if (side_ok) { SDN_BEGIN(); pg8::gemm_phase<EpiX1, pg8::StaticOrder, true, false, false, SideCvt>(lds + RING_OFF, D, S, E, &sdn);
            while (sdn.sl < sdn.sl_end) { f32x4 sv[2][2]; sdn.load(sv); sdn.store<0>(sv); } } else
#endif
        pg8::gemm_phase<EpiX1, pg8::StaticOrder, true, false>(lds + RING_OFF, D, S, E);
    } SEAM(7);
#ifdef PROBE_PH
    if (PROBE_PH == 8) pts_a = __builtin_amdgcn_s_memrealtime(); else if (PROBE_PH + 1 == 8) pts_b = __builtin_amdgcn_s_memrealtime();
#endif
#if defined(PROBE_PH) && defined(PROBE_P6SUB)
    { unsigned long long tsv[3] = {0, 0, 0}; const unsigned long long t_in = __builtin_amdgcn_s_memrealtime();
      if (IN(8)) { p6_route(args, lds, tid, lane, wave, G, tsv); }
      const unsigned long long t_out = __builtin_amdgcn_s_memrealtime();
      if (PROBE_P6SUB == 0) { pts_a = t_in; pts_b = tsv[0]; } else if (PROBE_P6SUB == 1) { pts_a = tsv[0]; pts_b = tsv[1]; } else if (PROBE_P6SUB == 2) { pts_a = tsv[1]; pts_b = tsv[2]; } else { pts_a = tsv[2]; pts_b = t_out; } }
    SEAM(8);
#else
    if (IN(8)) { p6_route(args, lds, tid, lane, wave, G); } SEAM(8);
#endif
#ifdef PROBE_PH
    if (PROBE_PH == 9) pts_a = __builtin_amdgcn_s_memrealtime(); else if (PROBE_PH + 1 == 9) pts_b = __builtin_amdgcn_s_memrealtime();
#endif
    if (IN(9)) {
        moe_build_tab(args, lds, tid);
#if MOE_E
        EpiHMe E{(bf16*)(ws + WS_HM)};
        moe_gemmE<true, EpiHMe>(lds, D, moe_tab(lds), G, vcu, (const char*)(ws + WS_H), route_list(ws), args.in[I_WG], args.in[I_WU], (size_t)D * DE, DE, 64, E);
#elif MOE_MT == 256
        EpiHMx E{(bf16*)(ws + WS_HM)};
                moe_gemm256<true, EpiHMx>(lds, D, moe_tab(lds), G, vcu, (const char*)(ws + WS_H), route_list(ws), args.in[I_WG], args.in[I_WU], (size_t)D * DE, DE, 128, E);
#else
        EpiHMm E{(bf16*)(ws + WS_HM)};
        moe_gemm<true, EpiHMm>(lds, D, moe_tab(lds), G, vcu, (const char*)(ws + WS_H), route_list(ws), args.in[I_WG], args.in[I_WU], (size_t)D * DE, DE, 128, E);
#endif
    } SEAM(9);
#ifdef PROBE_PH
    if (PROBE_PH == 10) pts_a = __builtin_amdgcn_s_memrealtime(); else if (PROBE_PH + 1 == 10) pts_b = __builtin_amdgcn_s_memrealtime();
#endif
    if (IN(10)) {
        if (lo == 10) moe_build_tab(args, lds, tid);
#if MOE_E
        EpiYe E{(bf16*)(ws + WS_Y)};
        moe_gemmE<false, EpiYe>(lds, DE, moe_tab(lds), G, vcu, (const char*)(ws + WS_HM), nullptr, args.in[I_WD], args.in[I_WD] + 64, (size_t)DE * D, D, 128, E);
#elif MOE_MT == 256
#if MOE_KSPLIT
        EpiYk E{(bf16*)(ws + WS_Y), (bf16*)(ws + WS_Y2)};
        moe_gemm256<false, EpiYk, true>(lds, DE, moe_tab(lds), G, vcu, (const char*)(ws + WS_HM), nullptr, args.in[I_WD], args.in[I_WD] + 128, (size_t)DE * D, D, 256, E);
#else
        EpiYx E{(bf16*)(ws + WS_Y)};
        moe_gemm256<false, EpiYx>(lds, DE, moe_tab(lds), G, vcu, (const char*)(ws + WS_HM), nullptr, args.in[I_WD], args.in[I_WD] + 128, (size_t)DE * D, D, 256, E);
#endif
#else
        EpiYm E{(bf16*)(ws + WS_Y)};
        moe_gemm<false, EpiYm>(lds, DE, moe_tab(lds), G, vcu, (const char*)(ws + WS_HM), nullptr, args.in[I_WD], args.in[I_WD] + 128, (size_t)DE * D, D, 256, E);
#endif
    }
    if (IN(10) && IN(11)) xcd_barrier(bar, wave == 0 && lane_id() == 0);
#ifdef PROBE_PH
    if (PROBE_PH == 11) pts_a = __builtin_amdgcn_s_memrealtime(); else if (PROBE_PH + 1 == 11) pts_b = __builtin_amdgcn_s_memrealtime();
#endif
    if (IN(11)) { const int lane2 = lane_id(), tid2 = wave * 64 + lane2; if (lo == 11) moe_build_tab(args, lds, tid2); p9_final(args, lds, tid2, lane2, wave, vcu, G); }
#ifdef PROBE_PH
    if (bx == PROBE_BX && wave == PROBE_WV) {
        if (PROBE_PH == 11) pts_b = __builtin_amdgcn_s_memrealtime();
        const long long v = (long long)(pts_b - pts_a);
        const unsigned long long t0 = __builtin_amdgcn_s_memrealtime();
        while ((long long)(__builtin_amdgcn_s_memrealtime() - t0) < v * 10) __builtin_amdgcn_s_sleep(32);
    }
#endif
#undef IN
#undef SEAM
}
#ifndef MK_ONE_LAUNCH
#define MK_ONE_LAUNCH 0
#endif
constexpr int N_PHASES = 12;
extern "C" void kernel_launch(void* const* d_in, const int* in_sizes, int n_in, void* d_out, int out_size, void* d_ws, size_t ws_size, hipStream_t stream) {
    static int grid = 0;
    if (grid == 0) {
        int dev = 0, cus = 0;
        if (hipGetDevice(&dev) != hipSuccess || hipDeviceGetAttribute(&cus, hipDeviceAttributeMultiprocessorCount, dev) != hipSuccess) { grid = -1; return; }
        if (hipFuncSetAttribute((const void*)mega, hipFuncAttributeMaxDynamicSharedMemorySize, LDS_BYTES) != hipSuccess) { fprintf(stderr, "hipFuncSetAttribute failed\n"); grid = -1; return; }
        if (ws_size < WS_END || n_in != 19) { fprintf(stderr, "ws too small / bad inputs: %zu < %zu\n", ws_size, (size_t)WS_END); grid = -1; return; }
        int per_cu = 0;
        if (hipOccupancyMaxActiveBlocksPerMultiprocessor(&per_cu, (const void*)mega, NWAVES * 64, LDS_BYTES) != hipSuccess || per_cu < 1) fprintf(stderr, "occupancy query: %d\n", per_cu);
        (void)hipGetLastError();
        grid = cus;
    }
    if (grid < 0) return;
    unsigned char* ws = (unsigned char*)d_ws;
    (void)hipMemsetAsync(ws + WS_CTL, 0, CTL_ZERO_BYTES, stream);
    Args a{};
    for (int i = 0; i < 19; ++i) a.in[i] = (const float*)d_in[i];
    a.out = (float*)d_out; a.ws = ws;
#if MK_ONE_LAUNCH
    a.ph_lo = 0; a.ph_hi = N_PHASES; hipLaunchKernelGGL(mega, dim3(grid), dim3(NWAVES * 64), LDS_BYTES, stream, a);
#ifdef PROBE_EXTRA
    a.ph_lo = PROBE_EXTRA; a.ph_hi = PROBE_EXTRA + 1; hipLaunchKernelGGL(mega, dim3(grid), dim3(NWAVES * 64), LDS_BYTES, stream, a);
#endif
#else
    for (int ph = 0; ph < N_PHASES; ++ph) { a.ph_lo = ph; a.ph_hi = ph + 1; hipLaunchKernelGGL(mega, dim3(grid), dim3(NWAVES * 64), LDS_BYTES, stream, a); }
#endif
}
```

```cpp
#define MK_ONE_LAUNCH 1
#include <hip/hip_runtime.h>
#include <cstdint>
#include <cstdio>

constexpr int D = 2048, NB = 4, SEQ = 2048, T = NB * SEQ;
constexpr int CONV_CH = 1024, RH = 8, DK = 128, DV = 256, RQK = 1024, RV = 2048, CHUNK = 128, NCH = SEQ / CHUNK;
constexpr int NE = 32, DE = 1024, NA = T * 2;
constexpr int INC = 13312, MODC = 6 * D;
constexpr int OFF_CB = 0, OFF_CC = 1024, OFF_CX = 2048, OFF_Q = 3072, OFF_K = 4096, OFF_V = 5120, OFF_RG = 7168, OFF_GA = 9216, OFF_GB = 11264;
constexpr float EPS = 1e-6f;
constexpr int ADA_KS = 16;
#ifndef MOE_MT
#define MOE_MT 256
#endif
constexpr int RPAD = NA + NE * MOE_MT;

constexpr size_t al256(size_t x) { return (x + 255) & ~(size_t)255; }
constexpr size_t WS_CTL = 0, CTL_ZERO_BYTES = 1u << 20;
constexpr size_t WS_ZERO = WS_CTL + (768u << 10);
constexpr size_t WS_MODP = WS_CTL + CTL_ZERO_BYTES;
constexpr size_t WS_MOD = WS_MODP + al256((size_t)ADA_KS * 4 * MODC * 4);
constexpr size_t WS_ROPE = WS_MOD + al256((size_t)4 * MODC * 4);
constexpr size_t WS_WRT = WS_ROPE + al256((size_t)2 * SEQ * 64 * 4);
constexpr size_t WS_WIN = WS_WRT + al256((size_t)2 * 48 * D * 2);
constexpr int K4 = CONV_CH + RV;
constexpr size_t WS_W4 = WS_WIN + al256((size_t)INC * D * 2);
constexpr size_t WS_WO = WS_W4 + al256((size_t)D * K4 * 2);
constexpr size_t WS_WGU = WS_WO + al256((size_t)D * D * 2);
constexpr size_t WS_WD = WS_WGU + al256((size_t)NE * 2 * DE * D * 2);
constexpr size_t WS_H = WS_WD + al256((size_t)NE * D * DE * 2);
constexpr size_t WS_U = WS_H + al256((size_t)T * D * 2);
constexpr size_t WS_KVT = WS_U + al256((size_t)T * INC * 2);
constexpr size_t WS_SPT = WS_KVT + al256((size_t)NB * RH * NCH * DV * DK * 2);
constexpr size_t WS_A4 = WS_SPT + al256((size_t)NB * RH * NCH * DV * DK * 2);
constexpr size_t WS_T1 = WS_A4 + al256((size_t)T * K4 * 2);
constexpr size_t WS_MG = WS_T1 + al256((size_t)T * D * 2);
constexpr size_t WS_X1 = WS_MG + al256((size_t)T * D * 2);
constexpr size_t WS_ROUTE = WS_X1 + al256((size_t)T * D * 4);
constexpr size_t WS_END = WS_ROUTE + al256((size_t)NA * 12) + al256((size_t)NE * T * 4);
constexpr size_t WS_HM = WS_U;
constexpr size_t WS_Y = WS_HM + al256((size_t)RPAD * DE * 2);
constexpr size_t WS_Y2 = WS_Y + al256((size_t)RPAD * D * 2);
static_assert(WS_Y2 + (size_t)128 * 65536 * 2 <= WS_KVT, "HM/Y/Y2 overlay fits inside U");
#ifndef P0_T64
#define P0_T64 1
#endif
#ifndef TAIL_W4
#define TAIL_W4 1
#endif
#ifndef P0_V2
#define P0_V2 1
#endif
#ifndef ROUTE_NSH
#define ROUTE_NSH 16
#endif
constexpr int NSH = ROUTE_NSH, SHCAP = 8192 / ROUTE_NSH;
#ifndef MOE_SKIPHALF
#define MOE_SKIPHALF 1
#endif
#ifndef MOE_TAILSPLIT
#define MOE_TAILSPLIT 0
#endif
#ifndef MOE_KSPLIT
#define MOE_KSPLIT 0
#endif
constexpr int CW_CNT = 64;
constexpr int CW_BAR = 4096;

constexpr int RING_OFF = 0, RING_BYTES = 131072;
constexpr int LDSCTL_OFF = RING_BYTES, MISC_OFF = LDSCTL_OFF + 320;
constexpr int LDSTAB_OFF = MISC_OFF + 128;
constexpr int LDS_BYTES = 147456;
constexpr int NWAVES = 8;

#define GAS __attribute__((address_space(1)))
#define LAS __attribute__((address_space(3)))
typedef unsigned short bf16;
typedef unsigned v4u __attribute__((ext_vector_type(4)));
typedef unsigned v2u __attribute__((ext_vector_type(2)));
typedef float f32x4 __attribute__((ext_vector_type(4)));
typedef short bf16x8 __attribute__((ext_vector_type(8)));
typedef short bf16x4 __attribute__((ext_vector_type(4)));
typedef GAS unsigned gu32;
#define RLX_AGENT __ATOMIC_RELAXED, __HIP_MEMORY_SCOPE_AGENT
#define LDS_WAIT() asm volatile("s_waitcnt lgkmcnt(0)" ::: "memory")
#define VM_WAIT() asm volatile("s_waitcnt vmcnt(0)" ::: "memory")
__device__ __forceinline__ unsigned f2bf(float f) { unsigned u = __builtin_bit_cast(unsigned, f); return (u + 0x7fffu + ((u >> 16) & 1u)) >> 16; }
__device__ __forceinline__ unsigned pk2(float lo, float hi) { return f2bf(lo) | (f2bf(hi) << 16); }
__device__ __forceinline__ float bf2f(unsigned short b) { return __builtin_bit_cast(float, (unsigned)b << 16); }
__device__ __forceinline__ float bflo(unsigned w) { return __builtin_bit_cast(float, w << 16); }
__device__ __forceinline__ float bfhi(unsigned w) { return __builtin_bit_cast(float, w & 0xffff0000u); }
__device__ __forceinline__ float silu_f(float v) { return v * __builtin_amdgcn_rcpf(1.f + __expf(-v)); }
__device__ __forceinline__ float sigm_f(float v) { return __builtin_amdgcn_rcpf(1.f + __expf(-v)); }
__device__ __forceinline__ float wave_sum(float v) {
#pragma unroll
    for (int o = 1; o < 64; o <<= 1) v += __shfl_xor(v, o);
    return v;
}

#define XB_TMO      128
#define XB_XCNT(j)  (256  + 64 * (j))
#define XB_XSUB(j)  (1280 + 64 * (j))
#define XB_XGEN(j)  (2304 + 64 * (j))
#define XB_TOP      3328
#define XB_TOPGEN   3392
#define XCD_BAR_WORDS 3456
#define XB_SPIN_CAP (1u << 18)
__device__ __forceinline__ unsigned xb_ld(unsigned* p)              { return __hip_atomic_load(p, __ATOMIC_RELAXED, __HIP_MEMORY_SCOPE_AGENT); }
__device__ __forceinline__ unsigned xb_add(unsigned* p, unsigned v) { return __hip_atomic_fetch_add(p, v, __ATOMIC_RELAXED, __HIP_MEMORY_SCOPE_AGENT); }
__device__ __forceinline__ unsigned xb_xcc_id() { return (unsigned)__builtin_amdgcn_s_getreg((3 << 11) | 20) & 0xFu; }
#define XB_SPIN(cond, bar) do { unsigned _sp = 0; while (cond) { __builtin_amdgcn_s_sleep(1); \
    if ((++_sp & 255u) == 0u) { if (xb_ld(&(bar)[XB_TMO])) break; if (_sp > XB_SPIN_CAP) { atomicAdd(&(bar)[XB_TMO], 1u); break; } } } } while (0)
struct XcdBarrier { unsigned* bar; unsigned x; volatile LAS unsigned* st; };
__device__ __forceinline__ XcdBarrier xcd_barrier_post(unsigned* bar, volatile LAS unsigned* st) {
    XcdBarrier b; b.bar = bar; b.x = xb_xcc_id(); b.st = st;
    if (threadIdx.x == 0) (void)xb_add(&bar[XB_XCNT(b.x)], 1u);
    return b;
}
__device__ __forceinline__ void xcd_barrier_complete(unsigned* bar, unsigned x, unsigned& nloc, unsigned& nx) {
    const unsigned G = gridDim.x * gridDim.y * gridDim.z;
    unsigned sum, cnt, mine, sp = 0u;
    for (;;) {
        sum = 0u; cnt = 0u; mine = 0u;
#pragma unroll
        for (unsigned j = 0; j < 16; ++j) { const unsigned c = xb_ld(&bar[XB_XCNT(j)]); sum += c; cnt += (c > 0u) ? 1u : 0u; mine = (j == x) ? c : mine; }
        if (sum == G) break;
        __builtin_amdgcn_s_sleep(1);
        if ((++sp & 255u) == 0u) { if (xb_ld(&bar[XB_TMO])) break; if (sp > XB_SPIN_CAP) { atomicAdd(&bar[XB_TMO], 1u); break; } }
    }
    nloc = mine > 0u ? mine : 1u; nx = cnt > 0u ? cnt : 1u;
}
__device__ __forceinline__ int lane_id() { return (int)__builtin_amdgcn_mbcnt_hi(~0u, __builtin_amdgcn_mbcnt_lo(~0u, 0u)); }
__device__ __forceinline__ void xcd_barrier(const XcdBarrier& b, const bool t0) {
    asm volatile("s_waitcnt vmcnt(0)" ::: "memory");
    __syncthreads();
    if (t0) {
        unsigned* bar = b.bar;
        __builtin_amdgcn_s_waitcnt(0);
        unsigned nloc = b.st[0], nx = b.st[1];
        if (nloc == 0u) { xcd_barrier_complete(bar, b.x, nloc, nx); b.st[0] = nloc; b.st[1] = nx; }
        const unsigned old = xb_add(&bar[XB_XSUB(b.x)], 1u);
        const unsigned gen = old / nloc;
        if (old + 1u == (gen + 1u) * nloc) {
            __builtin_amdgcn_fence(__ATOMIC_RELEASE, "agent");
            asm volatile("s_waitcnt vmcnt(0)" ::: "memory");
            const unsigned og = xb_add(&bar[XB_TOP], 1u);
            const unsigned tg = og / nx;
            if (og + 1u == (tg + 1u) * nx) xb_add(&bar[XB_TOPGEN], 1u);
            else XB_SPIN(xb_ld(&bar[XB_TOPGEN]) == tg, bar);
            __builtin_amdgcn_fence(__ATOMIC_ACQUIRE, "agent");
            xb_add(&bar[XB_XGEN(b.x)], 1u);
            asm volatile("s_waitcnt vmcnt(0)" ::: "memory");
        } else {
            XB_SPIN(xb_ld(&bar[XB_XGEN(b.x)]) == gen, bar);
            __builtin_amdgcn_fence(__ATOMIC_ACQUIRE, "agent");
            asm volatile("s_waitcnt vmcnt(0)" ::: "memory");
        }
    }
    __syncthreads();
}
namespace pg8 {
#define PG8_LAS __attribute__((address_space(3)))
typedef unsigned short bf16_t;
typedef short bf16x8 __attribute__((ext_vector_type(8)));
typedef float f32x4 __attribute__((ext_vector_type(4)));
typedef float f32x2 __attribute__((ext_vector_type(2)));
typedef unsigned u32x4 __attribute__((ext_vector_type(4)));
typedef unsigned u32x2 __attribute__((ext_vector_type(2)));
constexpr int BM = 256, BK = 64, HALF = 128, HTB = HALF * BK * 2  , STAGE_BYTES = 8 * HTB, NXCD = 8, WGM = 8;

__host__ __device__ __forceinline__ int lds_byte(int r, int c) { const int st = (r >> 4) * 2 + (c >> 5), rr = r & 15, cc = c & 31, ob = rr * 64 + cc * 2; return st * 1024 + (ob ^ (((ob >> 9) & 1) << 5)); }
__host__ __device__ __forceinline__ void stage_rc(int b, int& R, int& C) { const int st = b / 1024, sb = b % 1024, swz = sb ^ (((sb >> 9) & 1) << 5); R = (st >> 1) * 16 + swz / 64; C = (st & 1) * 32 + (swz % 64) / 2; }
__host__ __device__ __forceinline__ int perm32(int rho) { const int n = rho >> 4, i = rho & 15; return 8 * (i >> 2) + 4 * n + (i & 3); }

#ifndef PG8_HALF_TAIL
#define PG8_HALF_TAIL 0
#endif
struct Unit { int pm, pn, e, row0, half; };

struct StaticOrder {
    const bf16_t* A; const bf16_t* Bt; int nM, nN, nwg, G, c, tail = 0; static constexpr int ldb = 0;
    __device__ void init(const bf16_t* A_, const bf16_t* Bt_, int M, int N, int G_, int c_) { A = A_; Bt = Bt_; nM = M / BM; nN = N / BM; nwg = nM * nN; G = G_; c = c_; }
    __device__ bool next(int i, Unit& u) const {
        long L = (long)i * G + c; u.half = 0;
        { const int full = nwg / G, rem = nwg - full * G; const bool halved = PG8_HALF_TAIL && rem > 0 && 2 * rem <= G;
          if (tail) { if (!halved || i > 0 || c >= 2 * rem) return false; L = (long)full * G + (c >> 1); u.half = 1 + (c & 1); }
          else if (halved && i >= full) return false; }
        if (L >= nwg) return false;
        int wgid = (int)L; { const int q = nwg / NXCD, r = nwg % NXCD, xcd = wgid % NXCD, off = wgid / NXCD; wgid = (xcd < r ? xcd * (q + 1) : r * (q + 1) + (xcd - r) * q) + off; }
        const int nig = WGM * nN, gid = wgid / nig, fm = gid * WGM, gsz = (nM - fm) < WGM ? (nM - fm) : WGM;
        u.pm = fm + ((wgid % nig) % gsz); u.pn = (wgid % nig) / gsz; u.e = 0; u.row0 = u.pm * BM; return true;
    }
    __device__ __forceinline__ const char* a_tile(const Unit& u, size_t tstep) const { return (const char*)A + (size_t)u.pm * tstep; }
    __device__ __forceinline__ const char* b_tile(const Unit& u, size_t tstep) const { return (const char*)Bt + (size_t)u.pn * tstep + (u.half == 2 ? tstep / 2 : 0); }
    __device__ __forceinline__ void a_offsets(const Unit&, const int (&)[2], const int (&)[2], int, unsigned (&)[2][2]) const {}
};

__device__ __forceinline__ unsigned cvt_pk_bf16(float lo, float hi) { unsigned r; asm volatile("v_cvt_pk_bf16_f32 %0, %1, %2" : "=v"(r) : "v"(lo), "v"(hi)); return r; }

typedef short s16x4 __attribute__((ext_vector_type(4)));
struct NoSide { static constexpr bool ON = false; __device__ __forceinline__ void load(f32x4 (&)[2][2]) {} template <int N> __device__ __forceinline__ void store(f32x4 (&)[2][2]) {} };
template <class Epi, class Sched, bool ALIGN_EPI, bool GATHER, bool BKN = false, class Side = NoSide, bool HALFN = false, bool MIDHOOK = false>
__device__ __forceinline__ void gemm_phase(PG8_LAS unsigned char* lds, const int K, const Sched& S, const Epi& E, Side* side = nullptr) {
    const int tid = threadIdx.x, wid = __builtin_amdgcn_readfirstlane(tid >> 6), lane = tid & 63, wr = wid >> 2, wc = wid & 3, fr = lane & 15, fq = lane >> 4;
    const int nt = K / BK;
    unsigned voffA[2], voffB[2]; int stR[2], stC[2];
#pragma unroll
    for (int i = 0; i < 2; ++i) { int R, C; stage_rc(tid * 16 + i * 8192, R, C); const int Rb = Epi::PERM ? ((R & ~31) + perm32(R & 31)) : R;
        voffA[i] = (unsigned)(R * K + C) * 2u; voffB[i] = (unsigned)(Rb * K + C) * 2u; stR[i] = R; stC[i] = C;
        if constexpr (BKN) { const int b = tid * 16 + i * 8192, kk = b >> 8, chp = (b & 255) >> 4, ch = chp ^ (((kk & 3) << 2) | ((kk >> 2) & 3)); voffB[i] = (unsigned)(kk * S.ldb + 8 * ch) * 2u; } }
    const size_t kstep = (size_t)(BK * 2);
    const size_t hstep = (size_t)HALF * K * 2;
    const size_t tstep = 2 * hstep;
    const size_t kstepB = BKN ? (size_t)BK * S.ldb * 2 : kstep, hstepB = BKN ? (size_t)(HALF * 2) : hstep;
    const unsigned ldsw = (unsigned)wid * 1024u;
    const int aoff = lds_byte(wr * 64 + fr, fq * 8), boff = lds_byte(wc * 32 + fr, fq * 8);
    unsigned tb[2][2] = {{0u, 0u}, {0u, 0u}};
    if constexpr (BKN) { const int q = fr >> 2, p = lane & 3;
#pragma unroll
        for (int n = 0; n < 2; ++n)
#pragma unroll
            for (int t = 0; t < 2; ++t) { const int row = 8 * fq + 4 * t + q, ch = 2 * (2 * wc + n) + (p >> 1);
                tb[n][t] = (unsigned)(uintptr_t)lds + 4u * HTB + (unsigned)(256 * row + 16 * (ch ^ (((row & 3) << 2) | ((row >> 2) & 3))) + 8 * (p & 1)); } }
#define PG8_SA(b, h) (((b) * 2 + (h)) * HTB)
#define PG8_SB(b, h) ((4 + (b) * 2 + (h)) * HTB)
#define PG8_STAGE(bufoff, gbase, voff) do { _Pragma("unroll") for (int _i = 0; _i < 2; ++_i) \
        __builtin_amdgcn_global_load_lds((const unsigned*)((const char*)(gbase) + (voff)[_i]), (PG8_LAS unsigned*)(lds + (bufoff) + ldsw + _i * 8192), 16, 0, 0); } while (0)
#define PG8_STAGE_A(bufoff, gbase, h, VO) do { if constexpr (GATHER) { PG8_STAGE(bufoff, gbase, VO[h]); } else { PG8_STAGE(bufoff, (gbase) + (h) * hstep, voffA); } } while (0)
#define PG8_LDA(dst, b, h) do { _Pragma("unroll") for (int m = 0; m < 4; ++m) _Pragma("unroll") for (int k = 0; k < 2; ++k) dst[m][k] = *(const PG8_LAS bf16x8*)(lds + PG8_SA(b, h) + aoff + m * 2048 + k * 1024); } while (0)
#define PG8_TR(dst, vb, off) asm volatile("ds_read_b64_tr_b16 %0, %1 offset:%c2" : "=&v"(dst) : "v"(vb), "i"(off) : "memory")
#define PG8_LDB(dst, b, h) do { if constexpr (BKN) { _Pragma("unroll") for (int n = 0; n < 2; ++n) _Pragma("unroll") for (int k = 0; k < 2; ++k) { s16x4 _lo, _hi; \
            PG8_TR(_lo, tb[n][0], ((b) * 2 + (h)) * HTB + k * 8192); PG8_TR(_hi, tb[n][1], ((b) * 2 + (h)) * HTB + k * 8192); dst##L[n][k] = _lo; dst##H[n][k] = _hi; } } \
        else { _Pragma("unroll") for (int n = 0; n < 2; ++n) _Pragma("unroll") for (int k = 0; k < 2; ++k) dst[n][k] = *(const PG8_LAS bf16x8*)(lds + PG8_SB(b, h) + boff + n * 2048 + k * 1024); } } while (0)
#define PG8_BF(Bt, n, k) (BKN ? (bf16x8){Bt##L[n][k][0], Bt##L[n][k][1], Bt##L[n][k][2], Bt##L[n][k][3], Bt##H[n][k][0], Bt##H[n][k][1], Bt##H[n][k][2], Bt##H[n][k][3]} : Bt[n][k])
#define PG8_MMA(ai, bj, At, Bt) do { __builtin_amdgcn_s_setprio(1); _Pragma("unroll") for (int m = 0; m < 4; ++m) _Pragma("unroll") for (int n = 0; n < 2; ++n) _Pragma("unroll") for (int k = 0; k < 2; ++k) \
        acc[ai][bj][m][n] = __builtin_amdgcn_mfma_f32_16x16x32_bf16(PG8_BF(Bt, n, k), At[m][k], acc[ai][bj][m][n], 0, 0, 0); __builtin_amdgcn_s_setprio(0); } while (0)
#define PG8_WAIT_V(n) asm volatile("s_waitcnt vmcnt(" #n ")" ::: "memory")
#define PG8_WAIT_L(n) asm volatile("s_waitcnt lgkmcnt(" #n ")" ::: "memory")
#define PG8_BAR __builtin_amdgcn_s_barrier()
#define PG8_SCHED __builtin_amdgcn_sched_barrier(0)
#define PG8_TRIP(t) do { \
            const bool last = (t == nt - 2); \
            const char* a1 = cA + (size_t)(t + 1) * kstep; \
            const char* a2 = last ? nA : cA + (size_t)(t + 2) * kstep; const char* b2 = last ? nB : cB + (size_t)(t + 2) * kstepB; \
            const char* a3 = a2 + kstep; const char* b3 = b2 + kstepB; \
            unsigned vo2[2][2]; \
_Pragma("unroll") \
            for (int h = 0; h < 2; ++h) \
_Pragma("unroll") \
                for (int i = 0; i < 2; ++i) vo2[h][i] = last ? nxtVO[h][i] : curVO[h][i]; \
            f32x4 sv[2][2]; \
            if constexpr (Side::ON) { side->load(sv); PG8_SCHED; } \
            PG8_LDB(B0, 0, 0); PG8_LDB(B1, 0, 1); PG8_SCHED; PG8_LDA(At, 0, 0); PG8_STAGE_A(PG8_SA(1, 1), a1, 1, curVO); \
            if constexpr (Side::ON) PG8_WAIT_V(14); else PG8_WAIT_V(8); \
            PG8_WAIT_L(0); PG8_BAR; PG8_SCHED; PG8_MMA(0, 0, At, B0); if constexpr (!HALFN) PG8_MMA(0, 1, At, B1); PG8_BAR; PG8_SCHED; \
            PG8_LDA(At, 0, 1); PG8_STAGE(PG8_SB(0, 0), b2, voffB); PG8_STAGE(PG8_SB(0, 1), b2 + hstepB, voffB); PG8_STAGE_A(PG8_SA(0, 0), a2, 0, vo2); \
            if constexpr (Side::ON) PG8_WAIT_V(14); else PG8_WAIT_V(8); \
            PG8_WAIT_L(0); PG8_BAR; PG8_SCHED; PG8_MMA(1, 0, At, B0); if constexpr (!HALFN) PG8_MMA(1, 1, At, B1); PG8_BAR; PG8_SCHED; \
            PG8_LDB(B0, 1, 0); PG8_LDB(B1, 1, 1); PG8_SCHED; PG8_LDA(At, 1, 0); PG8_STAGE_A(PG8_SA(0, 1), a2, 1, vo2); \
            PG8_WAIT_V(8); PG8_WAIT_L(0); PG8_BAR; PG8_SCHED; PG8_MMA(0, 0, At, B0); if constexpr (!HALFN) PG8_MMA(0, 1, At, B1); PG8_BAR; PG8_SCHED; \
            PG8_LDA(At, 1, 1); PG8_STAGE(PG8_SB(1, 0), b3, voffB); PG8_STAGE(PG8_SB(1, 1), b3 + hstepB, voffB); PG8_STAGE_A(PG8_SA(1, 0), a3, 0, vo2); \
            PG8_WAIT_V(8); PG8_WAIT_L(0); PG8_BAR; PG8_SCHED; PG8_MMA(1, 0, At, B0); if constexpr (!HALFN) PG8_MMA(1, 1, At, B1); PG8_BAR; PG8_SCHED; \
            if constexpr (Side::ON) { side->template store<16>(sv); PG8_SCHED; } \
        } while (0)
    Unit cur, nxt; int ui = 0;
    if (!S.next(0, cur)) return;
    f32x4 acc[2][2][4][2];
#pragma unroll
    for (int a = 0; a < 2; ++a)
#pragma unroll
        for (int b = 0; b < 2; ++b)
#pragma unroll
            for (int m = 0; m < 4; ++m)
#pragma unroll
                for (int n = 0; n < 2; ++n) acc[a][b][m][n] = (f32x4){0.f, 0.f, 0.f, 0.f};
    bf16x8 At[4][2], B0[2][2], B1[2][2]; s16x4 B0L[2][2], B0H[2][2], B1L[2][2], B1H[2][2];
    unsigned curVO[2][2] = {{0u, 0u}, {0u, 0u}}, nxtVO[2][2] = {{0u, 0u}, {0u, 0u}};
    const char* cA = S.a_tile(cur, tstep); const char* cB = S.b_tile(cur, tstep);
    if constexpr (GATHER) S.a_offsets(cur, stR, stC, K, curVO);
    PG8_STAGE(PG8_SB(0, 0), cB, voffB); PG8_STAGE(PG8_SB(0, 1), cB + hstepB, voffB); PG8_STAGE_A(PG8_SA(0, 0), cA, 0, curVO); PG8_STAGE_A(PG8_SA(0, 1), cA, 1, curVO);
    if (wr == 1) PG8_BAR;
    PG8_WAIT_V(2); PG8_BAR;
    PG8_STAGE(PG8_SB(1, 0), cB + kstepB, voffB); PG8_STAGE_A(PG8_SA(1, 0), cA + kstep, 0, curVO); PG8_STAGE(PG8_SB(1, 1), cB + hstepB + kstepB, voffB);
    PG8_WAIT_V(6); PG8_BAR;
    for (;;) {
        const bool has_next = S.next(ui + 1, nxt);
        const char* nA = has_next ? S.a_tile(nxt, tstep) : cA; const char* nB = has_next ? S.b_tile(nxt, tstep) : cB;
        if constexpr (GATHER) { if (has_next) S.a_offsets(nxt, stR, stC, K, nxtVO); else {
#pragma unroll
            for (int h = 0; h < 2; ++h)
#pragma unroll
                for (int i = 0; i < 2; ++i) nxtVO[h][i] = curVO[h][i]; } }
        if constexpr (MIDHOOK) {
            for (int t = 0; t < Epi::MID_T; t += 2) PG8_TRIP(t);
            E.mid(acc, cur, wr, wc, fr, fq); PG8_SCHED;
            for (int t = Epi::MID_T; t < nt; t += 2) PG8_TRIP(t);
        } else { for (int t = 0; t < nt; t += 2) PG8_TRIP(t); }
        if constexpr (ALIGN_EPI) { if (wr == 0) PG8_BAR; }
        E(acc, cur, wr, wc, fr, fq);
        if (!has_next) break;
#pragma unroll
        for (int a = 0; a < 2; ++a)
#pragma unroll
            for (int b = 0; b < 2; ++b)
#pragma unroll
                for (int m = 0; m < 4; ++m)
#pragma unroll
                    for (int n = 0; n < 2; ++n) acc[a][b][m][n] = (f32x4){0.f, 0.f, 0.f, 0.f};
        cur = nxt; cA = nA; cB = nB; ++ui;
        if constexpr (GATHER) {
#pragma unroll
            for (int h = 0; h < 2; ++h)
#pragma unroll
                for (int i = 0; i < 2; ++i) curVO[h][i] = nxtVO[h][i]; }
        if constexpr (ALIGN_EPI) { if (wr == 1) PG8_BAR; }
    }
    PG8_WAIT_V(0);
    if constexpr (!ALIGN_EPI) { if (wr == 0) PG8_BAR; }
    PG8_BAR;
#undef PG8_TRIP
#undef PG8_SA
#undef PG8_SB
#undef PG8_STAGE
#undef PG8_STAGE_A
#undef PG8_LDA
#undef PG8_LDB
#undef PG8_TR
#undef PG8_BF
#undef PG8_MMA
#undef PG8_WAIT_V
#undef PG8_WAIT_L
#undef PG8_BAR
#undef PG8_SCHED
}
}
using pg8::Unit; using pg8::u32x4; using pg8::cvt_pk_bf16;
struct EpiBf16 {
    static constexpr bool PERM = true; bf16* O; int ldc;
    __device__ __forceinline__ void operator()(const f32x4 (&acc)[2][2][4][2], const Unit& u, int wr, int wc, int fr, int fq) const {
        const int row0 = u.row0 + wr * 64 + fr, col0 = u.pn * 256 + wc * 32 + 8 * fq;
#pragma unroll
        for (int ai = 0; ai < 2; ++ai)
#pragma unroll
            for (int m = 0; m < 4; ++m) { bf16* rowp = O + (size_t)(row0 + ai * 128 + m * 16) * ldc + col0;
#pragma unroll
                for (int bj = 0; bj < 2; ++bj) { const f32x4 v0 = acc[ai][bj][m][0], v1 = acc[ai][bj][m][1];
                    u32x4 w; w.x = cvt_pk_bf16(v0[0], v0[1]); w.y = cvt_pk_bf16(v0[2], v0[3]); w.z = cvt_pk_bf16(v1[0], v1[1]); w.w = cvt_pk_bf16(v1[2], v1[3]);
                    *(u32x4*)(rowp + bj * 128) = w; } }
    }
};

__device__ __forceinline__ void unpack8(const v4u w, float (&f)[8]) { f[0] = bflo(w.x); f[1] = bfhi(w.x); f[2] = bflo(w.y); f[3] = bfhi(w.y); f[4] = bflo(w.z); f[5] = bfhi(w.z); f[6] = bflo(w.w); f[7] = bfhi(w.w); }
struct EpiBf16H {
    static constexpr bool PERM = true; bf16* O; int ldc;
    __device__ __forceinline__ void operator()(const f32x4 (&acc)[2][2][4][2], const Unit& u, int wr, int wc, int fr, int fq) const {
        const int row0 = u.row0 + wr * 64 + fr, col0 = u.pn * 256 + (u.half == 2 ? 128 : 0) + wc * 32 + 8 * fq;
#pragma unroll
        for (int ai = 0; ai < 2; ++ai)
#pragma unroll
            for (int m = 0; m < 4; ++m) { const f32x4 v0 = acc[ai][0][m][0], v1 = acc[ai][0][m][1];
                u32x4 w; w.x = cvt_pk_bf16(v0[0], v0[1]); w.y = cvt_pk_bf16(v0[2], v0[3]); w.z = cvt_pk_bf16(v1[0], v1[1]); w.w = cvt_pk_bf16(v1[2], v1[3]);
                *(u32x4*)(O + (size_t)(row0 + ai * 128 + m * 16) * ldc + col0) = w; }
    }
};

struct EpiT1 {
    static constexpr bool PERM = true; const bf16* U; bf16* T1;
    __device__ __forceinline__ void operator()(const f32x4 (&acc)[2][2][4][2], const Unit& u, int wr, int wc, int fr, int fq) const {
        const int row0 = u.row0 + wr * 64 + fr, col0 = u.pn * 256 + wc * 32 + 8 * fq;
#pragma unroll
        for (int ai = 0; ai < 2; ++ai)
#pragma unroll
            for (int m = 0; m < 4; ++m) { const size_t r = (size_t)(row0 + ai * 128 + m * 16);
#pragma unroll
                for (int bj = 0; bj < 2; ++bj) { const int c = col0 + bj * 128; float ga[8]; unpack8(*(const v4u*)(U + r * INC + OFF_GA + c), ga);
                    const f32x4 v0 = acc[ai][bj][m][0], v1 = acc[ai][bj][m][1];
                    u32x4 w; w.x = cvt_pk_bf16(sigm_f(ga[0]) * v0[0], sigm_f(ga[1]) * v0[1]); w.y = cvt_pk_bf16(sigm_f(ga[2]) * v0[2], sigm_f(ga[3]) * v0[3]);
                    w.z = cvt_pk_bf16(sigm_f(ga[4]) * v1[0], sigm_f(ga[5]) * v1[1]); w.w = cvt_pk_bf16(sigm_f(ga[6]) * v1[2], sigm_f(ga[7]) * v1[3]);
                    *(u32x4*)(T1 + r * D + c) = w; } }
    }
};
struct EpiMG {
    static constexpr bool PERM = true; const bf16* U; const bf16* T1; bf16* MG;
    __device__ __forceinline__ void operator()(const f32x4 (&acc)[2][2][4][2], const Unit& u, int wr, int wc, int fr, int fq) const {
        const int row0 = u.row0 + wr * 64 + fr, col0 = u.pn * 256 + wc * 32 + 8 * fq;
#pragma unroll
        for (int ai = 0; ai < 2; ++ai)
#pragma unroll
            for (int m = 0; m < 4; ++m) { const size_t r = (size_t)(row0 + ai * 128 + m * 16);
#pragma unroll
                for (int bj = 0; bj < 2; ++bj) { const int c = col0 + bj * 128; float gb[8], t1[8]; unpack8(*(const v4u*)(U + r * INC + OFF_GB + c), gb); unpack8(*(const v4u*)(T1 + r * D + c), t1);
                    const f32x4 v0 = acc[ai][bj][m][0], v1 = acc[ai][bj][m][1];
                    u32x4 w; w.x = cvt_pk_bf16(t1[0] + sigm_f(gb[0]) * v0[0], t1[1] + sigm_f(gb[1]) * v0[1]); w.y = cvt_pk_bf16(t1[2] + sigm_f(gb[2]) * v0[2], t1[3] + sigm_f(gb[3]) * v0[3]);
                    w.z = cvt_pk_bf16(t1[4] + sigm_f(gb[4]) * v1[0], t1[5] + sigm_f(gb[5]) * v1[1]); w.w = cvt_pk_bf16(t1[6] + sigm_f(gb[6]) * v1[2], t1[7] + sigm_f(gb[7]) * v1[3]);
                    *(u32x4*)(MG + r * D + c) = w; } }
    }
};
struct EpiMG2 {
    static constexpr bool PERM = true; static constexpr int MID_T = CONV_CH / 64; const bf16* U; bf16* MG;
    __device__ __forceinline__ void mid(f32x4 (&acc)[2][2][4][2], const Unit& u, int wr, int wc, int fr, int fq) const {
        const unsigned vb0 = (unsigned)(((size_t)(u.row0 + wr * 64 + fr) * INC + (size_t)(u.pn * 256 + wc * 32 + 8 * fq)) * 2);
#pragma unroll
        for (int ai = 0; ai < 2; ++ai)
#pragma unroll
            for (int mp = 0; mp < 2; ++mp) {
                v4u va[2][2], vb[2][2];
#pragma unroll
                for (int mm = 0; mm < 2; ++mm)
#pragma unroll
                    for (int bj = 0; bj < 2; ++bj) { const unsigned off = vb0 + (unsigned)((((ai * 128 + (mp * 2 + mm) * 16) * INC) + bj * 128) * 2);
                        asm volatile("global_load_dwordx4 %0, %1, %2" : "=&v"(va[mm][bj]) : "v"(off + (unsigned)(OFF_GA * 2)), "s"(U) : "memory");
                        asm volatile("global_load_dwordx4 %0, %1, %2" : "=&v"(vb[mm][bj]) : "v"(off + (unsigned)(OFF_GB * 2)), "s"(U) : "memory"); }
                asm volatile("s_waitcnt vmcnt(0)" : "+v"(va[0][0]), "+v"(va[0][1]), "+v"(va[1][0]), "+v"(va[1][1]), "+v"(vb[0][0]), "+v"(vb[0][1]), "+v"(vb[1][0]), "+v"(vb[1][1]) :: "memory");
#pragma unroll
                for (int mm = 0; mm < 2; ++mm)
#pragma unroll
                    for (int bj = 0; bj < 2; ++bj) { const int m = mp * 2 + mm;
                        const unsigned wa[4] = {va[mm][bj].x, va[mm][bj].y, va[mm][bj].z, va[mm][bj].w}, wb[4] = {vb[mm][bj].x, vb[mm][bj].y, vb[mm][bj].z, vb[mm][bj].w};
#pragma unroll
                        for (int i = 0; i < 2; ++i) {
                            acc[ai][bj][m][0][2 * i] *= (1.f + __expf(-bflo(wb[i]))) * __builtin_amdgcn_rcpf(1.f + __expf(-bflo(wa[i])));
                            acc[ai][bj][m][0][2 * i + 1] *= (1.f + __expf(-bfhi(wb[i]))) * __builtin_amdgcn_rcpf(1.f + __expf(-bfhi(wa[i])));
                            acc[ai][bj][m][1][2 * i] *= (1.f + __expf(-bflo(wb[2 + i]))) * __builtin_amdgcn_rcpf(1.f + __expf(-bflo(wa[2 + i])));
                            acc[ai][bj][m][1][2 * i + 1] *= (1.f + __expf(-bfhi(wb[2 + i]))) * __builtin_amdgcn_rcpf(1.f + __expf(-bfhi(wa[2 + i]))); }
                        asm volatile("" : "+v"(acc[ai][bj][m][0]), "+v"(acc[ai][bj][m][1]) :: "memory"); }
                __builtin_amdgcn_sched_barrier(0); }
    }
    __device__ __forceinline__ void operator()(const f32x4 (&acc)[2][2][4][2], const Unit& u, int wr, int wc, int fr, int fq) const {
        const int row0 = u.row0 + wr * 64 + fr, col0 = u.pn * 256 + wc * 32 + 8 * fq;
        v4u gt[2][4][2];
#pragma unroll
        for (int ai = 0; ai < 2; ++ai)
#pragma unroll
            for (int m = 0; m < 4; ++m)
#pragma unroll
                for (int bj = 0; bj < 2; ++bj) gt[ai][m][bj] = *(const v4u*)(U + (size_t)(row0 + ai * 128 + m * 16) * INC + OFF_GB + col0 + bj * 128);
#pragma unroll
        for (int ai = 0; ai < 2; ++ai)
#pragma unroll
            for (int m = 0; m < 4; ++m) { const size_t r = (size_t)(row0 + ai * 128 + m * 16);
#pragma unroll
                for (int bj = 0; bj < 2; ++bj) { const int c = col0 + bj * 128; float gb[8]; unpack8(gt[ai][m][bj], gb);
                    const f32x4 v0 = acc[ai][bj][m][0], v1 = acc[ai][bj][m][1];
                    u32x4 w; w.x = cvt_pk_bf16(sigm_f(gb[0]) * v0[0], sigm_f(gb[1]) * v0[1]); w.y = cvt_pk_bf16(sigm_f(gb[2]) * v0[2], sigm_f(gb[3]) * v0[3]);
                    w.z = cvt_pk_bf16(sigm_f(gb[4]) * v1[0], sigm_f(gb[5]) * v1[1]); w.w = cvt_pk_bf16(sigm_f(gb[6]) * v1[2], sigm_f(gb[7]) * v1[3]);
                    *(u32x4*)(MG + r * D + c) = w; } }
    }
};

struct EpiX1 {
    static constexpr bool PERM = true; const float* X; const float* MOD; float* X1;
    __device__ __forceinline__ void operator()(const f32x4 (&acc)[2][2][4][2], const Unit& u, int wr, int wc, int fr, int fq) const {
        const int row0 = u.row0 + wr * 64 + fr, col0 = u.pn * 256 + wc * 32 + 8 * fq; const int b = u.row0 / SEQ;
        f32x4 gv[2][2];
#pragma unroll
        for (int bj = 0; bj < 2; ++bj)
#pragma unroll
            for (int n = 0; n < 2; ++n) gv[bj][n] = *(const f32x4*)(MOD + (size_t)b * MODC + 2 * D + col0 + bj * 128 + 4 * n);
#pragma unroll
        for (int ai = 0; ai < 2; ++ai) {
            f32x4 xv[4][2][2];
#pragma unroll
            for (int m = 0; m < 4; ++m)
#pragma unroll
                for (int bj = 0; bj < 2; ++bj)
#pragma unroll
                    for (int n = 0; n < 2; ++n) xv[m][bj][n] = *(const f32x4*)(X + (size_t)(row0 + ai * 128 + m * 16) * D + col0 + bj * 128 + 4 * n);
#pragma unroll
            for (int m = 0; m < 4; ++m)
#pragma unroll
                for (int bj = 0; bj < 2; ++bj)
#pragma unroll
                    for (int n = 0; n < 2; ++n) *(f32x4*)(X1 + (size_t)(row0 + ai * 128 + m * 16) * D + col0 + bj * 128 + 4 * n) = xv[m][bj][n] + gv[bj][n] * acc[ai][bj][m][n]; }
    }
};

struct Args { const float* in[19]; float* out; unsigned char* ws; int ph_lo, ph_hi; };
enum { I_X = 0, I_C, I_WADA, I_BADA, I_N1G, I_WIN, I_CONVW, I_WCO, I_WRO, I_WO, I_N2G, I_WRG, I_BRG, I_WRE, I_BRE, I_WG, I_WU, I_WD, I_NFG };

constexpr int I_WIN_N_ = (D / 64) * (INC / 32), I_WCO_N_ = (CONV_CH / 64) * (D / 32), I_WRO_N_ = (RV / 64) * (D / 32), I_WO_N_ = (D / 64) * (D / 32), I_TR_ALL = I_WIN_N_ + I_WCO_N_ + I_WRO_N_ + I_WO_N_;
__device__ __forceinline__ void transpose_item(const float* W, int ldw, int k0, int n0, bf16* dst, int ldk, LAS float* scr, int lane) {
#pragma unroll 8
    for (int i = 0; i < 32; ++i) { const int kk = 2 * i + (lane >> 5); scr[kk * 33 + (lane & 31)] = W[(size_t)(k0 + kk) * ldw + n0 + (lane & 31)]; }
    LDS_WAIT(); asm volatile("" ::: "memory");
    const int c = lane & 7;
#pragma unroll
    for (int j = 0; j < 4; ++j) { const int n = (lane >> 3) + 8 * j; const LAS float* s = scr + (8 * c) * 33 + n;
        v4u o; o.x = pk2(s[0 * 33], s[1 * 33]); o.y = pk2(s[2 * 33], s[3 * 33]); o.z = pk2(s[4 * 33], s[5 * 33]); o.w = pk2(s[6 * 33], s[7 * 33]);
        *(GAS v4u*)(dst + (size_t)n * ldk + 8 * c) = o; }
    LDS_WAIT(); asm volatile("" ::: "memory");
}
__device__ __forceinline__ void transpose_load(const float* W, int ldw, int k0, int n0, int lane, float (&v)[32]) {
#pragma unroll
    for (int i = 0; i < 32; ++i) { const int kk = 2 * i + (lane >> 5); v[i] = W[(size_t)(k0 + kk) * ldw + n0 + (lane & 31)]; }
}
__device__ __forceinline__ void transpose_finish(const float (&v)[32], bf16* dst, int ldk, LAS float* scr, int lane) {
#pragma unroll
    for (int i = 0; i < 32; ++i) { const int kk = 2 * i + (lane >> 5); scr[kk * 33 + (lane & 31)] = v[i]; }
    LDS_WAIT(); asm volatile("" ::: "memory");
    const int c = lane & 7;
#pragma unroll
    for (int j = 0; j < 4; ++j) { const int n = (lane >> 3) + 8 * j; const LAS float* s = scr + (8 * c) * 33 + n;
        v4u o; o.x = pk2(s[0 * 33], s[1 * 33]); o.y = pk2(s[2 * 33], s[3 * 33]); o.z = pk2(s[4 * 33], s[5 * 33]); o.w = pk2(s[6 * 33], s[7 * 33]);
        *(GAS v4u*)(dst + (size_t)n * ldk + 8 * c) = o; }
    LDS_WAIT(); asm volatile("" ::: "memory");
}
struct TrItem { const float* W; int ldw, k0, n0; bf16* dst; int ldk; };
__device__ __forceinline__ TrItem tr_item(const Args& a, int r) {
    unsigned char* ws = a.ws; TrItem t;
    if (r < I_WIN_N_) { const int nblk = INC / 32, kb = r / nblk, nb = r % nblk; t = TrItem{a.in[I_WIN], INC, 64 * kb, 32 * nb, (bf16*)(ws + WS_WIN) + (size_t)(32 * nb) * D + 64 * kb, D}; return t; } r -= I_WIN_N_;
    if (r < I_WCO_N_) { const int nblk = D / 32, kb = r / nblk, nb = r % nblk; t = TrItem{a.in[I_WCO], D, 64 * kb, 32 * nb, (bf16*)(ws + WS_W4) + (size_t)(32 * nb) * K4 + 64 * kb, K4}; return t; } r -= I_WCO_N_;
    if (r < I_WRO_N_) { const int nblk = D / 32, kb = r / nblk, nb = r % nblk; t = TrItem{a.in[I_WRO], D, 64 * kb, 32 * nb, (bf16*)(ws + WS_W4) + (size_t)(32 * nb) * K4 + CONV_CH + 64 * kb, K4}; return t; } r -= I_WRO_N_;
    { const int nblk = D / 32, kb = r / nblk, nb = r % nblk; t = TrItem{a.in[I_WO], D, 64 * kb, 32 * nb, (bf16*)(ws + WS_WO) + (size_t)(32 * nb) * D + 64 * kb, D}; return t; }
}
typedef float f32x2 __attribute__((ext_vector_type(2)));
constexpr int I_WIN64 = (D / 64) * (INC / 64);
__device__ __forceinline__ void tr64_load(const float* W, int r, int lane, f32x2 (&v)[32]) {
    const int nblk = INC / 64, kb = r / nblk, nb = r % nblk; const float* src = W + (size_t)(64 * kb) * INC + 64 * nb + 2 * (lane & 31);
#pragma unroll
    for (int i = 0; i < 32; ++i) v[i] = *(const f32x2*)(src + (size_t)(2 * i + (lane >> 5)) * INC);
}
__device__ __forceinline__ void tr64_finish(const f32x2 (&v)[32], bf16* WT, int r, LAS float* scr, int lane) {
    const int nblk = INC / 64, kb = r / nblk, nb = r % nblk;
#pragma unroll
    for (int i = 0; i < 32; ++i) { const int kk = 2 * i + (lane >> 5); scr[kk * 65 + 2 * (lane & 31)] = v[i].x; scr[kk * 65 + 2 * (lane & 31) + 1] = v[i].y; }
    LDS_WAIT(); asm volatile("" ::: "memory");
    const int c = lane & 7; bf16* dst = WT + (size_t)(64 * nb) * D + 64 * kb;
#pragma unroll
    for (int j = 0; j < 8; ++j) { const int n = (lane >> 3) + 8 * j; const LAS float* s = scr + (8 * c) * 65 + n;
        v4u o; o.x = pk2(s[0 * 65], s[1 * 65]); o.y = pk2(s[2 * 65], s[3 * 65]); o.z = pk2(s[4 * 65], s[5 * 65]); o.w = pk2(s[6 * 65], s[7 * 65]);
        *(GAS v4u*)(dst + (size_t)n * D + 8 * c) = o; }
    LDS_WAIT(); asm volatile("" ::: "memory");
}
constexpr int I_WIN128 = (D / 128) * (INC / 32);
__device__ __forceinline__ void tr128_load(const float* W, int r, int lane, float (&v)[64]) {
    const int nblk = INC / 32, kb = r / nblk, nb = r % nblk; const float* src = W + (size_t)(128 * kb) * INC + 32 * nb + (lane & 31);
#pragma unroll
    for (int i = 0; i < 64; ++i) v[i] = src[(size_t)(2 * i + (lane >> 5)) * INC];
}
__device__ __forceinline__ void tr128_finish(const float (&v)[64], bf16* WT, int r, LAS float* scr, int lane) {
    const int nblk = INC / 32, kb = r / nblk, nb = r % nblk;
#pragma unroll
    for (int i = 0; i < 64; ++i) { const int kk = 2 * i + (lane >> 5); scr[kk * 33 + (lane & 31)] = v[i]; }
    LDS_WAIT(); asm volatile("" ::: "memory");
    const int c = lane & 15; bf16* dst = WT + (size_t)(32 * nb) * D + 128 * kb;
#pragma unroll
    for (int j = 0; j < 8; ++j) { const int n = (lane >> 4) + 4 * j; const LAS float* s = scr + (8 * c) * 33 + n;
        v4u o; o.x = pk2(s[0 * 33], s[1 * 33]); o.y = pk2(s[2 * 33], s[3 * 33]); o.z = pk2(s[4 * 33], s[5 * 33]); o.w = pk2(s[6 * 33], s[7 * 33]);
        *(GAS v4u*)(dst + (size_t)n * D + 8 * c) = o; }
    LDS_WAIT(); asm volatile("" ::: "memory");
}
__device__ __forceinline__ void tr_range(const Args& a, LAS float* scr, int lane, int r0, int stride, int r_end) {
    int r = r0; float v[32]; TrItem cur{}; if (r < r_end) { cur = tr_item(a, r); transpose_load(cur.W, cur.ldw, cur.k0, cur.n0, lane, v); }
    while (r < r_end) {
        const int rn = r + stride; float vn[32]; TrItem nx{};
        if (rn < r_end) { nx = tr_item(a, rn); transpose_load(nx.W, nx.ldw, nx.k0, nx.n0, lane, vn); }
        transpose_finish(v, cur.dst, cur.ldk, scr, lane);
        if (rn < r_end) {
#pragma unroll
            for (int i = 0; i < 32; ++i) v[i] = vn[i]; }
        cur = nx; r = rn;
    }
}
constexpr int I_ADA = (MODC / 256) * ADA_KS;
constexpr int I_WIN_N = (D / 64) * (INC / 32), I_WCO_N = (CONV_CH / 64) * (D / 32), I_WRO_N = (RV / 64) * (D / 32), I_WO_N = (D / 64) * (D / 32);
constexpr int I_GU1 = (D / 64) * (DE / 32), I_DN1 = (DE / 64) * (D / 32), I_EXP1 = 2 * I_GU1 + I_DN1;
#ifndef MOE_E
#define MOE_E 0
#endif
#ifndef SIDE_CVT
#define SIDE_CVT 0
#endif
#ifndef LATE_W4
#define LATE_W4 0
#endif
constexpr int P0_ITEMS = I_ADA + I_WIN_N + (LATE_W4 ? 0 : I_WCO_N + I_WRO_N + I_WO_N);

__device__ __forceinline__ void p0_prologue(const Args& a, LAS unsigned char* lds, int tid, int lane, int wave, int vcu, int G, bool cvt_experts, unsigned long long* ts_items = nullptr) {
    unsigned char* ws = a.ws;
    LAS float* sc = (LAS float*)(lds + 98304);
    for (int i = tid; i < 4 * D; i += 512) sc[i] = silu_f(a.in[I_C][i]);
    __syncthreads();
    LAS float* scr = (LAS float*)(lds + wave * 12288);
    const int gw = vcu * NWAVES + wave, NGW = G * NWAVES;
#if P0_V2 && !LATE_W4
    const bool ada_wave = wave < 3; const int aw = vcu * 3 + wave, NAW = G * 3;
    if (ada_wave) for (int r = aw; r < I_ADA; r += NAW) {
        const int cc = r % (MODC / 256), ks = r / (MODC / 256);
        const float* wp = a.in[I_WADA] + (size_t)(ks * 128) * MODC + cc * 256 + lane * 4;
        f32x4 a0 = {0.f, 0.f, 0.f, 0.f}, a1 = a0, a2 = a0, a3 = a0;
#pragma unroll 1
        for (int k0 = 0; k0 < 128; k0 += 32) { f32x4 w[32];
#pragma unroll
            for (int k = 0; k < 32; ++k) w[k] = *(const f32x4*)(wp + (size_t)(k0 + k) * MODC);
            __builtin_amdgcn_sched_barrier(0);
#pragma unroll
            for (int k = 0; k < 32; ++k) { const int kk = ks * 128 + k0 + k; a0 += sc[kk] * w[k]; a1 += sc[D + kk] * w[k]; a2 += sc[2 * D + kk] * w[k]; a3 += sc[3 * D + kk] * w[k]; } }
        float* pp = (float*)(ws + WS_MODP) + (size_t)(ks * 4) * MODC + cc * 256 + lane * 4;
        *(f32x4*)(pp) = a0; *(f32x4*)(pp + MODC) = a1; *(f32x4*)(pp + 2 * MODC) = a2; *(f32x4*)(pp + 3 * MODC) = a3;
    }
    if (ts_items) ts_items[1] = __builtin_amdgcn_s_memrealtime();
#if TAIL_W4 && P0_T64
    if (!ada_wave) {
        LAS float* sc64 = (LAS float*)(lds + (wave - 3) * 16896);
        const int nw = vcu * 5 + (wave - 3), NNW = G * 5;
#if P0_T64 == 2
        { int r = nw; float v[64]; if (r < I_WIN128) tr128_load(a.in[I_WIN], r, lane, v);
          while (r < I_WIN128) {
            const int rn = r + NNW; float vn[64];
            if (rn < I_WIN128) tr128_load(a.in[I_WIN], rn, lane, vn);
            tr128_finish(v, (bf16*)(ws + WS_WIN), r, sc64, lane);
            if (rn < I_WIN128) {
#pragma unroll
                for (int i = 0; i < 64; ++i) v[i] = vn[i]; }
            r = rn;
          } }
        if (false) {
#else
        {
#endif
        int r = nw; f32x2 v[32]; if (r < I_WIN64) tr64_load(a.in[I_WIN], r, lane, v);
        while (r < I_WIN64) {
            const int rn = r + NNW; f32x2 vn[32];
            if (rn < I_WIN64) tr64_load(a.in[I_WIN], rn, lane, vn);
            tr64_finish(v, (bf16*)(ws + WS_WIN), r, sc64, lane);
            if (rn < I_WIN64) {
#pragma unroll
                for (int i = 0; i < 32; ++i) v[i] = vn[i]; }
            r = rn;
        } } }
#else
    {
      const int nw = vcu * 5 + (wave - 3), NNW = G * 5;
      int round = 0; int r = gw;
      constexpr int I_TR_P0 = TAIL_W4 ? I_WIN_N_ : I_TR_ALL;
      constexpr int NSR = TAIL_W4 ? 1 : 2;
      auto next_item = [&](int rd) -> int { if (rd < NSR) return rd * NGW + gw; if (ada_wave) return I_TR_ALL; return NSR * NGW + (rd - NSR) * NNW + nw; };
      r = next_item(0);
      float v[32]; TrItem cur{}; if (r < I_TR_P0) { cur = tr_item(a, r); transpose_load(cur.W, cur.ldw, cur.k0, cur.n0, lane, v); }
      while (r < I_TR_P0) {
          ++round; const int rn = next_item(round);
          float vn[32]; TrItem nx{};
          if (rn < I_TR_P0) { nx = tr_item(a, rn); transpose_load(nx.W, nx.ldw, nx.k0, nx.n0, lane, vn); }
          transpose_finish(v, cur.dst, cur.ldk, scr, lane);
          if (rn < I_TR_P0) {
#pragma unroll
              for (int i = 0; i < 32; ++i) v[i] = vn[i]; }
          cur = nx; r = rn;
      } }
#endif
#else
    for (int it = gw; it < P0_ITEMS; it += NGW) {
        int r = it;
        if (r < I_ADA) {
            const int cc = r % (MODC / 256), ks = r / (MODC / 256);
            const float* wp = a.in[I_WADA] + (size_t)(ks * 128) * MODC + cc * 256 + lane * 4;
            f32x4 a0 = {0.f, 0.f, 0.f, 0.f}, a1 = a0, a2 = a0, a3 = a0;
#pragma unroll 8
            for (int k = 0; k < 128; ++k) { const f32x4 w = *(const f32x4*)(wp + (size_t)k * MODC); const int kk = ks * 128 + k;
                a0 += sc[kk] * w; a1 += sc[D + kk] * w; a2 += sc[2 * D + kk] * w; a3 += sc[3 * D + kk] * w; }
            float* pp = (float*)(ws + WS_MODP) + (size_t)(ks * 4) * MODC + cc * 256 + lane * 4;
            *(f32x4*)(pp) = a0; *(f32x4*)(pp + MODC) = a1; *(f32x4*)(pp + 2 * MODC) = a2; *(f32x4*)(pp + 3 * MODC) = a3;
            continue;
        }
        r -= I_ADA;
        if (r < I_WIN_N) { const int nblk = INC / 32, kb = r / nblk, nb = r % nblk; transpose_item(a.in[I_WIN], INC, 64 * kb, 32 * nb, (bf16*)(ws + WS_WIN) + (size_t)(32 * nb) * D + 64 * kb, D, scr, lane); continue; } r -= I_WIN_N;
#if !LATE_W4
        if (r < I_WCO_N) { const int nblk = D / 32, kb = r / nblk, nb = r % nblk; transpose_item(a.in[I_WCO], D, 64 * kb, 32 * nb, (bf16*)(ws + WS_W4) + (size_t)(32 * nb) * K4 + 64 * kb, K4, scr, lane); continue; } r -= I_WCO_N;
        if (r < I_WRO_N) { const int nblk = D / 32, kb = r / nblk, nb = r % nblk; transpose_item(a.in[I_WRO], D, 64 * kb, 32 * nb, (bf16*)(ws + WS_W4) + (size_t)(32 * nb) * K4 + CONV_CH + 64 * kb, K4, scr, lane); continue; } r -= I_WRO_N;
        { const int nblk = D / 32, kb = r / nblk, nb = r % nblk; transpose_item(a.in[I_WO], D, 64 * kb, 32 * nb, (bf16*)(ws + WS_WO) + (size_t)(32 * nb) * D + 64 * kb, D, scr, lane); }
#endif
    }
#endif
    if (ts_items) ts_items[0] = __builtin_amdgcn_s_memrealtime();
    if (cvt_experts) {
        const size_t NG8 = (size_t)NE * D * DE / 8;
        const size_t gt = (size_t)vcu * 512 + tid, GT = (size_t)G * 512;
        for (size_t it0 = gt; it0 < 3 * NG8; it0 += 4 * GT) {
            f32x4 v0[4], v1[4];
#pragma unroll
            for (int j = 0; j < 4; ++j) { const size_t it = it0 + (size_t)j * GT; if (it < 3 * NG8) { const int which = (int)(it / NG8); const size_t i = (it % NG8) * 8;
                const float* src = a.in[which == 0 ? I_WG : which == 1 ? I_WU : I_WD] + i; v0[j] = __builtin_nontemporal_load((const f32x4*)src); v1[j] = __builtin_nontemporal_load((const f32x4*)(src + 4)); } }
#pragma unroll
            for (int j = 0; j < 4; ++j) { const size_t it = it0 + (size_t)j * GT; if (it < 3 * NG8) { const int which = (int)(it / NG8); const size_t i = (it % NG8) * 8;
                v4u o; o.x = pk2(v0[j].x, v0[j].y); o.y = pk2(v0[j].z, v0[j].w); o.z = pk2(v1[j].x, v1[j].y); o.w = pk2(v1[j].z, v1[j].w);
                if (which == 2) *(v4u*)((bf16*)(ws + WS_WD) + i) = o;
                else { const size_t ek = i / DE; const int n = (int)(i % DE); *(v4u*)((bf16*)(ws + WS_WGU) + ek * (2 * DE) + (n / 128) * 256 + (n % 128) + (which ? 128 : 0)) = o; } } }
        }
    }
    { bf16* wrt = (bf16*)(ws + WS_WRT);
      for (int idx = vcu * 512 + tid; idx < 48 * D; idx += G * 512) { const int o = idx / D, d = idx % D;
          const float w = o < 4 ? a.in[I_WRG][d * 4 + o] : (o < 36 ? a.in[I_WRE][d * 32 + (o - 4)] : 0.f);
          const unsigned hi = f2bf(w); const float r = w - __builtin_bit_cast(float, hi << 16); wrt[idx] = (bf16)hi; wrt[48 * D + idx] = (bf16)f2bf(r); } }
    float* rc = (float*)(ws + WS_ROPE);
    for (int idx = vcu * 512 + tid; idx < SEQ * 64; idx += G * 512) { const int pos = idx >> 6, j = idx & 63;
        const float inv = powf(10000.f, -(float)(2 * j) / 128.f); const float ang = (float)pos * inv; rc[idx] = cosf(ang); rc[SEQ * 64 + idx] = sinf(ang); }
}

__device__ __forceinline__ void late_w4_convert(const Args& a, LAS unsigned char* lds, int lane, int wave, int vcu, int G) {
    unsigned char* ws = a.ws; LAS float* scr = (LAS float*)(lds + wave * 12288);
    const int gw = vcu * NWAVES + wave, NGW = G * NWAVES;
    for (int it = gw; it < I_WCO_N + I_WRO_N + I_WO_N; it += NGW) { int r = it;
        if (r < I_WCO_N) { const int nblk = D / 32, kb = r / nblk, nb = r % nblk; transpose_item(a.in[I_WCO], D, 64 * kb, 32 * nb, (bf16*)(ws + WS_W4) + (size_t)(32 * nb) * K4 + 64 * kb, K4, scr, lane); continue; } r -= I_WCO_N;
        if (r < I_WRO_N) { const int nblk = D / 32, kb = r / nblk, nb = r % nblk; transpose_item(a.in[I_WRO], D, 64 * kb, 32 * nb, (bf16*)(ws + WS_W4) + (size_t)(32 * nb) * K4 + CONV_CH + 64 * kb, K4, scr, lane); continue; } r -= I_WRO_N;
        { const int nblk = D / 32, kb = r / nblk, nb = r % nblk; transpose_item(a.in[I_WO], D, 64 * kb, 32 * nb, (bf16*)(ws + WS_WO) + (size_t)(32 * nb) * D + 64 * kb, D, scr, lane); }
    }
}

__device__ __forceinline__ float mod_value(const Args& a, int b, int j) {
    const float* pp = (const float*)(a.ws + WS_MODP) + (size_t)b * MODC + j; float s = a.in[I_BADA][j];
#pragma unroll
    for (int ks = 0; ks < ADA_KS; ++ks) s += pp[(size_t)ks * 4 * MODC];
    return s;
}
__device__ __forceinline__ void p1_norm(const Args& a, LAS unsigned char* lds, int tid, int lane, int wave, int G) {
    float* MOD = (float*)(a.ws + WS_MOD);
    for (int idx = blockIdx.x * 512 + tid; idx < 4 * MODC; idx += G * 512) MOD[idx] = mod_value(a, idx / MODC, idx % MODC);
    LAS float* tsc = (LAS float*)lds; LAS float* tsh = tsc + D;
    bf16* H = (bf16*)(a.ws + WS_H); const float* g = a.in[I_N1G];
    for (int rb = blockIdx.x; rb < T / 32; rb += G) {
        const int b = (rb * 32) / SEQ;
        __syncthreads();
        {
          const float* pp = (const float*)(a.ws + WS_MODP) + (size_t)b * MODC + tid; float pv[ADA_KS][8], bv[8];
#pragma unroll
          for (int i = 0; i < 8; ++i) bv[i] = a.in[I_BADA][(i >> 2) * D + (i & 3) * 512 + tid];
#pragma unroll
          for (int ks = 0; ks < ADA_KS; ++ks)
#pragma unroll
              for (int i = 0; i < 8; ++i) pv[ks][i] = pp[(size_t)ks * 4 * MODC + (i >> 2) * D + (i & 3) * 512];
          __builtin_amdgcn_sched_barrier(0);
#pragma unroll
          for (int i = 0; i < 8; ++i) { float s = bv[i];
#pragma unroll
              for (int ks = 0; ks < ADA_KS; ++ks) s += pv[ks][i];
              if (i < 4) tsh[(i & 3) * 512 + tid] = s; else tsc[(i & 3) * 512 + tid] = 1.f + s; } }
        __syncthreads();
        f32x4 gg[8], v[8];
#pragma unroll
        for (int j = 0; j < 8; ++j) { gg[j] = *(const f32x4*)(g + 4 * lane + 256 * j); v[j] = ((const GAS f32x4*)(a.in[I_X] + (size_t)(rb * 32 + wave * 4) * D) + lane)[64 * j]; }
#pragma unroll
        for (int rr = 0; rr < 4; ++rr) {
            const int row = rb * 32 + wave * 4 + rr;
            f32x4 vn[8];
            if (rr < 3) {
#pragma unroll
                for (int j = 0; j < 8; ++j) vn[j] = ((const GAS f32x4*)(a.in[I_X] + (size_t)(row + 1) * D) + lane)[64 * j]; }
            float s = 0.f;
#pragma unroll
            for (int j = 0; j < 8; ++j) s += (v[j].x * v[j].x + v[j].y * v[j].y) + (v[j].z * v[j].z + v[j].w * v[j].w);
            const float rstd = rsqrtf(wave_sum(s) * (1.f / D) + EPS);
            GAS v2u* o8 = (GAS v2u*)(H + (size_t)row * D) + lane;
#pragma unroll
            for (int j = 0; j < 8; ++j) { const int d = 4 * lane + 256 * j; const f32x4 cs = *(const LAS f32x4*)(tsc + d), sh = *(const LAS f32x4*)(tsh + d);
                const f32x4 o = v[j] * rstd * gg[j] * cs + sh; v2u w; w.x = pk2(o.x, o.y); w.y = pk2(o.z, o.w); o8[64 * j] = w; }
            if (rr < 3) {
#pragma unroll
                for (int j = 0; j < 8; ++j) v[j] = vn[j]; }
        }
    }
}

typedef short s16x4 __attribute__((ext_vector_type(4)));
constexpr int RS_K = 288, RS_V = 544;
constexpr int KS_OFF = 0, VS_OFF = 128 * RS_K;
#define TR_READ(dst, vb, off) asm volatile("ds_read_b64_tr_b16 %0, %1 offset:%c2" : "=&v"(dst) : "v"(vb), "i"(off) : "memory")
#define SBAR() __builtin_amdgcn_sched_barrier(0)
#define PK8(L, H) (bf16x8){L[0], L[1], L[2], L[3], H[0], H[1], H[2], H[3]}

__device__ __forceinline__ void p3a_unit(const Args& a, LAS unsigned char* lds, int unit, int tid, int lane, int wave) {
    const int n = unit % NCH, bh = unit / NCH, h = bh % RH, b = bh / RH;
    bf16* U = (bf16*)(a.ws + WS_U); const float* rc = (const float*)(a.ws + WS_ROPE);
    const size_t t0 = (size_t)b * SEQ + (size_t)n * CHUNK;
    const float log_g = log1pf(-exp2f(-5.f - (float)h));
    __syncthreads();
    {
        v4u x1[4], x2[4]; f32x4 c0[4], c1[4], s0[4], s1[4]; v4u vv[8];
#pragma unroll
        for (int it = 0; it < 4; ++it) { const int task = tid + 512 * it; const int isk = task >> 10, r_ = (task >> 3) & 127, c8 = task & 7;
            const bf16* p = U + (t0 + r_) * INC + (isk ? OFF_K : OFF_Q) + h * DK + c8 * 8; x1[it] = *(const v4u*)p; x2[it] = *(const v4u*)(p + 64);
            const float* cp = rc + (size_t)(n * CHUNK + r_) * 64 + c8 * 8; const float* sp = cp + SEQ * 64;
            c0[it] = *(const f32x4*)cp; c1[it] = *(const f32x4*)(cp + 4); s0[it] = *(const f32x4*)sp; s1[it] = *(const f32x4*)(sp + 4); }
#pragma unroll
        for (int it = 0; it < 8; ++it) { const int task = tid + 512 * it; const int r_ = task >> 5, c = task & 31; vv[it] = *(const v4u*)(U + (t0 + r_) * INC + OFF_V + h * DV + c * 8); }
#pragma unroll
        for (int it = 0; it < 4; ++it) { const int task = tid + 512 * it; const int isk = task >> 10, r_ = (task >> 3) & 127, c8 = task & 7;
            bf16* p = U + (t0 + r_) * INC + (isk ? OFF_K : OFF_Q) + h * DK + c8 * 8;
            const float cs[8] = {c0[it].x, c0[it].y, c0[it].z, c0[it].w, c1[it].x, c1[it].y, c1[it].z, c1[it].w}, sn[8] = {s0[it].x, s0[it].y, s0[it].z, s0[it].w, s1[it].x, s1[it].y, s1[it].z, s1[it].w};
            const unsigned w1[4] = {x1[it].x, x1[it].y, x1[it].z, x1[it].w}, w2[4] = {x2[it].x, x2[it].y, x2[it].z, x2[it].w};
            const float sc = isk ? 0.08838834764831845f : 1.f;
            const float kd = isk ? __expf(log_g * (float)(127 - r_)) : 0.f;
            float o1[8], o2[8];
#pragma unroll
            for (int i = 0; i < 4; ++i) {
                const float a0 = bflo(w1[i]), a1 = bfhi(w1[i]), b0 = bflo(w2[i]), b1 = bfhi(w2[i]);
                o1[2 * i] = (a0 * cs[2 * i] - b0 * sn[2 * i]) * sc; o1[2 * i + 1] = (a1 * cs[2 * i + 1] - b1 * sn[2 * i + 1]) * sc;
                o2[2 * i] = (a0 * sn[2 * i] + b0 * cs[2 * i]) * sc; o2[2 * i + 1] = (a1 * sn[2 * i + 1] + b1 * cs[2 * i + 1]) * sc;
            }
            v4u y1, y2; y1.x = pk2(o1[0], o1[1]); y1.y = pk2(o1[2], o1[3]); y1.z = pk2(o1[4], o1[5]); y1.w = pk2(o1[6], o1[7]);
            y2.x = pk2(o2[0], o2[1]); y2.y = pk2(o2[2], o2[3]); y2.z = pk2(o2[4], o2[5]); y2.w = pk2(o2[6], o2[7]);
            *(v4u*)p = y1; *(v4u*)(p + 64) = y2;
            if (isk) {
                v4u z1, z2; z1.x = pk2(o1[0] * kd, o1[1] * kd); z1.y = pk2(o1[2] * kd, o1[3] * kd); z1.z = pk2(o1[4] * kd, o1[5] * kd); z1.w = pk2(o1[6] * kd, o1[7] * kd);
                z2.x = pk2(o2[0] * kd, o2[1] * kd); z2.y = pk2(o2[2] * kd, o2[3] * kd); z2.z = pk2(o2[4] * kd, o2[5] * kd); z2.w = pk2(o2[6] * kd, o2[7] * kd);
                *(LAS v4u*)(lds + KS_OFF + r_ * RS_K + c8 * 16) = z1; *(LAS v4u*)(lds + KS_OFF + r_ * RS_K + 128 + c8 * 16) = z2;
            }
        }
#pragma unroll
        for (int it = 0; it < 8; ++it) { const int task = tid + 512 * it; const int r_ = task >> 5, c = task & 31; *(LAS v4u*)(lds + VS_OFF + r_ * RS_V + c * 16) = vv[it]; }
    }
    __syncthreads();
    const int g = lane >> 4, q = (lane & 15) >> 2, p = lane & 3;
    const unsigned aK = (unsigned)(uintptr_t)(lds + KS_OFF) + (unsigned)((8 * g + q) * RS_K + 8 * p);
    const unsigned aV = (unsigned)(uintptr_t)(lds + VS_OFF) + (unsigned)((8 * g + q) * RS_V + 64 * wave + 8 * p);
    f32x4 acc[8][2];
#pragma unroll
    for (int mt = 0; mt < 8; ++mt) { acc[mt][0] = (f32x4){0.f, 0.f, 0.f, 0.f}; acc[mt][1] = (f32x4){0.f, 0.f, 0.f, 0.f}; }
#pragma unroll
    for (int ks = 0; ks < 4; ++ks) {
        s16x4 al[8], ah[8], bl[2], bhh[2];
#pragma unroll
        for (int mt = 0; mt < 8; ++mt) { TR_READ(al[mt], aK, ks * 32 * RS_K + mt * 32); TR_READ(ah[mt], aK, ks * 32 * RS_K + 4 * RS_K + mt * 32); }
#pragma unroll
        for (int nt = 0; nt < 2; ++nt) { TR_READ(bl[nt], aV, ks * 32 * RS_V + nt * 32); TR_READ(bhh[nt], aV, ks * 32 * RS_V + 4 * RS_V + nt * 32); }
        asm volatile("s_waitcnt lgkmcnt(0)" ::: "memory"); SBAR();
#pragma unroll
        for (int mt = 0; mt < 8; ++mt)
#pragma unroll
            for (int nt = 0; nt < 2; ++nt) acc[mt][nt] = __builtin_amdgcn_mfma_f32_16x16x32_bf16(PK8(al[mt], ah[mt]), PK8(bl[nt], bhh[nt]), acc[mt][nt], 0, 0, 0);
    }
    bf16* KVT = (bf16*)(a.ws + WS_KVT) + (size_t)unit * DV * DK;
#pragma unroll
    for (int mt = 0; mt < 8; ++mt)
#pragma unroll
        for (int nt = 0; nt < 2; ++nt) { const int e = 32 * wave + 16 * nt + (lane & 15), d = 16 * mt + 4 * g;
            v2u w; w.x = pk2(acc[mt][nt][0], acc[mt][nt][1]); w.y = pk2(acc[mt][nt][2], acc[mt][nt][3]); *(v2u*)(KVT + (size_t)e * DK + d) = w; }
}

__device__ __forceinline__ void p3b_scan_conv(const Args& a, int tid, int lane, int wave, int vcu, int G) {
    const bf16* KVT = (const bf16*)(a.ws + WS_KVT); bf16* SPT = (bf16*)(a.ws + WS_SPT);
    for (int idx = blockIdx.x * 512 + tid; idx < NB * RH * DV * DK / 8; idx += G * 512) {
        const int bh = idx / (DV * DK / 8), o8 = (idx % (DV * DK / 8)) * 8, h = bh % RH;
        const float cd = __expf(log1pf(-exp2f(-5.f - (float)h)) * 128.f);
        float s[8];
#pragma unroll
        for (int i = 0; i < 8; ++i) s[i] = 0.f;
        v4u kvv[NCH - 1];
#pragma unroll
        for (int n = 1; n < NCH; ++n) kvv[n - 1] = *(const v4u*)(KVT + ((size_t)(bh * NCH + n - 1)) * DV * DK + o8);
#pragma unroll
        for (int n = 1; n < NCH; ++n) {
            const v4u kv = kvv[n - 1];
            const unsigned w[4] = {kv.x, kv.y, kv.z, kv.w};
#pragma unroll
            for (int i = 0; i < 4; ++i) { s[2 * i] = cd * s[2 * i] + bflo(w[i]); s[2 * i + 1] = cd * s[2 * i + 1] + bfhi(w[i]); }
            v4u o; o.x = pk2(s[0], s[1]); o.y = pk2(s[2], s[3]); o.z = pk2(s[4], s[5]); o.w = pk2(s[6], s[7]);
            *(v4u*)(SPT + ((size_t)(bh * NCH + n)) * DV * DK + o8) = o;
        }
    }
    const bf16* U = (const bf16*)(a.ws + WS_U); bf16* AIN = (bf16*)(a.ws + WS_A4); const float* cw = a.in[I_CONVW];
    const int gw = vcu * NWAVES + wave, NGW = G * NWAVES;
    for (int task = gw; task < (T / 8) * 2; task += NGW) {
        const int tb = task >> 1, ch = (task & 1) * 512 + lane * 8, tr0 = tb * 8;
        const bool first = (tr0 % SEQ) == 0;
        v4u hc[2], hx[2], ccv[8], cxv[8], cbv[8]; f32x4 wv[3][2];
#pragma unroll
        for (int k = 0; k < 3; ++k) { wv[k][0] = *(const f32x4*)(cw + k * CONV_CH + ch); wv[k][1] = *(const f32x4*)(cw + k * CONV_CH + ch + 4); }
#pragma unroll
        for (int hh = 0; hh < 2; ++hh) { const size_t row = (size_t)(first ? tr0 : tr0 - 2 + hh) * INC; hc[hh] = *(const v4u*)(U + row + OFF_CC + ch); hx[hh] = *(const v4u*)(U + row + OFF_CX + ch); }
#pragma unroll
        for (int rr = 0; rr < 8; ++rr) { const size_t row = (size_t)(tr0 + rr) * INC; ccv[rr] = *(const v4u*)(U + row + OFF_CC + ch); cxv[rr] = *(const v4u*)(U + row + OFF_CX + ch); cbv[rr] = *(const v4u*)(U + row + OFF_CB + ch); }
        __builtin_amdgcn_sched_barrier(0);
        const float w0[8] = {wv[0][0].x, wv[0][0].y, wv[0][0].z, wv[0][0].w, wv[0][1].x, wv[0][1].y, wv[0][1].z, wv[0][1].w};
        const float w1[8] = {wv[1][0].x, wv[1][0].y, wv[1][0].z, wv[1][0].w, wv[1][1].x, wv[1][1].y, wv[1][1].z, wv[1][1].w};
        const float w2[8] = {wv[2][0].x, wv[2][0].y, wv[2][0].z, wv[2][0].w, wv[2][1].x, wv[2][1].y, wv[2][1].z, wv[2][1].w};
        float zm2[8], zm1[8];
        { const unsigned a2[4] = {hc[0].x, hc[0].y, hc[0].z, hc[0].w}, b2[4] = {hx[0].x, hx[0].y, hx[0].z, hx[0].w}, a1[4] = {hc[1].x, hc[1].y, hc[1].z, hc[1].w}, b1[4] = {hx[1].x, hx[1].y, hx[1].z, hx[1].w};
#pragma unroll
          for (int i = 0; i < 4; ++i) { zm2[2 * i] = first ? 0.f : bflo(a2[i]) * bflo(b2[i]); zm2[2 * i + 1] = first ? 0.f : bfhi(a2[i]) * bfhi(b2[i]); zm1[2 * i] = first ? 0.f : bflo(a1[i]) * bflo(b1[i]); zm1[2 * i + 1] = first ? 0.f : bfhi(a1[i]) * bfhi(b1[i]); } }
#pragma unroll
        for (int rr = 0; rr < 8; ++rr) {
            const unsigned ac[4] = {ccv[rr].x, ccv[rr].y, ccv[rr].z, ccv[rr].w}, ax[4] = {cxv[rr].x, cxv[rr].y, cxv[rr].z, cxv[rr].w}, ab[4] = {cbv[rr].x, cbv[rr].y, cbv[rr].z, cbv[rr].w};
            float z[8], o[8];
#pragma unroll
            for (int i = 0; i < 4; ++i) { z[2 * i] = bflo(ac[i]) * bflo(ax[i]); z[2 * i + 1] = bfhi(ac[i]) * bfhi(ax[i]); }
#pragma unroll
            for (int i = 0; i < 8; ++i) o[i] = w0[i] * zm2[i] + w1[i] * zm1[i] + w2[i] * z[i];
#pragma unroll
            for (int i = 0; i < 4; ++i) { o[2 * i] *= bflo(ab[i]); o[2 * i + 1] *= bfhi(ab[i]); }
            v4u ov; ov.x = pk2(o[0], o[1]); ov.y = pk2(o[2], o[3]); ov.z = pk2(o[4], o[5]); ov.w = pk2(o[6], o[7]);
            *(v4u*)(AIN + (size_t)(tr0 + rr) * K4 + ch) = ov;
#pragma unroll
            for (int i = 0; i < 8; ++i) { zm2[i] = zm1[i]; zm1[i] = z[i]; }
        }
    }
}

__device__ __forceinline__ void p3c_unit(const Args& a, LAS unsigned char* lds, int unit, int tid, int lane, int wave) {
    const int n = unit % NCH, bh = unit / NCH, h = bh % RH, b = bh / RH;
    const bf16* U = (const bf16*)(a.ws + WS_U);
    const size_t t0 = (size_t)b * SEQ + (size_t)n * CHUNK;
    const float log_g = log1pf(-exp2f(-5.f - (float)h));
    __syncthreads();
    const int g = lane >> 4, fr = lane & 15, q = fr >> 2, p = lane & 3;
    const int il = 16 * wave + fr;
    v4u kk[4], spv[8], vv[8]; bf16x8 bq[4];
    const bf16* SP = (const bf16*)(a.ws + WS_SPT) + (size_t)unit * DV * DK;
#pragma unroll
    for (int it = 0; it < 4; ++it) { const int task = tid + 512 * it; const int r_ = task >> 4, c = task & 15; kk[it] = *(const v4u*)(U + (t0 + r_) * INC + OFF_K + h * DK + c * 8); }
    if (n > 0) {
#pragma unroll
        for (int it = 0; it < 8; ++it) { const int task = tid + 512 * it; spv[it] = *(const v4u*)(SP + (size_t)task * 8); }
    }
#pragma unroll
    for (int ks = 0; ks < 4; ++ks) bq[ks] = *(const bf16x8*)(U + (t0 + il) * INC + OFF_Q + h * DK + 32 * ks + 8 * g);
#pragma unroll
    for (int it = 0; it < 4; ++it) { const int task = tid + 512 * it; const int r_ = task >> 4, c = task & 15; *(LAS v4u*)(lds + KS_OFF + r_ * RS_K + c * 16) = kk[it]; }
    f32x4 acc[16];
#pragma unroll
    for (int et = 0; et < 16; ++et) acc[et] = (f32x4){0.f, 0.f, 0.f, 0.f};
    if (n > 0) {
#pragma unroll
        for (int it = 0; it < 8; ++it) { const int task = tid + 512 * it; const int e_ = task >> 4, c = task & 15; *(LAS v4u*)(lds + VS_OFF + e_ * RS_K + c * 16) = spv[it]; }
        __syncthreads();
    }
#pragma unroll
    for (int it = 0; it < 8; ++it) { const int task = tid + 512 * it; const int r_ = task >> 5, c = task & 31; vv[it] = *(const v4u*)(U + (t0 + r_) * INC + OFF_V + h * DV + c * 8); }
    if (n > 0) {
        const LAS unsigned char* sp = lds + VS_OFF + fr * RS_K + 16 * g;
#pragma unroll
        for (int ks = 0; ks < 4; ++ks)
#pragma unroll
            for (int eh = 0; eh < 2; ++eh) {
                bf16x8 as[8];
#pragma unroll
                for (int e8 = 0; e8 < 8; ++e8) as[e8] = *(const LAS bf16x8*)(sp + (16 * (eh * 8 + e8)) * RS_K + 64 * ks);
#pragma unroll
                for (int e8 = 0; e8 < 8; ++e8) acc[eh * 8 + e8] = __builtin_amdgcn_mfma_f32_16x16x32_bf16(as[e8], bq[ks], acc[eh * 8 + e8], 0, 0, 0);
                SBAR();
            }
        const float qd = __expf(log_g * (float)(il + 1));
#pragma unroll
        for (int et = 0; et < 16; ++et) acc[et] = acc[et] * qd;
        __syncthreads();
    }
#pragma unroll
    for (int it = 0; it < 8; ++it) { const int task = tid + 512 * it; const int r_ = task >> 5, c = task & 31; *(LAS v4u*)(lds + VS_OFF + r_ * RS_V + c * 16) = vv[it]; }
    __syncthreads();
    const unsigned aV = (unsigned)(uintptr_t)(lds + VS_OFF) + (unsigned)((4 * g + q) * RS_V + 8 * p);
    const int npair = (wave >> 1) + 1;
#pragma unroll 1
    for (int pp = 0; pp < npair; ++pp) {
        f32x4 st[2];
#pragma unroll
        for (int hh = 0; hh < 2; ++hh) {
            const LAS unsigned char* kp = lds + KS_OFF + (32 * pp + 16 * hh + fr) * RS_K + 16 * g;
            f32x4 s = {0.f, 0.f, 0.f, 0.f};
#pragma unroll
            for (int ks = 0; ks < 4; ++ks) { const bf16x8 ak = *(const LAS bf16x8*)(kp + 64 * ks); s = __builtin_amdgcn_mfma_f32_16x16x32_bf16(ak, bq[ks], s, 0, 0, 0); }
#pragma unroll
            for (int r = 0; r < 4; ++r) { const int jl = 32 * pp + 16 * hh + 4 * g + r; const float f = (il >= jl) ? __expf(log_g * (float)(il - jl)) : 0.f; s[r] *= f; }
            st[hh] = s;
        }
        v4u pw; pw.x = pk2(st[0][0], st[0][1]); pw.y = pk2(st[0][2], st[0][3]); pw.z = pk2(st[1][0], st[1][1]); pw.w = pk2(st[1][2], st[1][3]);
        const bf16x8 bp = __builtin_bit_cast(bf16x8, pw);
        const unsigned av = aV + (unsigned)(pp * 32 * RS_V);
#pragma unroll
        for (int eh = 0; eh < 2; ++eh) {
            s16x4 vl[8], vh[8];
#pragma unroll
            for (int e8 = 0; e8 < 8; ++e8) { TR_READ(vl[e8], av, (eh * 8 + e8) * 32); TR_READ(vh[e8], av, 16 * RS_V + (eh * 8 + e8) * 32); }
            asm volatile("s_waitcnt lgkmcnt(0)" ::: "memory"); SBAR();
#pragma unroll
            for (int e8 = 0; e8 < 8; ++e8) acc[eh * 8 + e8] = __builtin_amdgcn_mfma_f32_16x16x32_bf16(PK8(vl[e8], vh[e8]), bp, acc[eh * 8 + e8], 0, 0, 0);
        }
    }
    float ss = 0.f;
#pragma unroll
    for (int et = 0; et < 16; ++et) ss += (acc[et][0] * acc[et][0] + acc[et][1] * acc[et][1]) + (acc[et][2] * acc[et][2] + acc[et][3] * acc[et][3]);
    ss += __shfl_xor(ss, 16); ss += __shfl_xor(ss, 32);
    const float rstd = rsqrtf(ss * (1.f / DV) + EPS);
    const bf16* rgp = U + (t0 + il) * INC + OFF_RG + h * DV + 4 * g;
    bf16* rnp = (bf16*)(a.ws + WS_A4) + (t0 + il) * K4 + CONV_CH + h * DV + 4 * g;
#pragma unroll
    for (int et = 0; et < 16; ++et) {
        const v2u rg = *(const v2u*)(rgp + 16 * et);
        const float o0 = acc[et][0] * rstd * silu_f(bflo(rg.x)), o1 = acc[et][1] * rstd * silu_f(bfhi(rg.x)), o2 = acc[et][2] * rstd * silu_f(bflo(rg.y)), o3 = acc[et][3] * rstd * silu_f(bfhi(rg.y));
        v2u w; w.x = pk2(o0, o1); w.y = pk2(o2, o3); *(v2u*)(rnp + 16 * et) = w;
    }
}
__device__ __forceinline__ int* route_eid(unsigned char* ws) { return (int*)(ws + WS_ROUTE); }
__device__ __forceinline__ int* route_pos(unsigned char* ws) { return (int*)(ws + WS_ROUTE) + NA; }
__device__ __forceinline__ float* route_cw(unsigned char* ws) { return (float*)(ws + WS_ROUTE) + 2 * NA; }
__device__ __forceinline__ int* route_list(unsigned char* ws) { return (int*)(ws + WS_ROUTE + al256((size_t)NA * 12)); }

__device__ __forceinline__ const GAS char* uni_ptr(const void* p) { const unsigned long long v = (unsigned long long)p;
    return (const GAS char*)(((unsigned long long)(unsigned)__builtin_amdgcn_readfirstlane((int)(v >> 32)) << 32) | (unsigned long long)(unsigned)__builtin_amdgcn_readfirstlane((int)(v & 0xffffffffu))); }
constexpr int P6_TAB = 0, P6_HI = 16384, P6_RS = 1040, P6_LO = P6_HI + 32 * P6_RS, P6_LG = P6_LO + 32 * P6_RS, P6_CP = 0;
__device__ __forceinline__ void p6_route(const Args& a, LAS unsigned char* lds, int tid, int lane, int wave, int G, unsigned long long* tsv = nullptr) {
    unsigned char* ws = a.ws;
    const float* MOD = (const float*)(ws + WS_MOD); const float* X1 = (const float*)(ws + WS_X1); bf16* H2 = (bf16*)(ws + WS_H);
    const float* g = a.in[I_N2G]; const bf16* WRT = (const bf16*)(ws + WS_WRT);
    LAS float* tsc = (LAS float*)(lds + P6_TAB); LAS float* tsh = tsc + D; LAS float* lg = (LAS float*)(lds + P6_LG);
    int* cnt = (int*)(ws + WS_CTL) + CW_CNT;
    const int fr = lane & 15, fq = lane >> 4;
    for (int rb = blockIdx.x; rb < T / 32; rb += G) {
        const int b = (rb * 32) / SEQ;
        asm volatile("" : "+s"(WRT), "+s"(g));
        __syncthreads();
        { const GAS char* mb = uni_ptr(MOD + (size_t)b * MODC + 3 * D);
          for (int d = tid; d < D; d += 512) { tsh[d] = *(const GAS float*)(mb + (unsigned)d * 4u); tsc[d] = 1.f + *(const GAS float*)(mb + (unsigned)(D + d) * 4u); } }
        __syncthreads();
#define P6_PUT(rr_, c_) do { const int rl = wave * 4 + (rr_); _Pragma("unroll") for (int jj = 0; jj < 2; ++jj) { const int dl = 4 * lane + 256 * jj; const f32x4 x = hv[rr_][2 * (c_) + jj]; \
            const unsigned h0 = f2bf(x.x), h1 = f2bf(x.y), h2_ = f2bf(x.z), h3 = f2bf(x.w); \
            const float l0 = x.x - __builtin_bit_cast(float, h0 << 16), l1 = x.y - __builtin_bit_cast(float, h1 << 16), l2 = x.z - __builtin_bit_cast(float, h2_ << 16), l3 = x.w - __builtin_bit_cast(float, h3 << 16); \
            v2u wh, wl; wh.x = h0 | (h1 << 16); wh.y = h2_ | (h3 << 16); wl.x = pk2(l0, l1); wl.y = pk2(l2, l3); \
            *(LAS v2u*)(lds + P6_HI + rl * P6_RS + dl * 2) = wh; *(LAS v2u*)(lds + P6_LO + rl * P6_RS + dl * 2) = wl; } } while (0)
        f32x4 hv[4][8];
        { f32x4 gg[8];
#pragma unroll
          for (int rr = 0; rr < 4; ++rr)
#pragma unroll
            for (int j = 0; j < 8; ++j) hv[rr][j] = *(const GAS f32x4*)(uni_ptr(X1 + (size_t)(rb * 32 + wave * 4 + rr) * D + 256 * j) + lane * 16);
#pragma unroll
          for (int j = 0; j < 8; ++j) gg[j] = *(const GAS f32x4*)(uni_ptr(g + 256 * j) + lane * 16);
#pragma unroll
          for (int rr = 0; rr < 4; ++rr) {
            float s = 0.f;
#pragma unroll
            for (int j = 0; j < 8; ++j) s += (hv[rr][j].x * hv[rr][j].x + hv[rr][j].y * hv[rr][j].y) + (hv[rr][j].z * hv[rr][j].z + hv[rr][j].w * hv[rr][j].w);
            const float rstd = rsqrtf(wave_sum(s) * (1.f / D) + EPS);
            GAS char* o8 = (GAS char*)uni_ptr(H2 + (size_t)(rb * 32 + wave * 4 + rr) * D);
#pragma unroll
            for (int j = 0; j < 8; ++j) { const int d = 4 * lane + 256 * j; const f32x4 cs = *(const LAS f32x4*)(tsc + d), sh = *(const LAS f32x4*)(tsh + d);
                hv[rr][j] = hv[rr][j] * rstd * gg[j] * cs + sh; v2u w; w.x = pk2(hv[rr][j].x, hv[rr][j].y); w.y = pk2(hv[rr][j].z, hv[rr][j].w); *(GAS v2u*)(o8 + 512 * j + lane * 8) = w; }
            P6_PUT(rr, 0);
          } }
        if (tsv) tsv[0] = __builtin_amdgcn_s_memrealtime();
        f32x4 acc[2][3];
#pragma unroll
        for (int mt = 0; mt < 2; ++mt)
#pragma unroll
            for (int n = 0; n < 3; ++n) acc[mt][n] = (f32x4){0.f, 0.f, 0.f, 0.f};
        bf16x8 bq[2][2][3];
#define P6_LOADB(c_, dst) do { const unsigned vo_ = (unsigned)((fr * D + 8 * fq) * 2); _Pragma("unroll") for (int kk = 0; kk < 2; ++kk) _Pragma("unroll") for (int n = 0; n < 3; ++n) { \
            const bf16* w0_ = WRT + (size_t)(n * 16) * D + 512 * (c_) + (2 * wave + kk) * 32; \
            dst[kk][0][n] = *(const GAS bf16x8*)(uni_ptr(w0_) + vo_); dst[kk][1][n] = *(const GAS bf16x8*)(uni_ptr(w0_ + (size_t)48 * D) + vo_); } } while (0)
#pragma unroll
        for (int c = 0; c < 4; ++c) {
            P6_LOADB(c, bq);
            if (c > 0) {
#pragma unroll
                for (int rr = 0; rr < 4; ++rr) P6_PUT(rr, c); }
            __syncthreads();
#pragma unroll
            for (int kk = 0; kk < 2; ++kk) { const int ks = 2 * wave + kk;
                bf16x8 ah[2], al[2];
#pragma unroll
                for (int mt = 0; mt < 2; ++mt) { ah[mt] = *(const LAS bf16x8*)(lds + P6_HI + (mt * 16 + fr) * P6_RS + (ks * 32 + 8 * fq) * 2); al[mt] = *(const LAS bf16x8*)(lds + P6_LO + (mt * 16 + fr) * P6_RS + (ks * 32 + 8 * fq) * 2); }
#pragma unroll
                for (int mt = 0; mt < 2; ++mt)
#pragma unroll
                    for (int n = 0; n < 3; ++n) { f32x4 t = acc[mt][n];
                        t = __builtin_amdgcn_mfma_f32_16x16x32_bf16(al[mt], bq[kk][1][n], t, 0, 0, 0); t = __builtin_amdgcn_mfma_f32_16x16x32_bf16(al[mt], bq[kk][0][n], t, 0, 0, 0);
                        t = __builtin_amdgcn_mfma_f32_16x16x32_bf16(ah[mt], bq[kk][1][n], t, 0, 0, 0); t = __builtin_amdgcn_mfma_f32_16x16x32_bf16(ah[mt], bq[kk][0][n], t, 0, 0, 0); acc[mt][n] = t; } }
            __syncthreads();
        }
#undef P6_LOADB
#undef P6_PUT
        if (tsv) tsv[1] = __builtin_amdgcn_s_memrealtime();
#pragma unroll
        for (int mt = 0; mt < 2; ++mt)
#pragma unroll
            for (int n = 0; n < 3; ++n) *(LAS f32x4*)(lds + P6_CP + ((wave * 6 + mt * 3 + n) * 64 + lane) * 16) = acc[mt][n];
        __syncthreads();
        for (int idx = tid; idx < 6 * 256; idx += 512) { const int tile = idx >> 8, ln = (idx >> 2) & 63, reg = idx & 3; float s = 0.f;
#pragma unroll
            for (int w = 0; w < 8; ++w) s += *(const LAS float*)(lds + P6_CP + ((w * 6 + tile) * 64 + ln) * 16 + reg * 4);
            const int mt = tile / 3, n = tile % 3, row = mt * 16 + 4 * (ln >> 4) + reg, o = n * 16 + (ln & 15);
            lg[row * 48 + o] = s + (o < 4 ? a.in[I_BRG][o] : (o < 36 ? a.in[I_BRE][o - 4] : 0.f)); }
        __syncthreads();
        if (tsv) tsv[2] = __builtin_amdgcn_s_memrealtime();
        if (tid < 32) {
            const LAS float* l = lg + tid * 48;
            int gs = 0; float m = l[0];
#pragma unroll
            for (int q = 1; q < 4; ++q) { const float v = l[q]; if (v > m) { m = v; gs = q; } }
            float den = 0.f;
#pragma unroll
            for (int q = 0; q < 4; ++q) den += __expf(l[q] - m);
            const float gw = 1.f / den;
            float el[8];
#pragma unroll
            for (int i = 0; i < 8; ++i) el[i] = l[4 + gs * 8 + i];
            float m2 = el[0];
#pragma unroll
            for (int i = 1; i < 8; ++i) m2 = fmaxf(m2, el[i]);
            float pr[8];
#pragma unroll
            for (int i = 0; i < 8; ++i) pr[i] = __expf(el[i] - m2);
            int i1 = 0; float p1 = pr[0];
#pragma unroll
            for (int i = 1; i < 8; ++i) if (pr[i] > p1) { p1 = pr[i]; i1 = i; }
            int i2 = -1; float p2 = -1.f;
#pragma unroll
            for (int i = 0; i < 8; ++i) if (i != i1 && pr[i] > p2) { p2 = pr[i]; i2 = i; }
            const float sden = 1.f / (p1 + p2);
            const int t = rb * 32 + tid; const int e0 = gs * 8 + i1, e1 = gs * 8 + i2;
            const int sh = rb & (NSH - 1);
            const int q0 = sh * SHCAP + atomicAdd(&cnt[sh * 32 + e0], 1), q1 = sh * SHCAP + atomicAdd(&cnt[sh * 32 + e1], 1);
            route_eid(ws)[2 * t] = e0; route_eid(ws)[2 * t + 1] = e1; route_pos(ws)[2 * t] = q0; route_pos(ws)[2 * t + 1] = q1;
            route_cw(ws)[2 * t] = gw * p1 * sden; route_cw(ws)[2 * t + 1] = gw * p2 * sden;
            route_list(ws)[(size_t)e0 * T + q0] = t; route_list(ws)[(size_t)e1 * T + q1] = t;
        }
    }
}

constexpr int MT = MOE_MT;
struct MoeTab { LAS int* cnt; LAS int* tpre; LAS int* tile_e; LAS int* gstart; LAS int* gtile; LAS int* spre; };
__device__ __forceinline__ MoeTab moe_tab(LAS unsigned char* lds) { MoeTab t; t.cnt = (LAS int*)(lds + LDSTAB_OFF); t.tpre = t.cnt + 32; t.tile_e = t.tpre + 40; t.gstart = t.tile_e + 168; t.gtile = t.gstart + 16; t.spre = t.gtile + 200; return t; }
__device__ __forceinline__ int moe_lidx(const LAS int* spre, int e, int idx) { const LAS int* p = spre + e * NSH; int s = 0;
#pragma unroll
    for (int j = 1; j < NSH; ++j) s += (idx >= p[j]) ? 1 : 0;
    return s * SHCAP + idx - p[s]; }
__device__ __forceinline__ void moe_build_tab(const Args& a, LAS unsigned char* lds, int tid) {
    MoeTab t = moe_tab(lds); const int* cnt = (const int*)(a.ws + WS_CTL) + CW_CNT;
    __syncthreads();
    if (tid < 64) {
        const int e = tid & 31; int c = 0; int cs[NSH];
#pragma unroll
        for (int s = 0; s < NSH; ++s) cs[s] = cnt[s * 32 + e];
        __builtin_amdgcn_sched_barrier(0);
#pragma unroll
        for (int s = 0; s < NSH; ++s) { if (tid < 32) t.spre[e * NSH + s] = c; c += cs[s]; }
        const int n = (c + MT - 1) / MT;
        int incl = n;
#pragma unroll
        for (int o = 1; o < 32; o <<= 1) { const int v = __shfl_up(incl, o, 32); if (e >= o) incl += v; }
        const int pre = incl - n;
        if (tid < 32) { t.cnt[e] = c; t.tpre[e] = pre; if (e == 31) t.tpre[NE] = incl;
            for (int i = 0; i < n; ++i) t.tile_e[pre + i] = e; }
    }
    __syncthreads();
}
template <bool GATHER> struct MoeOrder {
    MoeTab tab; const char* A; const char* Bt; const int* list; int G, c, K, ldb; size_t eBstride;
    __device__ __forceinline__ bool next(int i, Unit& u) const {
        const int L = i * G + c; const int total = tab.tpre[NE] * 8; if (L >= total) return false;
        const int rtg = L >> 3; u.pn = L & 7; u.e = tab.tile_e[rtg]; u.pm = rtg - tab.tpre[u.e]; u.row0 = rtg * 256; u.half = 0; return true;
    }
    __device__ __forceinline__ const char* a_tile(const Unit& u, size_t tstep) const { return GATHER ? A : A + (size_t)(u.row0 / 256) * tstep; }
    __device__ __forceinline__ const char* b_tile(const Unit& u, size_t tstep) const { return Bt + (size_t)u.e * eBstride + (ldb ? (size_t)u.pn * 512 : (size_t)u.pn * tstep); }
    __device__ __forceinline__ void a_offsets(const Unit& u, const int (&R)[2], const int (&C)[2], int K_, unsigned (&vo)[2][2]) const {
        const int ce = tab.cnt[u.e];
#pragma unroll
        for (int h = 0; h < 2; ++h)
#pragma unroll
            for (int i = 0; i < 2; ++i) { int idx = u.pm * 256 + h * 128 + R[i]; idx = idx < ce ? idx : ce - 1; const int tok = list[(size_t)u.e * T + moe_lidx(tab.spre, u.e, idx)]; vo[h][i] = (unsigned)(tok * K_ + C[i]) * 2u; }
    }
};
struct EpiHM {
    static constexpr bool PERM = true; bf16* HM;
    __device__ __forceinline__ void operator()(const f32x4 (&acc)[2][2][4][2], const Unit& u, int wr, int wc, int fr, int fq) const {
        const int row0 = u.row0 + wr * 64 + fr, col0 = u.pn * 128 + wc * 32 + 8 * fq;
#pragma unroll
        for (int ai = 0; ai < 2; ++ai)
#pragma unroll
            for (int m = 0; m < 4; ++m) { const f32x4 g0 = acc[ai][0][m][0], g1 = acc[ai][0][m][1], u0 = acc[ai][1][m][0], u1 = acc[ai][1][m][1];
                u32x4 w; w.x = cvt_pk_bf16(silu_f(g0[0]) * u0[0], silu_f(g0[1]) * u0[1]); w.y = cvt_pk_bf16(silu_f(g0[2]) * u0[2], silu_f(g0[3]) * u0[3]);
                w.z = cvt_pk_bf16(silu_f(g1[0]) * u1[0], silu_f(g1[1]) * u1[1]); w.w = cvt_pk_bf16(silu_f(g1[2]) * u1[2], silu_f(g1[3]) * u1[3]);
                *(u32x4*)(HM + (size_t)(row0 + ai * 128 + m * 16) * DE + col0) = w; }
    }
};

struct EpiHMn {
    static constexpr bool PERM = false; bf16* HM;
    __device__ __forceinline__ void operator()(const f32x4 (&acc)[2][2][4][2], const Unit& u, int wr, int wc, int fr, int fq) const {
        const int row0 = u.row0 + wr * 64 + fr, col0 = u.pn * 128 + wc * 32 + 4 * fq;
#pragma unroll
        for (int ai = 0; ai < 2; ++ai)
#pragma unroll
            for (int m = 0; m < 4; ++m)
#pragma unroll
                for (int n = 0; n < 2; ++n) { const f32x4 g0 = acc[ai][0][m][n], u0 = acc[ai][1][m][n];
                    v2u w; w.x = cvt_pk_bf16(silu_f(g0[0]) * u0[0], silu_f(g0[1]) * u0[1]); w.y = cvt_pk_bf16(silu_f(g0[2]) * u0[2], silu_f(g0[3]) * u0[3]);
                    *(v2u*)(HM + (size_t)(row0 + ai * 128 + m * 16) * DE + col0 + 16 * n) = w; }
    }
};
struct EpiBf16n {
    static constexpr bool PERM = false; bf16* O; int ldc;
    __device__ __forceinline__ void operator()(const f32x4 (&acc)[2][2][4][2], const Unit& u, int wr, int wc, int fr, int fq) const {
        const int row0 = u.row0 + wr * 64 + fr, col0 = u.pn * 256 + wc * 32 + 4 * fq;
#pragma unroll
        for (int ai = 0; ai < 2; ++ai)
#pragma unroll
            for (int m = 0; m < 4; ++m) { bf16* rowp = O + (size_t)(row0 + ai * 128 + m * 16) * ldc + col0;
#pragma unroll
                for (int bj = 0; bj < 2; ++bj)
#pragma unroll
                    for (int n = 0; n < 2; ++n) { const f32x4 v = acc[ai][bj][m][n]; v2u w; w.x = cvt_pk_bf16(v[0], v[1]); w.y = cvt_pk_bf16(v[2], v[3]); *(v2u*)(rowp + bj * 128 + 16 * n) = w; } }
    }
};

constexpr int PGM_A = 0, PGM_B = 49152, PGM_LDS = PGM_B + 65536;
struct MoeUnit { int e, pn, rt, row0, hs, tq; };
template <bool GATHER, class Epi>
__device__ __forceinline__ void moe_gemm(LAS unsigned char* lds, const int K, const MoeTab tab, const int G, const int c, const char* A, const int* list,
                                          const float* B0, const float* B1, const size_t eB, const int ldb, const int colstep, const Epi& E) {
    const int tid = threadIdx.x, wid = __builtin_amdgcn_readfirstlane(tid >> 6), lane = tid & 63, wr = wid >> 2, wc = wid & 3, fr = lane & 15, fq = lane >> 4;
    const int nt = K / 64, ntiles = tab.tpre[NE];
    int stR[2], stC[2];
#pragma unroll
    for (int i = 0; i < 2; ++i) pg8::stage_rc(tid * 16 + i * 8192, stR[i], stC[i]);
    const int aoff = pg8::lds_byte(wr * 64 + fr, fq * 8);
    const int kb = 8 * wid + (lane >> 5), cl = lane & 31;
    const unsigned bvo = (unsigned)((kb * ldb + 4 * cl) * 4);
    const size_t ktB = (size_t)64 * ldb * 4, rowB2 = (size_t)2 * ldb * 4;
    unsigned bw[4];
#pragma unroll
    for (int j = 0; j < 4; ++j) { const int k = kb + 2 * j; bw[j] = (unsigned)(256 * k + 16 * ((cl >> 1) ^ (((k & 3) << 2) | ((k >> 2) & 3))) + 8 * (cl & 1)); }
    unsigned tb[2][2];
    { const int q = fr >> 2, p = lane & 3;
#pragma unroll
      for (int n = 0; n < 2; ++n)
#pragma unroll
        for (int t = 0; t < 2; ++t) { const int row = 8 * fq + 4 * t + q, ch = 2 * (2 * wc + n) + (p >> 1);
            tb[n][t] = (unsigned)(uintptr_t)lds + PGM_B + (unsigned)(256 * row + 16 * (ch ^ (((row & 3) << 2) | ((row >> 2) & 3))) + 8 * (p & 1)); } }
    const bool grouped = false; const int gsz = G, gj = c, gn = ntiles;
    (void)grouped;
#define PGM_UNIT(q, u, sb0, sb1, aBp, vop) do { (u).pn = (q) / gn; const int _rtg = (q) - (u).pn * gn; (u).e = tab.tile_e[_rtg]; (u).rt = _rtg - tab.tpre[(u).e]; (u).row0 = _rtg * 128; \
        (sb0) = (const char*)(B0 + (size_t)(u).e * eB + (size_t)(u).pn * colstep); (sb1) = (const char*)(B1 + (size_t)(u).e * eB + (size_t)(u).pn * colstep); \
        if constexpr (GATHER) { const int _ce = tab.cnt[(u).e]; _Pragma("unroll") for (int _i = 0; _i < 2; ++_i) { int _idx = (u).rt * 128 + stR[_i]; _idx = _idx < _ce ? _idx : _ce - 1; \
                const int _tok = list[(size_t)(u).e * T + moe_lidx(tab.spre, (u).e, _idx)]; (vop)[_i] = (unsigned)(_tok * K + stC[_i]) * 2u; } (aBp) = A; } \
        else { _Pragma("unroll") for (int _i = 0; _i < 2; ++_i) (vop)[_i] = (unsigned)(stR[_i] * K + stC[_i]) * 2u; (aBp) = A + (size_t)(u).row0 * K * 2; } } while (0)
#define PGM_TR(dst, vb, off) asm volatile("ds_read_b64_tr_b16 %0, %1 offset:%c2" : "=&v"(dst) : "v"(vb), "i"(off) : "memory")
#define PGM_STAGE_A(buf, ap, vop, kt) do { _Pragma("unroll") for (int _i = 0; _i < 2; ++_i) \
        __builtin_amdgcn_global_load_lds((const unsigned*)((ap) + (size_t)(kt) * 128 + (vop)[_i]), (LAS unsigned*)(lds + PGM_A + (buf) * 16384 + wid * 1024 + _i * 8192), 16, 0, 0); } while (0)
#define PGM_LOAD_B(rs, p0, p1, kt) do { _Pragma("unroll") for (int _j = 0; _j < 4; ++_j) { const char* _a0 = (p0) + (size_t)(kt) * ktB + (size_t)_j * rowB2; const char* _a1 = (p1) + (size_t)(kt) * ktB + (size_t)_j * rowB2; \
        asm volatile("global_load_dwordx4 %0, %1, %2" : "=&v"(rs[0][_j]) : "v"(bvo), "s"(_a0) : "memory"); \
        asm volatile("global_load_dwordx4 %0, %1, %2" : "=&v"(rs[1][_j]) : "v"(bvo), "s"(_a1) : "memory"); } } while (0)
#define PGM_WAIT8(rs) asm volatile("s_waitcnt vmcnt(10)" : "+v"(rs[0][0]), "+v"(rs[0][1]), "+v"(rs[0][2]), "+v"(rs[0][3]), "+v"(rs[1][0]), "+v"(rs[1][1]), "+v"(rs[1][2]), "+v"(rs[1][3]) :: "memory")
#define PGM_WRITE_B(rs, buf) do { _Pragma("unroll") for (int _h = 0; _h < 2; ++_h) _Pragma("unroll") for (int _j = 0; _j < 4; ++_j) { v2u _w; _w.x = cvt_pk_bf16(rs[_h][_j].x, rs[_h][_j].y); _w.y = cvt_pk_bf16(rs[_h][_j].z, rs[_h][_j].w); \
        *(LAS v2u*)(lds + PGM_B + ((buf) * 2 + _h) * 16384 + bw[_j]) = _w; } } while (0)
#define PGM_COMPUTE(cur, abuf) do { bf16x8 At[4][2]; s16x4 bl[2][2][2], bh[2][2][2]; const LAS unsigned char* _ap = lds + PGM_A + (abuf) * 16384 + aoff; \
        _Pragma("unroll") for (int h = 0; h < 2; ++h) _Pragma("unroll") for (int n = 0; n < 2; ++n) _Pragma("unroll") for (int k = 0; k < 2; ++k) { \
            PGM_TR(bl[h][n][k], tb[n][0], ((cur) * 2 + h) * 16384 + k * 8192); PGM_TR(bh[h][n][k], tb[n][1], ((cur) * 2 + h) * 16384 + k * 8192); } \
        _Pragma("unroll") for (int mm = 0; mm < 4; ++mm) _Pragma("unroll") for (int k = 0; k < 2; ++k) At[mm][k] = *(const LAS bf16x8*)(_ap + mm * 2048 + k * 1024); \
        asm volatile("s_waitcnt lgkmcnt(0)" ::: "memory"); SBAR(); __builtin_amdgcn_s_setprio(1); \
        _Pragma("unroll") for (int h = 0; h < 2; ++h) _Pragma("unroll") for (int mm = 0; mm < 4; ++mm) _Pragma("unroll") for (int n = 0; n < 2; ++n) _Pragma("unroll") for (int k = 0; k < 2; ++k) \
            acc[h][mm][n] = __builtin_amdgcn_mfma_f32_16x16x32_bf16(PK8(bl[h][n][k], bh[h][n][k]), At[mm][k], acc[h][mm][n], 0, 0, 0); \
        __builtin_amdgcn_s_setprio(0); SBAR(); } while (0)
#define PGM_BARRIER() do { asm volatile("s_waitcnt lgkmcnt(0)" ::: "memory"); __builtin_amdgcn_s_barrier(); asm volatile("" ::: "memory"); } while (0)
    int q = gj; if (q >= gn * 8) return;
    MoeUnit cur, nxt; const char *cb0, *cb1, *caB, *nb0, *nb1, *naB; unsigned cvo[2], nvo[2];
    PGM_UNIT(q, cur, cb0, cb1, caB, cvo);
    f32x4 rs0[2][4], rs1[2][4];
    asm volatile("s_waitcnt vmcnt(0)" ::: "memory"); PGM_BARRIER();
    int a0 = 0;
    PGM_STAGE_A(0, caB, cvo, 0); PGM_LOAD_B(rs0, cb0, cb1, 0); PGM_STAGE_A(1, caB, cvo, 1); PGM_LOAD_B(rs1, cb0, cb1, 1);
    PGM_WAIT8(rs0); PGM_WRITE_B(rs0, 0); PGM_BARRIER();
    for (;;) {
        const bool has_next = q + gsz < gn * 8;
        if (has_next) { PGM_UNIT(q + gsz, nxt, nb0, nb1, naB, nvo); } else { nxt = cur; nb0 = cb0; nb1 = cb1; naB = caB; nvo[0] = cvo[0]; nvo[1] = cvo[1]; }
        f32x4 acc[2][4][2];
#pragma unroll
        for (int b = 0; b < 2; ++b)
#pragma unroll
            for (int mm = 0; mm < 4; ++mm)
#pragma unroll
                for (int n = 0; n < 2; ++n) acc[b][mm][n] = (f32x4){0.f, 0.f, 0.f, 0.f};
#pragma unroll 1
        for (int t = 0; t < nt; t += 2) {
            const bool lastp = (t == nt - 2);
            const char* p0 = lastp ? nb0 : cb0; const char* p1 = lastp ? nb1 : cb1; const char* pa = lastp ? naB : caB; const int kt2 = lastp ? 0 : t + 2;
            unsigned vo2[2]; vo2[0] = lastp ? nvo[0] : cvo[0]; vo2[1] = lastp ? nvo[1] : cvo[1];
            { const int a2 = a0 >= 1 ? a0 - 1 : 2; PGM_STAGE_A(a2, pa, vo2, kt2); } PGM_LOAD_B(rs0, p0, p1, kt2);
            PGM_COMPUTE(0, a0);
            PGM_WAIT8(rs1); PGM_WRITE_B(rs1, 1); PGM_BARRIER();
            a0 = a0 == 2 ? 0 : a0 + 1;
            { const int a2 = a0 >= 1 ? a0 - 1 : 2; PGM_STAGE_A(a2, pa, vo2, kt2 + 1); } PGM_LOAD_B(rs1, p0, p1, kt2 + 1);
            PGM_COMPUTE(1, a0);
            PGM_WAIT8(rs0); PGM_WRITE_B(rs0, 0); PGM_BARRIER();
            a0 = a0 == 2 ? 0 : a0 + 1;
        }
        E(acc, cur, wr, wc, fr, fq);
        if (!has_next) break;
        cur = nxt; cb0 = nb0; cb1 = nb1; caB = naB; cvo[0] = nvo[0]; cvo[1] = nvo[1]; q += gsz;
    }
    asm volatile("s_waitcnt vmcnt(0)" : "+v"(rs0[0][0]), "+v"(rs0[0][1]), "+v"(rs0[0][2]), "+v"(rs0[0][3]), "+v"(rs0[1][0]), "+v"(rs0[1][1]), "+v"(rs0[1][2]), "+v"(rs0[1][3]) :: "memory");
    asm volatile("" : "+v"(rs1[0][0]), "+v"(rs1[0][1]), "+v"(rs1[0][2]), "+v"(rs1[0][3]), "+v"(rs1[1][0]), "+v"(rs1[1][1]), "+v"(rs1[1][2]), "+v"(rs1[1][3]) :: "memory");
    PGM_BARRIER();
#undef PGM_UNIT
#undef PGM_TR
#undef PGM_STAGE_A
#undef PGM_LOAD_B
#undef PGM_WRITE_B
#undef PGM_WAIT8
#undef PGM_COMPUTE
#undef PGM_BARRIER
}
struct EpiHMm {
    bf16* HM;
    __device__ __forceinline__ void operator()(const f32x4 (&acc)[2][4][2], const MoeUnit& u, int wr, int wc, int fr, int fq) const {
        const int row0 = u.row0 + wr * 64 + fr, col0 = u.pn * 128 + wc * 32 + 4 * fq;
#pragma unroll
        for (int mm = 0; mm < 4; ++mm)
#pragma unroll
            for (int n = 0; n < 2; ++n) { const f32x4 g0 = acc[0][mm][n], u0 = acc[1][mm][n];
                v2u w; w.x = cvt_pk_bf16(silu_f(g0[0]) * u0[0], silu_f(g0[1]) * u0[1]); w.y = cvt_pk_bf16(silu_f(g0[2]) * u0[2], silu_f(g0[3]) * u0[3]);
                *(v2u*)(HM + (size_t)(row0 + mm * 16) * DE + col0 + 16 * n) = w; }
    }
};
struct EpiYm {
    bf16* Y;
    __device__ __forceinline__ void operator()(const f32x4 (&acc)[2][4][2], const MoeUnit& u, int wr, int wc, int fr, int fq) const {
        const int row0 = u.row0 + wr * 64 + fr, col0 = u.pn * 256 + wc * 32 + 4 * fq;
#pragma unroll
        for (int mm = 0; mm < 4; ++mm)
#pragma unroll
            for (int bj = 0; bj < 2; ++bj)
#pragma unroll
                for (int n = 0; n < 2; ++n) { const f32x4 v = acc[bj][mm][n]; v2u w; w.x = cvt_pk_bf16(v[0], v[1]); w.y = cvt_pk_bf16(v[2], v[3]); *(v2u*)(Y + (size_t)(row0 + mm * 16) * D + col0 + bj * 128 + 16 * n) = w; }
    }
};

constexpr int PGX_A = 0, PGX_B = 65536;
template <bool GATHER, class Epi, bool KSPLIT = false>
__device__ __forceinline__ void moe_gemm256(LAS unsigned char* lds, const int K, const MoeTab tab, const int G, const int c, const char* A, const int* list,
                                             const float* B0, const float* B1, const size_t eB, const int ldb, const int colstep, const Epi& E) {
    const int tid = threadIdx.x, wid = __builtin_amdgcn_readfirstlane(tid >> 6), lane = tid & 63, wr = wid >> 2, wc = wid & 3, fr = lane & 15, fq = lane >> 4;
    const int nt = K / 64, gn = tab.tpre[NE];
    int stR[2], stC[2];
#pragma unroll
    for (int i = 0; i < 2; ++i) pg8::stage_rc(tid * 16 + i * 8192, stR[i], stC[i]);
    const int aoff = pg8::lds_byte(wr * 64 + fr, fq * 8);
    const int kb = 8 * wid + (lane >> 5), cl = lane & 31;
    const unsigned bvo = (unsigned)((kb * ldb + 4 * cl) * 4);
    const size_t ktB = (size_t)64 * ldb * 4, rowB2 = (size_t)2 * ldb * 4;
    unsigned bw0; { const int k = kb; bw0 = (unsigned)(256 * k + 8 * (cl & 1)); }
    unsigned tb[2][2];
    { const int q = fr >> 2, p = lane & 3;
#pragma unroll
      for (int n = 0; n < 2; ++n)
#pragma unroll
        for (int t = 0; t < 2; ++t) { const int row = 8 * fq + 4 * t + q, ch = 2 * (2 * wc + n) + (p >> 1);
            tb[n][t] = (unsigned)(uintptr_t)lds + PGX_B + (unsigned)(256 * row + 16 * (ch ^ (((row & 3) << 2) | ((row >> 2) & 3))) + 8 * (p & 1)); } }
#define PGX_UNIT(q, u, sb0, sb1, aBp, vop) do { const int _q = (x_split && (q) >= x_full) ? x_full + (((q) - x_full) >> 1) : (q); (u).hs = (x_split && (q) >= x_full) ? (((q) - x_full) & 1) : -1; \
        (u).pn = _q / gn; const int _rtg = _q - (u).pn * gn; (u).e = tab.tile_e[_rtg]; (u).rt = _rtg - tab.tpre[(u).e]; (u).row0 = _rtg * 256; \
        (u).tq = MOE_SKIPHALF ? ((MOE_SKIPHALF > 1 && tab.cnt[(u).e] - (u).rt * 256 <= 64) ? 2 : ((tab.cnt[(u).e] - (u).rt * 256 <= 128) ? 1 : 0)) : ((x_split && (q) >= x_full) ? (((q) - x_full) >> 1) : 0); \
        { const size_t _bo = KSPLIT ? ((u).hs > 0 ? (size_t)(K / 2) * ldb : 0) : ((u).hs > 0 ? 64 : 0); \
          (sb0) = (const char*)(B0 + (size_t)(u).e * eB + (size_t)(u).pn * colstep + _bo); (sb1) = (const char*)(B1 + (size_t)(u).e * eB + (size_t)(u).pn * colstep + _bo); } \
        if constexpr (GATHER) { const int _ce = tab.cnt[(u).e]; _Pragma("unroll") for (int _h = 0; _h < 2; ++_h) _Pragma("unroll") for (int _i = 0; _i < 2; ++_i) { int _idx = (u).rt * 256 + _h * 128 + stR[_i]; _idx = _idx < _ce ? _idx : _ce - 1; \
                const int _tok = list[(size_t)(u).e * T + moe_lidx(tab.spre, (u).e, _idx)]; (vop)[_h][_i] = (unsigned)(_tok * K + stC[_i]) * 2u; } (aBp) = A; } \
        else { _Pragma("unroll") for (int _h = 0; _h < 2; ++_h) _Pragma("unroll") for (int _i = 0; _i < 2; ++_i) (vop)[_h][_i] = (unsigned)((_h * 128 + stR[_i]) * K + stC[_i]) * 2u; (aBp) = A + (size_t)(u).row0 * K * 2 + ((KSPLIT && (u).hs > 0) ? (size_t)K : 0); } } while (0)
#define PGX_TR(dst, vb, off) asm volatile("ds_read_b64_tr_b16 %0, %1 offset:%c2" : "=&v"(dst) : "v"(vb), "i"(off) : "memory")
#define PGX_STAGE_A(buf, ap, vop, kt, skip1) do { _Pragma("unroll") for (int _h = 0; _h < 2; ++_h) if (_h == 0 || !(MOE_SKIPHALF && (skip1) != 0)) _Pragma("unroll") for (int _i = 0; _i < 2; ++_i) if (_i == 0 || !(MOE_SKIPHALF > 1 && (skip1) == 2)) \
        __builtin_amdgcn_global_load_lds((const unsigned*)((ap) + (size_t)(kt) * 128 + (vop)[_h][_i]), (LAS unsigned*)(lds + PGX_A + ((buf) * 2 + _h) * 16384 + wid * 1024 + _i * 8192), 16, 0, 0); } while (0)
#define PGX_LOAD_B(rs, p0, p1, kt, hf) do { if (!(hf) || cl < 16) _Pragma("unroll") for (int _j = 0; _j < 4; ++_j) { const char* _a0 = (p0) + (size_t)(kt) * ktB + (size_t)_j * rowB2; const char* _a1 = (p1) + (size_t)(kt) * ktB + (size_t)_j * rowB2; \
        asm volatile("global_load_dwordx4 %0, %1, %2" : "=&v"(rs[0][_j]) : "v"(bvo), "s"(_a0) : "memory"); \
        asm volatile("global_load_dwordx4 %0, %1, %2" : "=&v"(rs[1][_j]) : "v"(bvo), "s"(_a1) : "memory"); } } while (0)
#define PGX_WAIT0(rs) asm volatile("s_waitcnt vmcnt(0)" : "+v"(rs[0][0]), "+v"(rs[0][1]), "+v"(rs[0][2]), "+v"(rs[0][3]), "+v"(rs[1][0]), "+v"(rs[1][1]), "+v"(rs[1][2]), "+v"(rs[1][3]) :: "memory")
#define PGX_WRITE_B(rs, buf) do { _Pragma("unroll") for (int _j = 0; _j < 4; ++_j) { const int _k = kb + 2 * _j; const unsigned _o = bw0 + 512u * _j + 16u * (unsigned)((cl >> 1) ^ (((_k & 3) << 2) | ((_k >> 2) & 3))); \
        _Pragma("unroll") for (int _h = 0; _h < 2; ++_h) { v2u _w; _w.x = cvt_pk_bf16(rs[_h][_j].x, rs[_h][_j].y); _w.y = cvt_pk_bf16(rs[_h][_j].z, rs[_h][_j].w); *(LAS v2u*)(lds + PGX_B + ((buf) * 2 + _h) * 16384 + _o) = _w; } } } while (0)
#define PGX_COMPUTE(cur) do { _Pragma("unroll") for (int h = 0; h < 2; ++h) { s16x4 bl[2][2], bh[2][2]; \
        _Pragma("unroll") for (int n = 0; n < 2; ++n) _Pragma("unroll") for (int k = 0; k < 2; ++k) { PGX_TR(bl[n][k], tb[n][0], ((cur) * 2 + h) * 16384 + k * 8192); PGX_TR(bh[n][k], tb[n][1], ((cur) * 2 + h) * 16384 + k * 8192); } \
        _Pragma("unroll") for (int ai = 0; ai < 2; ++ai) if ((ai == 0 && !(MOE_SKIPHALF > 1 && c_half == 2 && wr == 1)) || (ai == 1 && !(MOE_SKIPHALF && c_half))) { bf16x8 At[4][2]; \
            _Pragma("unroll") for (int mm = 0; mm < 4; ++mm) _Pragma("unroll") for (int k = 0; k < 2; ++k) At[mm][k] = *(const LAS bf16x8*)(lds + PGX_A + ((cur) * 2 + ai) * 16384 + aoff + mm * 2048 + k * 1024); \
            asm volatile("s_waitcnt lgkmcnt(0)" ::: "memory"); SBAR(); __builtin_amdgcn_s_setprio(1); \
            _Pragma("unroll") for (int mm = 0; mm < 4; ++mm) _Pragma("unroll") for (int n = 0; n < 2; ++n) _Pragma("unroll") for (int k = 0; k < 2; ++k) \
                acc[ai][h][mm][n] = __builtin_amdgcn_mfma_f32_16x16x32_bf16(PK8(bl[n][k], bh[n][k]), At[mm][k], acc[ai][h][mm][n], 0, 0, 0); \
            __builtin_amdgcn_s_setprio(0); SBAR(); } } } while (0)
#define PGX_BARRIER() do { asm volatile("s_waitcnt lgkmcnt(0)" ::: "memory"); __builtin_amdgcn_s_barrier(); asm volatile("" ::: "memory"); } while (0)
    const int x_total = gn * 8, x_full = (x_total / G) * G, x_tail = x_total - x_full; const bool x_split = MOE_TAILSPLIT && x_tail > 0 && 2 * x_tail <= G;
    const int x_n = x_split ? x_full + 2 * x_tail : x_total;
    const int r_full = (x_n / G) * G, r_rem = x_n - r_full; int tq = -1;
    if (r_rem > 0) { if (G % 8 == 0) { const int per = G / 8, xg = c / per, ig = c % per, lo_ = (xg * r_rem) / 8, hi_ = ((xg + 1) * r_rem) / 8; if (lo_ + ig < hi_) tq = r_full + lo_ + ig; } else if (c < r_rem) tq = r_full + c; }
    int q = c < r_full ? c : tq; if (q < 0) return;
    MoeUnit cur, nxt; const char *cb0, *cb1, *caB, *nb0, *nb1, *naB; unsigned cvo[2][2], nvo[2][2];
    PGX_UNIT(q, cur, cb0, cb1, caB, cvo);
    f32x4 rs[2][4];
    asm volatile("s_waitcnt vmcnt(0)" ::: "memory"); PGX_BARRIER();
    PGX_STAGE_A(0, caB, cvo, 0, cur.tq); PGX_LOAD_B(rs, cb0, cb1, 0, !KSPLIT && cur.hs >= 0);
    PGX_WAIT0(rs); PGX_WRITE_B(rs, 0); PGX_LOAD_B(rs, cb0, cb1, 1, !KSPLIT && cur.hs >= 0); PGX_BARRIER();
    for (;;) {
        const int qn = (q + G < r_full) ? q + G : (q < r_full ? tq : -1); const bool has_next = qn >= 0;
        if (has_next) { PGX_UNIT(qn, nxt, nb0, nb1, naB, nvo); } else { nxt = cur; nb0 = cb0; nb1 = cb1; naB = caB;
#pragma unroll
            for (int h = 0; h < 2; ++h) { nvo[h][0] = cvo[h][0]; nvo[h][1] = cvo[h][1]; } }
        f32x4 acc[2][2][4][2];
#pragma unroll
        for (int a = 0; a < 2; ++a)
#pragma unroll
            for (int b = 0; b < 2; ++b)
#pragma unroll
                for (int mm = 0; mm < 4; ++mm)
#pragma unroll
                    for (int n = 0; n < 2; ++n) acc[a][b][mm][n] = (f32x4){0.f, 0.f, 0.f, 0.f};
        const int c_half = cur.tq; (void)c_half;
        const int ntu = (KSPLIT && cur.hs >= 0) ? nt / 2 : nt;
#pragma unroll 1
        for (int t = 0; t < ntu; t += 2) {
            const bool lastp = (t == ntu - 2);
            int ts = t; asm volatile("" : "+s"(ts));
            const char* p0 = lastp ? nb0 : cb0; const char* p1 = lastp ? nb1 : cb1; const char* pa = lastp ? naB : caB; const int kt2 = lastp ? 0 : ts + 2; const bool hf2 = !KSPLIT && (lastp ? nxt.hs : cur.hs) >= 0;
            PGX_STAGE_A(1, caB, cvo, ts + 1, c_half);
            PGX_COMPUTE(0);
            PGX_WAIT0(rs); PGX_WRITE_B(rs, 1); PGX_LOAD_B(rs, p0, p1, kt2, hf2); PGX_BARRIER();
            { unsigned vo2[2][2];
#pragma unroll
              for (int h = 0; h < 2; ++h) { vo2[h][0] = lastp ? nvo[h][0] : cvo[h][0]; vo2[h][1] = lastp ? nvo[h][1] : cvo[h][1]; }
              PGX_STAGE_A(0, pa, vo2, kt2, lastp ? nxt.tq : c_half); }
            PGX_COMPUTE(1);
            PGX_WAIT0(rs); PGX_WRITE_B(rs, 0); PGX_LOAD_B(rs, p0, p1, kt2 + 1, hf2); PGX_BARRIER();
        }
        E(acc, cur, wr, wc, fr, fq);
        if (!has_next) break;
        cur = nxt; cb0 = nb0; cb1 = nb1; caB = naB; q = qn;
#pragma unroll
        for (int h = 0; h < 2; ++h) { cvo[h][0] = nvo[h][0]; cvo[h][1] = nvo[h][1]; }
    }
    PGX_WAIT0(rs); PGX_BARRIER();
#undef PGX_UNIT
#undef PGX_TR
#undef PGX_STAGE_A
#undef PGX_LOAD_B
#undef PGX_WAIT0
#undef PGX_WRITE_B
#undef PGX_COMPUTE
#undef PGX_BARRIER
}
__device__ __forceinline__ v4u widen_pair(v2u a, v2u b) {
    auto sx = __builtin_amdgcn_permlane16_swap(a.x, b.x, false, false); auto sy = __builtin_amdgcn_permlane16_swap(a.y, b.y, false, false);
    v4u r; r.x = sx[0]; r.y = sy[0]; r.z = sx[1]; r.w = sy[1]; return r; }
struct EpiHMx {
    bf16* HM;
    __device__ __forceinline__ void operator()(const f32x4 (&acc)[2][2][4][2], const MoeUnit& u, int wr, int wc, int fr, int fq) const {
        if (u.hs >= 0 && wc >= 2) return;
        const int row0 = u.row0 + wr * 64 + fr, col0 = u.pn * 128 + (u.hs > 0 ? 64 : 0) + wc * 32 + (fq & 1) * 16 + (fq >> 1) * 8;
#pragma unroll
        for (int ai = 0; ai < 2; ++ai)
#pragma unroll
            for (int mm = 0; mm < 4; ++mm) { v2u w[2];
#pragma unroll
                for (int n = 0; n < 2; ++n) { const f32x4 g0 = acc[ai][0][mm][n], u0 = acc[ai][1][mm][n];
                    w[n].x = cvt_pk_bf16(silu_f(g0[0]) * u0[0], silu_f(g0[1]) * u0[1]); w[n].y = cvt_pk_bf16(silu_f(g0[2]) * u0[2], silu_f(g0[3]) * u0[3]); }
                *(v4u*)(HM + (size_t)(row0 + ai * 128 + mm * 16) * DE + col0) = widen_pair(w[0], w[1]); }
    }
};
struct EpiYx {
    bf16* Y;
    __device__ __forceinline__ void operator()(const f32x4 (&acc)[2][2][4][2], const MoeUnit& u, int wr, int wc, int fr, int fq) const {
        if (u.hs >= 0 && wc >= 2) return;
        const int row0 = u.row0 + wr * 64 + fr, col0 = u.pn * 256 + (u.hs > 0 ? 64 : 0) + wc * 32 + (fq & 1) * 16 + (fq >> 1) * 8;
#pragma unroll
        for (int ai = 0; ai < 2; ++ai)
#pragma unroll
            for (int mm = 0; mm < 4; ++mm)
#pragma unroll
                for (int bj = 0; bj < 2; ++bj) { v2u w[2];
#pragma unroll
                    for (int n = 0; n < 2; ++n) { const f32x4 v = acc[ai][bj][mm][n]; w[n].x = cvt_pk_bf16(v[0], v[1]); w[n].y = cvt_pk_bf16(v[2], v[3]); }
                    *(v4u*)(Y + (size_t)(row0 + ai * 128 + mm * 16) * D + col0 + bj * 128) = widen_pair(w[0], w[1]); }
    }
};

struct EpiYk {
    bf16* Y; bf16* Y2;
    template <int PITCH> __device__ __forceinline__ void put(const f32x4 (&acc)[2][2][4][2], bf16* base, int wr, int wc, int fr, int fq) const {
        int r_ = wr * 64 + fr; asm volatile("" : "+v"(r_));
        bf16* p = base + (size_t)r_ * PITCH + wc * 32 + 4 * fq;
#pragma unroll
        for (int ai = 0; ai < 2; ++ai)
#pragma unroll
            for (int mm = 0; mm < 4; ++mm)
#pragma unroll
                for (int bj = 0; bj < 2; ++bj)
#pragma unroll
                    for (int n = 0; n < 2; ++n) { const f32x4 v = acc[ai][bj][mm][n]; v2u w; w.x = cvt_pk_bf16(v[0], v[1]); w.y = cvt_pk_bf16(v[2], v[3]); *(v2u*)(p + (size_t)(ai * 128 + mm * 16) * PITCH + bj * 128 + 16 * n) = w; }
    }
    __device__ __forceinline__ void operator()(const f32x4 (&acc)[2][2][4][2], const MoeUnit& u, int wr, int wc, int fr, int fq) const {
        if (u.hs > 0) put<256>(acc, Y2 + (size_t)u.tq * 65536, wr, wc, fr, fq); else put<D>(acc, Y + (size_t)u.row0 * D + u.pn * 256, wr, wc, fr, fq);
    }
};

template <bool SPLIT>
__device__ __forceinline__ void p9_tokens(const Args& a, const MoeTab& tab, int lane, int gw, int NGW, int ks_gn, int ks_full) {
    unsigned char* ws = a.ws;
    const float* MOD = (const float*)(ws + WS_MOD); const float* X1 = (const float*)(ws + WS_X1); const bf16* Y = (const bf16*)(ws + WS_Y); const float* gf = a.in[I_NFG];
    const bf16* Y2 = (const bf16*)(ws + WS_Y2); const bf16* ZR = (const bf16*)(ws + WS_ZERO);
    f32x4 gfv[8];
#pragma unroll
    for (int j = 0; j < 8; ++j) gfv[j] = *((const f32x4*)gf + lane + 64 * j);
    int ne0 = 0, ne1 = 0, np0 = 0, np1 = 0; float nw0 = 0.f, nw1 = 0.f;
    if (gw < T) { ne0 = route_eid(ws)[2 * gw]; ne1 = route_eid(ws)[2 * gw + 1]; np0 = route_pos(ws)[2 * gw]; np1 = route_pos(ws)[2 * gw + 1]; nw0 = route_cw(ws)[2 * gw]; nw1 = route_cw(ws)[2 * gw + 1]; }
    for (int t = gw; t < T; t += NGW) {
        const int b = t / SEQ;
        const int e0 = ne0, e1 = ne1;
        const int rr0 = __builtin_amdgcn_readfirstlane(tab.tpre[e0] * MT + tab.spre[e0 * NSH + np0 / SHCAP] + (np0 % SHCAP)), rr1 = __builtin_amdgcn_readfirstlane(tab.tpre[e1] * MT + tab.spre[e1 * NSH + np1 / SHCAP] + (np1 % SHCAP));
        const size_t r0 = (size_t)rr0, r1 = (size_t)rr1;
        const float w0 = nw0, w1 = nw1;
        { const int tn = t + NGW; if (tn < T) { ne0 = route_eid(ws)[2 * tn]; ne1 = route_eid(ws)[2 * tn + 1]; np0 = route_pos(ws)[2 * tn]; np1 = route_pos(ws)[2 * tn + 1]; nw0 = route_cw(ws)[2 * tn]; nw1 = route_cw(ws)[2 * tn + 1]; } }
        const GAS f32x4* xr = (const GAS f32x4*)(X1 + (size_t)t * D) + lane; const GAS v2u* y0 = (const GAS v2u*)(Y + r0 * D) + lane; const GAS v2u* y1 = (const GAS v2u*)(Y + r1 * D) + lane;
        const f32x4* g2 = (const f32x4*)(MOD + (size_t)b * MODC + 5 * D) + lane;
        f32x4 v[8]; float s = 0.f;
#pragma unroll
        for (int j = 0; j < 8; ++j) { v2u a0 = y0[64 * j], a1 = y1[64 * j]; const f32x4 gg = g2[64 * j];
            float p0[4] = {bflo(a0.x), bfhi(a0.x), bflo(a0.y), bfhi(a0.y)}, p1[4] = {bflo(a1.x), bfhi(a1.x), bflo(a1.y), bfhi(a1.y)};
            if constexpr (SPLIT) {
                const int q0 = j * ks_gn + (rr0 >> 8) - ks_full, q1 = j * ks_gn + (rr1 >> 8) - ks_full;
                const bf16* z0 = q0 >= 0 ? Y2 + ((size_t)q0 * 256 + (rr0 & 255)) * 256 : ZR; const bf16* z1 = q1 >= 0 ? Y2 + ((size_t)q1 * 256 + (rr1 & 255)) * 256 : ZR;
                const v2u b0 = *((const GAS v2u*)z0 + lane), b1 = *((const GAS v2u*)z1 + lane);
                p0[0] += bflo(b0.x); p0[1] += bfhi(b0.x); p0[2] += bflo(b0.y); p0[3] += bfhi(b0.y);
                p1[0] += bflo(b1.x); p1[1] += bfhi(b1.x); p1[2] += bflo(b1.y); p1[3] += bfhi(b1.y); }
            f32x4 y; y.x = w0 * p0[0] + w1 * p1[0]; y.y = w0 * p0[1] + w1 * p1[1]; y.z = w0 * p0[2] + w1 * p1[2]; y.w = w0 * p0[3] + w1 * p1[3];
            v[j] = xr[64 * j] + gg * y; s += (v[j].x * v[j].x + v[j].y * v[j].y) + (v[j].z * v[j].z + v[j].w * v[j].w); }
        const float rstd = rsqrtf(wave_sum(s) * (1.f / D) + EPS);
        GAS f32x4* o = (GAS f32x4*)(a.out + (size_t)t * D) + lane;
#pragma unroll
        for (int j = 0; j < 8; ++j) o[64 * j] = v[j] * rstd * gfv[j];
    }
}
__device__ __forceinline__ void p9_final(const Args& a, LAS unsigned char* lds, int tid, int lane, int wave, int vcu, int G) {
    MoeTab tab = moe_tab(lds);
    const int gw = vcu * NWAVES + wave, NGW = G * NWAVES;
    const int ks_gn = tab.tpre[NE], ks_total = ks_gn * 8, ks_full = (ks_total / G) * G; const bool ks_split = MOE_KSPLIT && (ks_total - ks_full) > 0 && 2 * (ks_total - ks_full) <= G;
    if (ks_split) p9_tokens<true>(a, tab, lane, gw, NGW, ks_gn, ks_full); else p9_tokens<false>(a, tab, lane, gw, NGW, ks_gn, ks_full);
}
constexpr size_t NG8 = (size_t)NE * D * DE / 8;
struct SideCvt {
    static constexpr bool ON = true;
    const float* wsrc[3]; bf16* WGU; bf16* WDn; size_t GT; unsigned vsrc, vgu, vdn; int spm, sl, sl_end;
    __device__ __forceinline__ void init(const Args& a, size_t gt, size_t GT_, int first, int last) { wsrc[0] = a.in[I_WG]; wsrc[1] = a.in[I_WU]; wsrc[2] = a.in[I_WD]; WGU = (bf16*)(a.ws + WS_WGU); WDn = (bf16*)(a.ws + WS_WD);
        GT = GT_; spm = (int)(NG8 / GT); sl = first; sl_end = last;
        const size_t i0 = gt * 8; const size_t ek0 = i0 / DE; const int n0 = (int)(i0 % DE);
        vsrc = (unsigned)(i0 * 4); vgu = (unsigned)((ek0 * (2 * DE) + (n0 / 128) * 256 + (n0 % 128)) * 2); vdn = (unsigned)(i0 * 2); }
    __device__ __forceinline__ void load(f32x4 (&v)[2][2]) {
#pragma unroll
        for (int j = 0; j < 2; ++j) { const int s = (sl + j < sl_end) ? sl + j : sl_end - 1; const int which = s >= 2 * spm ? 2 : (s >= spm ? 1 : 0); const int r = s - which * spm;
            const float* sb = (which == 2 ? wsrc[2] : which == 1 ? wsrc[1] : wsrc[0]) + (size_t)r * GT * 8;
            asm volatile("global_load_dwordx4 %0, %1, %2 nt" : "=&v"(v[j][0]) : "v"(vsrc), "s"(sb) : "memory");
            asm volatile("global_load_dwordx4 %0, %1, %2 offset:16 nt" : "=&v"(v[j][1]) : "v"(vsrc), "s"(sb) : "memory"); }
        sl += 2;
    }
    template <int NWAIT> __device__ __forceinline__ void store(f32x4 (&v)[2][2]) {
        if constexpr (NWAIT == 16) asm volatile("s_waitcnt vmcnt(16)" : "+v"(v[0][0]), "+v"(v[0][1]), "+v"(v[1][0]), "+v"(v[1][1]) :: "memory");
        else asm volatile("s_waitcnt vmcnt(0)" : "+v"(v[0][0]), "+v"(v[0][1]), "+v"(v[1][0]), "+v"(v[1][1]) :: "memory");
#pragma unroll
        for (int j = 0; j < 2; ++j) { const int s = (sl - 2 + j < sl_end) ? sl - 2 + j : sl_end - 1; const int which = s >= 2 * spm ? 2 : (s >= spm ? 1 : 0); const int r = s - which * spm;
            v4u o; o.x = cvt_pk_bf16(v[j][0].x, v[j][0].y); o.y = cvt_pk_bf16(v[j][0].z, v[j][0].w); o.z = cvt_pk_bf16(v[j][1].x, v[j][1].y); o.w = cvt_pk_bf16(v[j][1].z, v[j][1].w);
            char* db = which == 2 ? (char*)WDn + (size_t)r * GT * 16 : (char*)WGU + (size_t)r * GT * 32 + (which == 1 ? 256 : 0);
            const unsigned vo = which == 2 ? vdn : vgu;
            *(v4u*)(db + vo) = o; }
    }
};

__global__ void __launch_bounds__(NWAVES * 64, 2) mega(Args args) {
    extern __shared__ __attribute__((aligned(16))) unsigned char lds_raw[];
    LAS unsigned char* lds = (LAS unsigned char*)lds_raw;
    volatile LAS unsigned* MISC = (volatile LAS unsigned*)(lds + MISC_OFF);
    const int tid = threadIdx.x, lane = tid & 63, wave = __builtin_amdgcn_readfirstlane(tid >> 6);
    const int G = gridDim.x; const int bx = blockIdx.x; const int vcu = (G % 8 == 0) ? (bx % 8) * (G / 8) + bx / 8 : bx;
    unsigned char* ws = args.ws;
    gu32* ctl = (gu32*)(ws + WS_CTL);
    for (int u = tid; u < (LDS_BYTES - LDSCTL_OFF) / 4; u += NWAVES * 64) ((LAS unsigned*)(lds + LDSCTL_OFF))[u] = 0u;
    __syncthreads();
    const int lo = args.ph_lo, hi = args.ph_hi;
    XcdBarrier bar; bar.bar = (unsigned*)(ctl + CW_BAR) + lo * XCD_BAR_WORDS; bar.x = 0; bar.st = nullptr;
    if (hi - lo > 1) bar = xcd_barrier_post((unsigned*)(ctl + CW_BAR) + lo * XCD_BAR_WORDS, MISC + 8);
#if SIDE_CVT
    const bool side_ok = (NG8 % ((size_t)G * 512)) == 0; const int side_spm = (int)(NG8 / ((size_t)G * 512));
    int sdn_sl = 2 * side_spm;
#define SDN_BEGIN() SideCvt sdn; sdn.init(args, (size_t)bx * 512 + tid, (size_t)G * 512, sdn_sl, 3 * side_spm)
#define SDN_END() sdn_sl = sdn.sl
#else
    const bool side_ok = false;
#endif
#ifdef PROBE_PH
    unsigned long long pts_a = 0, pts_b = 0;
#endif
#define IN(k) (lo <= (k) && (k) < hi)
#define SEAM(k) do { if (IN(k) && IN((k) + 1)) xcd_barrier(bar, threadIdx.x == 0); } while (0)

#ifdef PROBE_PH
    if (PROBE_PH == 0) pts_a = __builtin_amdgcn_s_memrealtime(); else if (PROBE_PH + 1 == 0) pts_b = __builtin_amdgcn_s_memrealtime();
#endif
#if defined(PROBE_PH) && defined(PROBE_P0SUB)
    unsigned long long ts_iv[2] = {0, 0}; const unsigned long long ts_k0 = __builtin_amdgcn_s_memrealtime();
    if (IN(0)) { p0_prologue(args, lds, tid, lane, wave, vcu, G, false, ts_iv); }
    const unsigned long long ts_it = ts_iv[0];
    if (PROBE_P0SUB == 4) { pts_a = ts_k0; pts_b = ts_iv[1]; }
    if (PROBE_P0SUB == 1) { pts_a = ts_k0; pts_b = ts_it; }
    if (PROBE_P0SUB == 2) { pts_a = ts_it; pts_b = __builtin_amdgcn_s_memrealtime(); }
    if (PROBE_P0SUB == 3) pts_a = __builtin_amdgcn_s_memrealtime();
    SEAM(0);
#else
    if (IN(0)) { p0_prologue(args, lds, tid, lane, wave, vcu, G, false); } SEAM(0);
#endif
#ifdef PROBE_PH
    if (PROBE_PH == 1) pts_a = __builtin_amdgcn_s_memrealtime(); else if (PROBE_PH + 1 == 1) pts_b = __builtin_amdgcn_s_memrealtime();
#endif
    if (IN(1)) { p1_norm(args, lds, tid, lane, wave, G); } SEAM(1);
#ifdef PROBE_PH
    if (PROBE_PH == 2) pts_a = __builtin_amdgcn_s_memrealtime(); else if (PROBE_PH + 1 == 2) pts_b = __builtin_amdgcn_s_memrealtime();
#endif
    if (IN(2)) {
        pg8::StaticOrder S; S.init((const bf16*)(ws + WS_H), (const bf16*)(ws + WS_WIN), T, INC, G, bx);
        EpiBf16 E{(bf16*)(ws + WS_U), INC};
#if SIDE_CVT
        if (side_ok) {
            SideCvt sd; sd.init(args, (size_t)bx * 512 + tid, (size_t)G * 512, 0, 2 * side_spm);
            pg8::gemm_phase<EpiBf16, pg8::StaticOrder, true, false, false, SideCvt>(lds + RING_OFF, D, S, E, &sd);
            while (sd.sl < sd.sl_end) { f32x4 sv[2][2]; sd.load(sv); sd.store<0>(sv); }
        } else
#endif
        pg8::gemm_phase<EpiBf16, pg8::StaticOrder, true, false>(lds + RING_OFF, D, S, E);
#if TAIL_W4 && P0_V2 && !LATE_W4
        { const int nwg2 = (T / 256) * (INC / 256), rem = nwg2 % G; const bool helper = rem == 0 || bx >= rem;
          if (helper) { const int hi_ = rem == 0 ? bx : bx - rem, nh = rem == 0 ? G : G - rem;
              __syncthreads();
              tr_range(args, (LAS float*)(lds + wave * 12288), lane, I_WIN_N_ + hi_ * NWAVES + wave, nh * NWAVES, I_TR_ALL); } }
#endif
#if PG8_HALF_TAIL
        { pg8::StaticOrder S2 = S; S2.tail = 1; EpiBf16H E2{(bf16*)(ws + WS_U), INC};
          pg8::gemm_phase<EpiBf16H, pg8::StaticOrder, true, false, false, pg8::NoSide, true>(lds + RING_OFF, D, S2, E2); }
#endif
    } SEAM(2);
#ifdef PROBE_PH
    if (PROBE_PH == 3) pts_a = __builtin_amdgcn_s_memrealtime(); else if (PROBE_PH + 1 == 3) pts_b = __builtin_amdgcn_s_memrealtime();
#endif
    if (IN(3)) { for (int u = bx; u < NB * RH * NCH; u += G) p3a_unit(args, lds, u, tid, lane, wave);
#if LATE_W4
        __syncthreads(); late_w4_convert(args, lds, lane, wave, vcu, G);
#endif
    } SEAM(3);
#ifdef PROBE_PH
    if (PROBE_PH == 4) pts_a = __builtin_amdgcn_s_memrealtime(); else if (PROBE_PH + 1 == 4) pts_b = __builtin_amdgcn_s_memrealtime();
#endif
    if (IN(4)) { p3b_scan_conv(args, tid, lane, wave, vcu, G); } SEAM(4);
#ifdef PROBE_PH
    if (PROBE_PH == 5) pts_a = __builtin_amdgcn_s_memrealtime(); else if (PROBE_PH + 1 == 5) pts_b = __builtin_amdgcn_s_memrealtime();
#endif
    if (IN(5)) { for (int u = bx; u < NB * RH * NCH; u += G) p3c_unit(args, lds, u, tid, lane, wave); } SEAM(5);
#ifdef PROBE_PH
    if (PROBE_PH == 6) pts_a = __builtin_amdgcn_s_memrealtime(); else if (PROBE_PH + 1 == 6) pts_b = __builtin_amdgcn_s_memrealtime();
#endif
    if (IN(6)) {
        pg8::StaticOrder S; S.init((const bf16*)(ws + WS_A4), (const bf16*)(ws + WS_W4), T, D, G, bx);
        EpiMG2 E{(const bf16*)(ws + WS_U), (bf16*)(ws + WS_MG)};
        pg8::gemm_phase<EpiMG2, pg8::StaticOrder, true, false, false, pg8::NoSide, false, true>(lds + RING_OFF, K4, S, E);
    } SEAM(6);
#ifdef PROBE_PH
    if (PROBE_PH == 7) pts_a = __builtin_amdgcn_s_memrealtime(); else if (PROBE_PH + 1 == 7) pts_b = __builtin_amdgcn_s_memrealtime();
#endif
    if (IN(7)) {
        pg8::StaticOrder S; S.init((const bf16*)(ws + WS_MG), (const bf16*)(ws + WS_WO), T, D, G, bx);
        EpiX1 E{args.in[I_X], (const float*)(ws + WS_MOD), (float*)(ws + WS_X1)};
#if SIDE_CVT
        if (side_ok) { SDN_BEGIN(); pg8::gemm_phase<EpiX1, pg8::StaticOrder, true, false, false, SideCvt>(lds + RING_OFF, D, S, E, &sdn);
            while (sdn.sl < sdn.sl_end) { f32x4 sv[2][2]; sdn.load(sv); sdn.store<0>(sv); } } else
#endif
        pg8::gemm_phase<EpiX1, pg8::StaticOrder, true, false>(lds + RING_OFF, D, S, E);
    } SEAM(7);
#ifdef PROBE_PH
    if (PROBE_PH == 8) pts_a = __builtin_amdgcn_s_memrealtime(); else if (PROBE_PH + 1 == 8) pts_b = __builtin_amdgcn_s_memrealtime();
#endif
#if defined(PROBE_PH) && defined(PROBE_P6SUB)
    { unsigned long long tsv[3] = {0, 0, 0}; const unsigned long long t_in = __builtin_amdgcn_s_memrealtime();
      if (IN(8)) { p6_route(args, lds, tid, lane, wave, G, tsv); }
      const unsigned long long t_out = __builtin_amdgcn_s_memrealtime();
      if (PROBE_P6SUB == 0) { pts_a = t_in; pts_b = tsv[0]; } else if (PROBE_P6SUB == 1) { pts_a = tsv[0]; pts_b = tsv[1]; } else if (PROBE_P6SUB == 2) { pts_a = tsv[1]; pts_b = tsv[2]; } else { pts_a = tsv[2]; pts_b = t_out; } }
    SEAM(8);
#else
    if (IN(8)) { p6_route(args, lds, tid, lane, wave, G); } SEAM(8);
#endif
#ifdef PROBE_PH
    if (PROBE_PH == 9) pts_a = __builtin_amdgcn_s_memrealtime(); else if (PROBE_PH + 1 == 9) pts_b = __builtin_amdgcn_s_memrealtime();
#endif
    if (IN(9)) {
        moe_build_tab(args, lds, tid);
#if MOE_E
        EpiHMe E{(bf16*)(ws + WS_HM)};
        moe_gemmE<true, EpiHMe>(lds, D, moe_tab(lds), G, vcu, (const char*)(ws + WS_H), route_list(ws), args.in[I_WG], args.in[I_WU], (size_t)D * DE, DE, 64, E);
#elif MOE_MT == 256
        EpiHMx E{(bf16*)(ws + WS_HM)};
                moe_gemm256<true, EpiHMx>(lds, D, moe_tab(lds), G, vcu, (const char*)(ws + WS_H), route_list(ws), args.in[I_WG], args.in[I_WU], (size_t)D * DE, DE, 128, E);
#else
        EpiHMm E{(bf16*)(ws + WS_HM)};
        moe_gemm<true, EpiHMm>(lds, D, moe_tab(lds), G, vcu, (const char*)(ws + WS_H), route_list(ws), args.in[I_WG], args.in[I_WU], (size_t)D * DE, DE, 128, E);
#endif
    } SEAM(9);
#ifdef PROBE_PH
    if (PROBE_PH == 10) pts_a = __builtin_amdgcn_s_memrealtime(); else if (PROBE_PH + 1 == 10) pts_b = __builtin_amdgcn_s_memrealtime();
#endif
    if (IN(10)) {
        if (lo == 10) moe_build_tab(args, lds, tid);
#if MOE_E
        EpiYe E{(bf16*)(ws + WS_Y)};
        moe_gemmE<false, EpiYe>(lds, DE, moe_tab(lds), G, vcu, (const char*)(ws + WS_HM), nullptr, args.in[I_WD], args.in[I_WD] + 64, (size_t)DE * D, D, 128, E);
#elif MOE_MT == 256
#if MOE_KSPLIT
        EpiYk E{(bf16*)(ws + WS_Y), (bf16*)(ws + WS_Y2)};
        moe_gemm256<false, EpiYk, true>(lds, DE, moe_tab(lds), G, vcu, (const char*)(ws + WS_HM), nullptr, args.in[I_WD], args.in[I_WD] + 128, (size_t)DE * D, D, 256, E);
#else
        EpiYx E{(bf16*)(ws + WS_Y)};
        moe_gemm256<false, EpiYx>(lds, DE, moe_tab(lds), G, vcu, (const char*)(ws + WS_HM), nullptr, args.in[I_WD], args.in[I_WD] + 128, (size_t)DE * D, D, 256, E);
#endif
#else
        EpiYm E{(bf16*)(ws + WS_Y)};
        moe_gemm<false, EpiYm>(lds, DE, moe_tab(lds), G, vcu, (const char*)(ws + WS_HM), nullptr, args.in[I_WD], args.in[I_WD] + 128, (size_t)DE * D, D, 256, E);
#endif
    }
    if (IN(10) && IN(11)) xcd_barrier(bar, wave == 0 && lane_id() == 0);
#ifdef PROBE_PH
    if (PROBE_PH == 11) pts_a = __builtin_amdgcn_s_memrealtime(); else if (PROBE_PH + 1 == 11) pts_b = __builtin_amdgcn_s_memrealtime();
#endif
    if (IN(11)) { const int lane2 = lane_id(), tid2 = wave * 64 + lane2; if (lo == 11) moe_build_tab(args, lds, tid2); p9_final(args, lds, tid2, lane2, wave, vcu, G); }
#ifdef PROBE_PH
    if (bx == PROBE_BX && wave == PROBE_WV) {
        if (PROBE_PH == 11) pts_b = __builtin_amdgcn_s_memrealtime();
        const long long v = (long long)(pts_b - pts_a);
        const unsigned long long t0 = __builtin_amdgcn_s_memrealtime();
        while ((long long)(__builtin_amdgcn_s_memrealtime() - t0) < v * 10) __builtin_amdgcn_s_sleep(32);
    }
#endif
#undef IN
#undef SEAM
}
#ifndef MK_ONE_LAUNCH
#define MK_ONE_LAUNCH 0
#endif
constexpr int N_PHASES = 12;
extern "C" void kernel_launch(void* const* d_in, const int* in_sizes, int n_in, void* d_out, int out_size, void* d_ws, size_t ws_size, hipStream_t stream) {
    static int grid = 0;
    if (grid == 0) {
        int dev = 0, cus = 0;
        if (hipGetDevice(&dev) != hipSuccess || hipDeviceGetAttribute(&cus, hipDeviceAttributeMultiprocessorCount, dev) != hipSuccess) { grid = -1; return; }
        if (hipFuncSetAttribute((const void*)mega, hipFuncAttributeMaxDynamicSharedMemorySize, LDS_BYTES) != hipSuccess) { fprintf(stderr, "hipFuncSetAttribute failed\n"); grid = -1; return; }
        if (ws_size < WS_END || n_in != 19) { fprintf(stderr, "ws too small / bad inputs: %zu < %zu\n", ws_size, (size_t)WS_END); grid = -1; return; }
        int per_cu = 0;
        if (hipOccupancyMaxActiveBlocksPerMultiprocessor(&per_cu, (const void*)mega, NWAVES * 64, LDS_BYTES) != hipSuccess || per_cu < 1) fprintf(stderr, "occupancy query: %d\n", per_cu);
        (void)hipGetLastError();
        grid = cus;
    }
    if (grid < 0) return;
    unsigned char* ws = (unsigned char*)d_ws;
    (void)hipMemsetAsync(ws + WS_CTL, 0, CTL_ZERO_BYTES, stream);
    Args a{};
    for (int i = 0; i < 19; ++i) a.in[i] = (const float*)d_in[i];
    a.out = (float*)d_out; a.ws = ws;
#if MK_ONE_LAUNCH
    a.ph_lo = 0; a.ph_hi = N_PHASES; hipLaunchKernelGGL(mega, dim3(grid), dim3(NWAVES * 64), LDS_BYTES, stream, a);
#ifdef PROBE_EXTRA
    a.ph_lo = PROBE_EXTRA; a.ph_hi = PROBE_EXTRA + 1; hipLaunchKernelGGL(mega, dim3(grid), dim3(NWAVES * 64), LDS_BYTES, stream, a);
#endif
#else
    for (int ph = 0; ph < N_PHASES; ++ph) { a.ph_lo = ph; a.ph_hi = ph + 1; hipLaunchKernelGGL(mega, dim3(grid), dim3(NWAVES * 64), LDS_BYTES, stream, a); }
#endif
}
```
